# Optimizing an MI355X kernel written in HIP

```python
import jax, jax.numpy as jnp
from jax import lax
import numpy as np

D_MODEL = 2048
BATCH = 2
SEQ = 8192
DEPTH = 4

N_MIXERS = 3
N_GLA = (DEPTH + 2) // 3
N_POOL = (DEPTH + 1) // 3
N_DSA = DEPTH // 3

GLA_HEADS = 4
GLA_DK = D_MODEL // 2 // GLA_HEADS
GLA_DV = D_MODEL // GLA_HEADS
GLA_GATE_RANK = 16
GLA_TAU = 16.0
GLA_CHUNK = 64
GLA_IN_SIZES = (GLA_HEADS * GLA_DK, GLA_HEADS * GLA_DK, GLA_HEADS * GLA_DV, GLA_HEADS * GLA_DV)

POOL_WINDOWS = (2, 4, 8, 16)
POOL_GROUPS = len(POOL_WINDOWS)
POOL_GW = D_MODEL // POOL_GROUPS

DSA_HEADS = 16
DSA_KV_HEADS = 4
DSA_HEAD_DIM = D_MODEL // DSA_HEADS
DSA_IDX_HEADS = 16
DSA_IDX_DIM = 64
DSA_TOPK_MAX = 256
DSA_QBLOCK = 128
DSA_IN_SIZES = (DSA_HEADS * DSA_HEAD_DIM, DSA_KV_HEADS * DSA_HEAD_DIM, DSA_KV_HEADS * DSA_HEAD_DIM,
                DSA_IDX_HEADS * DSA_IDX_DIM, DSA_IDX_DIM, DSA_IDX_HEADS)

D_FF = ((8 * D_MODEL // 3 + 127) // 128) * 128
CONV_WIDTH = 3

PLE_DIM = 256
LN_EPS = 1e-5
ALPHA = (2.0 * DEPTH) ** 0.25
BETA = (8.0 * DEPTH) ** -0.25

kernel_name = "hybrid_gla_pool_dsa_convffn_deepnorm"


def _split_points(sizes):
    pts, acc = [], 0
    for s in sizes[:-1]:
        acc += s
        pts.append(acc)
    return pts


def _layer_norm(x, g, b):
    xf = x.astype(jnp.float32)
    mu = jnp.mean(xf, -1, keepdims=True)
    var = jnp.mean(jnp.square(xf - mu), -1, keepdims=True)
    return ((xf - mu) * lax.rsqrt(var + LN_EPS) * g.astype(jnp.float32) + b.astype(jnp.float32)).astype(x.dtype)


def _gla_mixer(x, w_in, w_a1, w_a2, b_a, norm_g, w_o):
    B, L, _ = x.shape
    H, DK, DV, C = GLA_HEADS, GLA_DK, GLA_DV, GLA_CHUNK
    n = L // C
    q, k, v, r = jnp.split(x @ w_in, _split_points(GLA_IN_SIZES), axis=-1)
    log_a = jax.nn.log_sigmoid(((x @ w_a1) @ w_a2 + b_a).astype(jnp.float32)) / GLA_TAU

    def to_chunks(t, d):
        return t.reshape(B, n, C, H, d).transpose(1, 0, 3, 2, 4).astype(jnp.float32)

    qc = to_chunks(q, DK) * (DK ** -0.5)
    kc = to_chunks(k, DK)
    vc = to_chunks(v, DV)
    bc = jnp.cumsum(to_chunks(log_a, DK), axis=3)
    causal = jnp.tril(jnp.ones((C, C), dtype=bool))[:, :, None]

    def step(S, inp):
        qt, kt, vt, bt = inp
        o_inter = jnp.einsum('bhtk,bhkv->bhtv', qt * jnp.exp(bt), S)
        diff = bt[:, :, :, None, :] - bt[:, :, None, :, :]
        decay = jnp.exp(jnp.where(causal, diff, -jnp.inf))
        scores = jnp.einsum('bhtk,bhsk,bhtsk->bhts', qt, kt, decay)
        o_intra = jnp.einsum('bhts,bhsv->bhtv', scores, vt)
        b_last = bt[:, :, -1:, :]
        S_new = S * jnp.exp(b_last[:, :, 0, :, None]) + jnp.einsum('bhsk,bhsv->bhkv', kt * jnp.exp(b_last - bt), vt)
        return S_new, o_inter + o_intra

    S0 = jnp.zeros((B, H, DK, DV), jnp.float32)
    _, o = lax.scan(step, S0, (qc, kc, vc, bc))
    o = o * lax.rsqrt(jnp.mean(o * o, -1, keepdims=True) + LN_EPS)
    o = o.transpose(1, 0, 3, 2, 4).reshape(B, L, H, DV) * norm_g.astype(jnp.float32).reshape(H, DV)
    o = o.reshape(B, L, H * DV).astype(x.dtype) * jax.nn.silu(r)
    return o @ w_o


def _pool_mixer(x, w_grp, scale):
    B, L, D = x.shape
    xf = x.astype(jnp.float32)
    cs = jnp.cumsum(xf, axis=1)
    t = jnp.arange(L)
    outs = []
    for g, w in enumerate(POOL_WINDOWS):
        csg = cs[:, :, g * POOL_GW:(g + 1) * POOL_GW]
        shifted = jnp.pad(csg, ((0, 0), (w, 0), (0, 0)))[:, :L]
        cnt = jnp.minimum(t + 1, w).astype(jnp.float32)[None, :, None]
        outs.append((csg - shifted) / cnt - xf[:, :, g * POOL_GW:(g + 1) * POOL_GW])
    pooled = jnp.stack(outs, axis=2).astype(x.dtype)
    y = jnp.einsum('blgc,gcd->blgd', pooled, w_grp).reshape(B, L, D)
    return y * scale


def _dsa_mixer(x, w_in, kidx_g, kidx_b, w_o):
    B, L, _ = x.shape
    G, R, Dh = DSA_KV_HEADS, DSA_HEADS // DSA_KV_HEADS, DSA_HEAD_DIM
    HI, DI, QB = DSA_IDX_HEADS, DSA_IDX_DIM, DSA_QBLOCK
    topk = min(DSA_TOPK_MAX, L // 4)
    nb = L // QB
    q, k, v, qi, ki, wi = jnp.split(x @ w_in, _split_points(DSA_IN_SIZES), axis=-1)
    q = q.reshape(B, L, G, R, Dh)
    k = k.reshape(B, L, G, Dh)
    v = v.reshape(B, L, G, Dh)
    qi = qi.reshape(B, L, HI, DI).astype(jnp.float32)
    ki = _layer_norm(ki, kidx_g, kidx_b).astype(jnp.float32)
    wi = wi.astype(jnp.float32) * (HI ** -0.5) * (DI ** -0.5)

    def blockify(t):
        return t.reshape((B, nb, QB) + t.shape[2:]).swapaxes(0, 1)

    s_pos = jnp.arange(L)

    def block(args):
        blk, qb, qib, wib = args
        t_pos = blk * QB + jnp.arange(QB)
        rel = jax.nn.relu(jnp.einsum('bthd,bsd->bths', qib, ki))
        idx_score = jnp.einsum('bth,bths->bts', wib, rel)
        admissible = s_pos[None, :] <= t_pos[:, None]
        idx_score = jnp.where(admissible[None], idx_score, -jnp.inf)
        _, sel = lax.top_k(idx_score, topk)
        valid = sel <= t_pos[None, :, None]
        ksel = jax.vmap(lambda kb, ib: kb[ib])(k, sel).astype(jnp.float32)
        vsel = jax.vmap(lambda vb, ib: vb[ib])(v, sel).astype(jnp.float32)
        s = jnp.einsum('btgrd,btkgd->btgrk', qb.astype(jnp.float32), ksel) * (Dh ** -0.5)
        s = jnp.where(valid[:, :, None, None, :], s, -jnp.inf)
        prob = jax.nn.softmax(s, axis=-1)
        o = jnp.einsum('btgrk,btkgd->btgrd', prob, vsel)
        return o.reshape(B, QB, G * R * Dh).astype(x.dtype)

    o = lax.map(block, (jnp.arange(nb), blockify(q), blockify(qi), blockify(wi)))
    o = o.swapaxes(0, 1).reshape(B, L, G * R * Dh)
    return o @ w_o


def _conv_ffn(x, w_up, conv_w, conv_b, w_down):
    L = x.shape[1]
    h = x @ w_up
    hp = jnp.pad(h, ((0, 0), (CONV_WIDTH - 1, 0), (0, 0)))
    hc = conv_b + hp[:, 0:L] * conv_w[0]
    for j in range(1, CONV_WIDTH):
        hc = hc + hp[:, j:j + L] * conv_w[j]
    g, u = jnp.split(hc, 2, axis=-1)
    return (jax.nn.gelu(g, approximate=False) * u) @ w_down


def setup_inputs(seed: int = 0) -> dict:
    key = jax.random.key(seed)
    ks = jax.random.split(key, 24)
    f32 = jnp.float32

    def nrm(k, shape, scale):
        return jax.random.normal(k, shape, f32) * scale

    D = D_MODEL
    return {
        "x": nrm(ks[0], (BATCH, SEQ, D), 1.0),
        "p": nrm(ks[1], (DEPTH, BATCH, SEQ, PLE_DIM), 1.0),
        "gla_w_in": nrm(ks[2], (N_GLA, D, sum(GLA_IN_SIZES)), D ** -0.5),
        "gla_w_a1": nrm(ks[3], (N_GLA, D, GLA_GATE_RANK), D ** -0.5),
        "gla_w_a2": nrm(ks[4], (N_GLA, GLA_GATE_RANK, GLA_HEADS * GLA_DK), GLA_GATE_RANK ** -0.5),
        "gla_b_a": nrm(ks[5], (N_GLA, GLA_HEADS * GLA_DK), 0.1),
        "gla_norm_g": 1.0 + nrm(ks[6], (N_GLA, GLA_HEADS * GLA_DV), 0.02),
        "gla_w_o": nrm(ks[7], (N_GLA, GLA_HEADS * GLA_DV, D), (GLA_HEADS * GLA_DV) ** -0.5 * BETA),
        "pool_w": nrm(ks[8], (N_POOL, POOL_GROUPS, POOL_GW, POOL_GW), POOL_GW ** -0.5 * BETA),
        "pool_scale": 1.0 + nrm(ks[9], (N_POOL, D), 0.02),
        "dsa_w_in": nrm(ks[10], (N_DSA, D, sum(DSA_IN_SIZES)), D ** -0.5),
        "dsa_kidx_g": 1.0 + nrm(ks[11], (N_DSA, DSA_IDX_DIM), 0.02),
        "dsa_kidx_b": nrm(ks[12], (N_DSA, DSA_IDX_DIM), 0.02),
        "dsa_w_o": nrm(ks[13], (N_DSA, DSA_HEADS * DSA_HEAD_DIM, D), (DSA_HEADS * DSA_HEAD_DIM) ** -0.5 * BETA),
        "ln_mix_g": 1.0 + nrm(ks[14], (DEPTH, D), 0.02),
        "ln_mix_b": nrm(ks[15], (DEPTH, D), 0.02),
        "ffn_w_up": nrm(ks[16], (DEPTH, D, 2 * D_FF), D ** -0.5),
        "ffn_conv_w": nrm(ks[17], (DEPTH, CONV_WIDTH, 2 * D_FF), CONV_WIDTH ** -0.5),
        "ffn_conv_b": nrm(ks[18], (DEPTH, 2 * D_FF), 0.02),
        "ffn_w_down": nrm(ks[19], (DEPTH, D_FF, D), D_FF ** -0.5 * BETA),
        "ple_gate_w": nrm(ks[20], (DEPTH, D, D), D ** -0.5),
        "ple_proj_w": nrm(ks[21], (DEPTH, PLE_DIM, D), PLE_DIM ** -0.5 * BETA),
        "ln_ffn_g": 1.0 + nrm(ks[22], (DEPTH, D), 0.02),
        "ln_ffn_b": nrm(ks[23], (DEPTH, D), 0.02),
    }


def reference(x, p, gla_w_in, gla_w_a1, gla_w_a2, gla_b_a, gla_norm_g, gla_w_o,
              pool_w, pool_scale, dsa_w_in, dsa_kidx_g, dsa_kidx_b, dsa_w_o,
              ln_mix_g, ln_mix_b, ffn_w_up, ffn_conv_w, ffn_conv_b, ffn_w_down,
              ple_gate_w, ple_proj_w, ln_ffn_g, ln_ffn_b):
    for i in range(DEPTH):
        kind, j = i % N_MIXERS, i // N_MIXERS
        if kind == 0:
            m = _gla_mixer(x, gla_w_in[j], gla_w_a1[j], gla_w_a2[j], gla_b_a[j], gla_norm_g[j], gla_w_o[j])
        elif kind == 1:
            m = _pool_mixer(x, pool_w[j], pool_scale[j])
        else:
            m = _dsa_mixer(x, dsa_w_in[j], dsa_kidx_g[j], dsa_kidx_b[j], dsa_w_o[j])
        x = _layer_norm(ALPHA * x + m, ln_mix_g[i], ln_mix_b[i])
        ple = jax.nn.sigmoid(x @ ple_gate_w[i]) * (p[i] @ ple_proj_w[i])
        f = _conv_ffn(x, ffn_w_up[i], ffn_conv_w[i], ffn_conv_b[i], ffn_w_down[i])
        x = _layer_norm(ALPHA * x + f + ple, ln_ffn_g[i], ln_ffn_b[i])
    return x
```

```cpp
#include <hip/hip_runtime.h>
#include <hip/hip_cooperative_groups.h>
#include <cstdio>
namespace cg = cooperative_groups;

#define LAS __attribute__((address_space(3)))
typedef unsigned short bf16_t;
typedef short bf16x8 __attribute__((ext_vector_type(8)));
typedef float f32x4 __attribute__((ext_vector_type(4)));
typedef float f32x2 __attribute__((ext_vector_type(2)));
typedef unsigned u32x4 __attribute__((ext_vector_type(4)));
typedef unsigned u32x2 __attribute__((ext_vector_type(2)));

constexpr int T = 16384, SEQ = 8192, D = 2048, DFF = 5504, NUP = 11008, PLE = 256;
constexpr int GLA_N = 6144, DSA_N = 4176, DSA_NP = 4352;
constexpr float LN_EPS = 1e-5f;
constexpr float ALPHA = 1.681792830507429f;

constexpr size_t OFF_XF = 0;
constexpr size_t OFF_XB = OFF_XF + (size_t)T * D * 4;
constexpr size_t OFF_PB = OFF_XB + (size_t)T * D * 2;
constexpr size_t OFF_PLE = OFF_PB + (size_t)4 * T * PLE * 2;
constexpr size_t OFF_H = OFF_PLE + (size_t)T * D * 2;
constexpr size_t OFF_ACT = OFF_H + (size_t)T * NUP * 2;
constexpr size_t OFF_O = OFF_ACT + (size_t)T * DFF * 2;
constexpr size_t OFF_KTT = OFF_O + (size_t)T * D * 2;
constexpr size_t OFF_SEL = OFF_KTT + (size_t)T * 1024 * 2;
constexpr size_t OFF_XA = OFF_SEL + (size_t)T * 256 * 4;
constexpr size_t OFF_SSQ = OFF_XA + (size_t)T * 16 * 4;
constexpr size_t OFF_DL = OFF_SSQ + (size_t)T * 4 * 4;
constexpr size_t OFF_KIN = OFF_DL + (size_t)8 * 32 * 256 * 4;
constexpr size_t OFF_PP = OFF_KIN + (size_t)T * 64 * 2;
constexpr size_t OFF_CTL = OFF_PP + (size_t)T * D * 2;
constexpr size_t CTL_BYTES = 65536;
constexpr size_t OFF_ST = OFF_CTL + CTL_BYTES;
constexpr size_t OFF_W = OFF_ST + (size_t)T * 8;
constexpr size_t W_GIN = 0;
constexpr size_t W_GO = W_GIN + (size_t)2 * GLA_N * D;
constexpr size_t W_POOL = W_GO + (size_t)2 * D * D;
constexpr size_t W_DIN = W_POOL + (size_t)D * 512;
constexpr size_t W_DO = W_DIN + (size_t)DSA_NP * D;
constexpr size_t W_UP = W_DO + (size_t)D * D;
constexpr size_t W_DOWN = W_UP + (size_t)4 * NUP * D;
constexpr size_t W_GATE = W_DOWN + (size_t)4 * D * DFF;
constexpr size_t W_PROJ = W_GATE + (size_t)4 * D * D;
constexpr size_t W_END = W_PROJ + (size_t)4 * D * PLE;
constexpr size_t WS_END = OFF_W + W_END * 2;
constexpr size_t OFF_QKVR = OFF_H;
constexpr size_t OFF_BP = OFF_H + (size_t)T * GLA_N * 2;
constexpr size_t OFF_UT = OFF_ACT;
constexpr size_t OFF_KT = OFF_ACT + (size_t)8 * 32 * 512 * 256 * 4;
static_assert(OFF_BP + (size_t)8 * 32 * 512 * 512 * 2 <= OFF_ACT, "GLA overlay 1");
static_assert(OFF_KT + (size_t)T * 1024 * 2 <= OFF_O, "GLA overlay 2");

constexpr int LDS_BYTES = 147456;
constexpr int LDS_BAR_OFF = LDS_BYTES - 64;

__device__ __forceinline__ float bf2f(unsigned short b) { return __uint_as_float(((unsigned)b) << 16); }
__device__ __forceinline__ unsigned f2bf(float f) { unsigned u = __float_as_uint(f); return (u + 0x7fffu + ((u >> 16) & 1u)) >> 16; }
__device__ __forceinline__ unsigned cvt_pk_bf16(float lo, float hi) { unsigned r; asm volatile("v_cvt_pk_bf16_f32 %0, %1, %2" : "=v"(r) : "v"(lo), "v"(hi)); return r; }
__device__ __forceinline__ float lo16(unsigned w) { return __uint_as_float(w << 16); }
__device__ __forceinline__ float hi16(unsigned w) { return __uint_as_float(w & 0xffff0000u); }
__device__ __forceinline__ float shx(float v, int m, int lane) { return __int_as_float(__builtin_amdgcn_ds_bpermute((lane ^ m) << 2, __float_as_int(v))); }
__device__ __forceinline__ int shi(int v, int src) { return __builtin_amdgcn_ds_bpermute(src << 2, v); }
__device__ __forceinline__ float wave_sum(float v, int lane) {
#pragma unroll
    for (int o = 1; o < 64; o <<= 1) v += shx(v, o, lane);
    return v;
}
__device__ __forceinline__ f32x2 gelu_pk(f32x2 v) {
    const f32x2 av = __builtin_elementwise_abs(v), d = av * 0.2316418882f + 1.0f;
    f32x2 t; t.x = __builtin_amdgcn_rcpf(d.x); t.y = __builtin_amdgcn_rcpf(d.y);
    f32x2 q = t * 0.5307027145f + (-0.7265760135f); q = q * t + 0.7107068705f; q = q * t + (-0.142248368f); q = q * t + 0.127414796f; q = q * t;
    const f32x2 s = (v * v) * (-0.72134752044f);
    f32x2 e; e.x = __builtin_amdgcn_exp2f(s.x); e.y = __builtin_amdgcn_exp2f(s.y);
    const f32x2 m = v * (q * e), r = v - m;
    f32x2 o; o.x = v.x < 0.f ? m.x : r.x; o.y = v.y < 0.f ? m.y : r.y; return o;
}
__device__ __forceinline__ float sigmoidf_(float x) { return 1.0f / (1.0f + __expf(-x)); }

__device__ __forceinline__ int lane_asm() { int l; asm volatile("v_mbcnt_lo_u32_b32 %0, -1, 0\n\tv_mbcnt_hi_u32_b32 %0, -1, %0" : "=&v"(l)); return l; }
__device__ __forceinline__ int opaque_tid(int widk) { asm volatile("" : "+s"(widk)); int l; asm volatile("v_mbcnt_lo_u32_b32 %0, -1, 0\n\tv_mbcnt_hi_u32_b32 %0, -1, %0" : "=&v"(l)); return (widk << 6) | l; }
__device__ __forceinline__ int opaque_s(int v) { v = __builtin_amdgcn_readfirstlane(v); asm volatile("" : "+s"(v)); return v; }
#define IDX_SETUP const int tid = opaque_tid(widk), lane = tid & 63, wid = __builtin_amdgcn_readfirstlane(tid >> 6); const int G = opaque_s(gridDim.x), c = opaque_s(blockIdx.x); \
    const int gw = c * 8 + wid, NGW = G * 8, gt = c * 512 + tid, NT = G * 512; (void)lane; (void)wid; (void)gw; (void)NGW; (void)gt; (void)NT;
namespace pg8 {
constexpr int BM = 256, BK = 64, HALF = 128, HTB = HALF * BK * 2, NXCD = 8, WGM = 4;
__host__ __device__ __forceinline__ int lds_byte(int r, int c) { const int st = (r >> 4) * 2 + (c >> 5), rr = r & 15, cc = c & 31, ob = rr * 64 + cc * 2; return st * 1024 + (ob ^ (((ob >> 9) & 1) << 5)); }
__host__ __device__ __forceinline__ void stage_rc(int b, int& R, int& C) { const int st = b / 1024, sb = b % 1024, swz = sb ^ (((sb >> 9) & 1) << 5); R = (st >> 1) * 16 + swz / 64; C = (st & 1) * 32 + (swz % 64) / 2; }
__host__ __device__ __forceinline__ int perm32(int rho) { const int n = rho >> 4, i = rho & 15; return 8 * (i >> 2) + 4 * n + (i & 3); }

struct Unit { int pm, pn; const char* A; const char* B; };

struct TileOrder {
    int nM, nN, nwg, G, c;
    __device__ __forceinline__ void init(int nM_, int nN_, int G_, int c_) { nM = nM_; nN = nN_; nwg = nM * nN; G = G_; c = c_; }
    __device__ __forceinline__ bool next(int i, int& pm, int& pn) const {
        const long L = (long)i * G + c; if (L >= nwg) return false;
        int wgid = (int)L; { const int q = nwg / NXCD, r = nwg % NXCD, xcd = wgid % NXCD, off = wgid / NXCD; wgid = (xcd < r ? xcd * (q + 1) : r * (q + 1) + (xcd - r) * q) + off; }
        const int nig = WGM * nN, gid = wgid / nig, fm = gid * WGM, gsz = (nM - fm) < WGM ? (nM - fm) : WGM;
        pm = fm + ((wgid % nig) % gsz); pn = (wgid % nig) / gsz; return true;
    }
};
struct PlainSched {
    TileOrder o; const char* A; const char* B; size_t tsA, tsB; int poolmode;
    __device__ __forceinline__ bool next(int i, Unit& u) const {
        if (!o.next(i, u.pm, u.pn)) return false;
        u.A = A + (size_t)u.pm * tsA + (poolmode ? (size_t)(u.pn >> 1) * 1024 : 0); u.B = B + (size_t)u.pn * tsB; return true;
    }
};

template <int ACT  > struct EpiBf16 {
    static constexpr bool PERM = true;
    bf16_t* O; int ldc;
    __device__ __forceinline__ void operator()(const f32x4 (&acc)[2][2][4][2], const Unit& u, int wr, int wc, int fr, int fq) const {
        const int lane = lane_asm(); fr = lane & 15; fq = lane >> 4; (void)lane;
        const int row0 = u.pm * BM + wr * 64 + fr, col0 = u.pn * BM + wc * 32 + 8 * fq;
#pragma unroll
        for (int ai = 0; ai < 2; ++ai)
#pragma unroll
            for (int m = 0; m < 4; ++m) { bf16_t* rowp = O + (size_t)(row0 + ai * HALF + m * 16) * ldc + col0;
#pragma unroll
                for (int bj = 0; bj < 2; ++bj) { f32x4 v0 = acc[ai][bj][m][0], v1 = acc[ai][bj][m][1];
                    if (ACT == 2) {
#pragma unroll
                        for (int j = 0; j < 4; ++j) { v0[j] = sigmoidf_(v0[j]); v1[j] = sigmoidf_(v1[j]); } }
                    u32x4 w; w.x = cvt_pk_bf16(v0[0], v0[1]); w.y = cvt_pk_bf16(v0[2], v0[3]); w.z = cvt_pk_bf16(v1[0], v1[1]); w.w = cvt_pk_bf16(v1[2], v1[3]);
                    *(u32x4*)(rowp + bj * HALF) = w; } }
    }
};
struct EpiPleMul {
    static constexpr bool PERM = true;
    bf16_t* O; int ldc;
    __device__ __forceinline__ void operator()(const f32x4 (&acc)[2][2][4][2], const Unit& u, int wr, int wc, int fr, int fq) const {
        const int lane = lane_asm(); fr = lane & 15; fq = lane >> 4; (void)lane;
        const int row0 = u.pm * BM + wr * 64 + fr, col0 = u.pn * BM + wc * 32 + 8 * fq;
#pragma unroll
        for (int ai = 0; ai < 2; ++ai)
#pragma unroll
            for (int m = 0; m < 4; ++m) { bf16_t* rowp = O + (size_t)(row0 + ai * HALF + m * 16) * ldc + col0;
#pragma unroll
                for (int bj = 0; bj < 2; ++bj) { const f32x4 v0 = acc[ai][bj][m][0], v1 = acc[ai][bj][m][1];
                    const u32x4 g = *(const u32x4*)(rowp + bj * HALF);
                    u32x4 w; w.x = cvt_pk_bf16(v0[0] * lo16(g.x), v0[1] * hi16(g.x)); w.y = cvt_pk_bf16(v0[2] * lo16(g.y), v0[3] * hi16(g.y));
                    w.z = cvt_pk_bf16(v1[0] * lo16(g.z), v1[1] * hi16(g.z)); w.w = cvt_pk_bf16(v1[2] * lo16(g.w), v1[3] * hi16(g.w));
                    *(u32x4*)(rowp + bj * HALF) = w; }
                asm volatile("" ::: "memory"); }
    }
};
struct EpiResid {
    static constexpr bool PERM = false;
    const float* src; float* dst; const float* cscale; const bf16_t* ple; const bf16_t* ple2;
    const float* st; const float* lg; const float* lb;
    __device__ __forceinline__ void operator()(const f32x4 (&acc)[2][2][4][2], const Unit& u, int wr, int wc, int fr, int fq) const {
        const int lane = lane_asm(); fr = lane & 15; fq = lane >> 4; (void)lane;
        const int row0 = u.pm * BM + wr * 64 + fr, col0 = u.pn * BM + wc * 32 + 4 * fq;
#pragma unroll
        for (int ai = 0; ai < 2; ++ai)
#pragma unroll
            for (int mp = 0; mp < 2; ++mp) {
                f32x4 sv[2][2][2]; u32x2 pv[2][2][2], qv[2][2][2]; f32x2 sr[2];
#pragma unroll
                for (int mm = 0; mm < 2; ++mm) { const int m = 2 * mp + mm; const size_t rr = (size_t)(row0 + ai * HALF + m * 16), off = rr * D + col0;
                    sr[mm] = (f32x2){0.f, 1.f}; if (st) sr[mm] = *(const f32x2*)(st + 2 * rr);
#pragma unroll
                    for (int bj = 0; bj < 2; ++bj)
#pragma unroll
                        for (int n = 0; n < 2; ++n) { const size_t o2 = off + bj * HALF + n * 16; sv[mm][bj][n] = *(const f32x4*)(src + o2);
                            if (ple) { pv[mm][bj][n] = *(const u32x2*)(ple + o2); qv[mm][bj][n] = *(const u32x2*)(ple2 + o2); } } }
#pragma unroll
                for (int mm = 0; mm < 2; ++mm) { const int m = 2 * mp + mm; const size_t off = (size_t)(row0 + ai * HALF + m * 16) * D + col0;
#pragma unroll
                    for (int bj = 0; bj < 2; ++bj)
#pragma unroll
                        for (int n = 0; n < 2; ++n) { const size_t o2 = off + bj * HALF + n * 16; f32x4 a = acc[ai][bj][m][n];
                            if (cscale) a = a * *(const f32x4*)(cscale + col0 + bj * HALF + n * 16);
                            if (ple) { const u32x2 pw = pv[mm][bj][n], qw = qv[mm][bj][n];
                                a = a + (f32x4){lo16(pw.x) * lo16(qw.x), hi16(pw.x) * hi16(qw.x), lo16(pw.y) * lo16(qw.y), hi16(pw.y) * hi16(qw.y)}; }
                            f32x4 sx = sv[mm][bj][n];
                            if (st) sx = (sx - sr[mm].x) * sr[mm].y * *(const f32x4*)(lg + col0 + bj * HALF + n * 16) + *(const f32x4*)(lb + col0 + bj * HALF + n * 16);
                            *(f32x4*)(dst + o2) = sx * ALPHA + a; } }
                asm volatile("" ::: "memory");
            }
    }
};

template <class Epi, class Sched>
__device__ __forceinline__ void gemm_phase(LAS unsigned char* lds, const int K, const int lda, const int ldb, const Sched& S, const Epi& E, int widk) {
    const int tid = opaque_tid(widk), wid = __builtin_amdgcn_readfirstlane(tid >> 6), lane = tid & 63, wr = wid >> 2, wc = wid & 3, fr = lane & 15, fq = lane >> 4;
    const int nt = K / BK;
    unsigned voffA[2], voffB[2];
#pragma unroll
    for (int i = 0; i < 2; ++i) { int R, C; stage_rc(tid * 16 + i * 8192, R, C); const int Rb = Epi::PERM ? ((R & ~31) + perm32(R & 31)) : R;
        voffA[i] = (unsigned)(R * lda + C) * 2u; voffB[i] = (unsigned)(Rb * ldb + C) * 2u; }
    const size_t kstep = (size_t)(BK * 2);
    const size_t hsA = (size_t)HALF * lda * 2, hsB = (size_t)HALF * ldb * 2;
    const unsigned ldsw = (unsigned)wid * 1024u;
    const int aoff = lds_byte(wr * 64 + fr, fq * 8), boff = lds_byte(wc * 32 + fr, fq * 8);
#define PG8_SA(b, h) (((b) * 2 + (h)) * HTB)
#define PG8_SB(b, h) ((4 + (b) * 2 + (h)) * HTB)
#define PG8_STAGE(bufoff, gbase, voff) do { _Pragma("unroll") for (int _i = 0; _i < 2; ++_i) \
        __builtin_amdgcn_global_load_lds((const unsigned*)((const char*)(gbase) + (voff)[_i]), (LAS unsigned*)(lds + (bufoff) + ldsw + _i * 8192), 16, 0, 0); } while (0)
#define PG8_LDA(dst, b, h) do { _Pragma("unroll") for (int m = 0; m < 4; ++m) _Pragma("unroll") for (int k = 0; k < 2; ++k) dst[m][k] = *(const LAS bf16x8*)(lds + PG8_SA(b, h) + aoff + m * 2048 + k * 1024); } while (0)
#define PG8_LDB(dst, b, h) do { _Pragma("unroll") for (int n = 0; n < 2; ++n) _Pragma("unroll") for (int k = 0; k < 2; ++k) dst[n][k] = *(const LAS bf16x8*)(lds + PG8_SB(b, h) + boff + n * 2048 + k * 1024); } while (0)
#define PG8_MMA(ai, bj, At, Bt) do { __builtin_amdgcn_s_setprio(1); _Pragma("unroll") for (int m = 0; m < 4; ++m) _Pragma("unroll") for (int n = 0; n < 2; ++n) _Pragma("unroll") for (int k = 0; k < 2; ++k) \
        acc[ai][bj][m][n] = __builtin_amdgcn_mfma_f32_16x16x32_bf16(Bt[n][k], At[m][k], acc[ai][bj][m][n], 0, 0, 0); __builtin_amdgcn_s_setprio(0); } while (0)
#define PG8_WAIT_V(n) asm volatile("s_waitcnt vmcnt(" #n ")" ::: "memory")
#define PG8_WAIT_L(n) asm volatile("s_waitcnt lgkmcnt(" #n ")" ::: "memory")
#define PG8_BAR __builtin_amdgcn_s_barrier()
#define PG8_SCHED __builtin_amdgcn_sched_barrier(0)
    Unit cur, nxt; int ui = 0;
    if (!S.next(0, cur)) return;
    f32x4 acc[2][2][4][2];
#pragma unroll
    for (int a = 0; a < 2; ++a)
#pragma unroll
        for (int b = 0; b < 2; ++b)
#pragma unroll
            for (int m = 0; m < 4; ++m)
#pragma unroll
                for (int n = 0; n < 2; ++n) acc[a][b][m][n] = (f32x4){0.f, 0.f, 0.f, 0.f};
    bf16x8 At[4][2], B0[2][2], B1[2][2];
    const char* cA = cur.A; const char* cB = cur.B;
    PG8_STAGE(PG8_SB(0, 0), cB, voffB); PG8_STAGE(PG8_SB(0, 1), cB + hsB, voffB); PG8_STAGE(PG8_SA(0, 0), cA, voffA); PG8_STAGE(PG8_SA(0, 1), cA + hsA, voffA);
    if (wr == 1) PG8_BAR;
    PG8_WAIT_V(2); PG8_BAR;
    PG8_STAGE(PG8_SB(1, 0), cB + kstep, voffB); PG8_STAGE(PG8_SA(1, 0), cA + kstep, voffA); PG8_STAGE(PG8_SB(1, 1), cB + hsB + kstep, voffB);
    PG8_WAIT_V(6); PG8_BAR;
    for (;;) {
        const bool has_next = S.next(ui + 1, nxt);
        const char* nA = has_next ? nxt.A : cA; const char* nB = has_next ? nxt.B : cB;
        for (int t = 0; t < nt; t += 2) {
            const bool last = (t == nt - 2);
            const char* a1 = cA + (size_t)(t + 1) * kstep;
            const char* a2 = last ? nA : cA + (size_t)(t + 2) * kstep; const char* b2 = last ? nB : cB + (size_t)(t + 2) * kstep;
            const char* a3 = a2 + kstep; const char* b3 = b2 + kstep;
            PG8_LDB(B0, 0, 0); PG8_LDB(B1, 0, 1); PG8_SCHED; PG8_LDA(At, 0, 0); PG8_STAGE(PG8_SA(1, 1), a1 + hsA, voffA);
            PG8_WAIT_V(8); PG8_WAIT_L(0); PG8_BAR; PG8_MMA(0, 0, At, B0); PG8_MMA(0, 1, At, B1); PG8_BAR; PG8_SCHED;
            PG8_LDA(At, 0, 1); PG8_STAGE(PG8_SB(0, 0), b2, voffB); PG8_STAGE(PG8_SB(0, 1), b2 + hsB, voffB); PG8_STAGE(PG8_SA(0, 0), a2, voffA);
            PG8_WAIT_V(8); PG8_WAIT_L(0); PG8_BAR; PG8_MMA(1, 0, At, B0); PG8_MMA(1, 1, At, B1); PG8_BAR; PG8_SCHED;
            PG8_LDB(B0, 1, 0); PG8_LDB(B1, 1, 1); PG8_SCHED; PG8_LDA(At, 1, 0); PG8_STAGE(PG8_SA(0, 1), a2 + hsA, voffA);
            PG8_WAIT_V(8); PG8_WAIT_L(0); PG8_BAR; PG8_MMA(0, 0, At, B0); PG8_MMA(0, 1, At, B1); PG8_BAR; PG8_SCHED;
            PG8_LDA(At, 1, 1); PG8_STAGE(PG8_SB(1, 0), b3, voffB); PG8_STAGE(PG8_SB(1, 1), b3 + hsB, voffB); PG8_STAGE(PG8_SA(1, 0), a3, voffA);
            PG8_WAIT_V(8); PG8_WAIT_L(0); PG8_BAR; PG8_MMA(1, 0, At, B0); PG8_MMA(1, 1, At, B1); PG8_BAR; PG8_SCHED;
        }
        if (wr == 0) PG8_BAR;
        E(acc, cur, wr, wc, fr, fq);
        if (!has_next) break;
#pragma unroll
        for (int a = 0; a < 2; ++a)
#pragma unroll
            for (int b = 0; b < 2; ++b)
#pragma unroll
                for (int m = 0; m < 4; ++m)
#pragma unroll
                    for (int n = 0; n < 2; ++n) acc[a][b][m][n] = (f32x4){0.f, 0.f, 0.f, 0.f};
        cur = nxt; cA = nA; cB = nB; ++ui;
        if (wr == 1) PG8_BAR;
    }
    PG8_WAIT_V(0);
    PG8_BAR;
#undef PG8_SA
#undef PG8_SB
#undef PG8_STAGE
#undef PG8_LDA
#undef PG8_LDB
#undef PG8_MMA
#undef PG8_WAIT_V
#undef PG8_WAIT_L
#undef PG8_BAR
#undef PG8_SCHED
}
}

struct GlaScoreSched {
    int G, c; const bf16_t* AP; const bf16_t* KT;
    __device__ __forceinline__ bool next(int i, pg8::Unit& u) const {
        const int idx = c + i * G; if (idx >= 256) return false;
        const int bh = idx >> 5, sc = idx & 31, b = bh >> 2, h = bh & 3; const size_t tok0 = (size_t)b * SEQ + sc * 256;
        u.pm = idx; u.pn = 0; u.A = (const char*)(AP + tok0 * 2048 + h * 512); u.B = (const char*)(KT + tok0 * 1024 + h * 256); return true;
    }
};
struct GlaScoreEpi {
    static constexpr bool PERM = true;
    bf16_t* AP;
    __device__ __forceinline__ void operator()(const f32x4 (&acc)[2][2][4][2], const pg8::Unit& u, int wr, int wc, int fr, int fq) const {
        const int lane = lane_asm(); fr = lane & 15; fq = lane >> 4; (void)lane;
        const int idx = u.pm, bh = idx >> 5, sc = idx & 31, b = bh >> 2, h = bh & 3; const size_t tok0 = (size_t)b * SEQ + sc * 256;
#pragma unroll
        for (int ai = 0; ai < 2; ++ai)
#pragma unroll
            for (int m = 0; m < 4; ++m) { const int r = ai * 128 + wr * 64 + m * 16 + fr; bf16_t* rowp = AP + (tok0 + r) * 2048 + h * 512 + 256;
#pragma unroll
                for (int bj = 0; bj < 2; ++bj) { const int c0 = bj * 128 + wc * 32 + 8 * fq; f32x4 v0 = acc[ai][bj][m][0], v1 = acc[ai][bj][m][1];
#pragma unroll
                    for (int j = 0; j < 4; ++j) { if (c0 + j > r) v0[j] = 0.f; if (c0 + 4 + j > r) v1[j] = 0.f; }
                    u32x4 w; w.x = cvt_pk_bf16(v0[0], v0[1]); w.y = cvt_pk_bf16(v0[2], v0[3]); w.z = cvt_pk_bf16(v1[0], v1[1]); w.w = cvt_pk_bf16(v1[2], v1[3]);
                    *(u32x4*)(rowp + c0) = w; } }
    }
};
struct GlaUSched {
    int G, c; const bf16_t* BP; const bf16_t* KTT;
    __device__ __forceinline__ bool next(int i, pg8::Unit& u) const {
        const int idx = c + i * G; if (idx >= 512) return false;
        const int bhsc = idx >> 1, mt = idx & 1, bh = bhsc >> 5, sc = bhsc & 31;
        u.pm = idx; u.pn = 0; u.A = (const char*)(BP + ((size_t)bhsc * 512 + mt * 256) * 512 + 256); u.B = (const char*)(KTT + (size_t)bh * 256 * SEQ + sc * 256); return true;
    }
};
struct GlaUEpi {
    static constexpr bool PERM = false;
    float* UT; const float* DL;
    __device__ __forceinline__ void operator()(const f32x4 (&acc)[2][2][4][2], const pg8::Unit& u, int wr, int wc, int fr, int fq) const {
        const int lane = lane_asm(); fr = lane & 15; fq = lane >> 4; (void)lane;
        const int idx = u.pm, bhsc = idx >> 1, mt = idx & 1; const float* dl = DL + (size_t)bhsc * 256;
#pragma unroll
        for (int ai = 0; ai < 2; ++ai)
#pragma unroll
            for (int m = 0; m < 4; ++m) { const int r = mt * 256 + ai * 128 + wr * 64 + m * 16 + fr; float* rowp = UT + ((size_t)bhsc * 512 + r) * 256;
#pragma unroll
                for (int bj = 0; bj < 2; ++bj)
#pragma unroll
                    for (int n = 0; n < 2; ++n) { const int c0 = bj * 128 + wc * 32 + n * 16 + 4 * fq; *(f32x4*)(rowp + c0) = acc[ai][bj][m][n] * *(const f32x4*)(dl + c0); } }
    }
};
struct GlaOSched {
    int G, c; const bf16_t* AP; const bf16_t* BP;
    __device__ __forceinline__ bool next(int i, pg8::Unit& u) const {
        const int idx = c + i * G; if (idx >= 512) return false;
        const int bhsc = idx >> 1, nt = idx & 1, bh = bhsc >> 5, sc = bhsc & 31, b = bh >> 2, h = bh & 3; const size_t tok0 = (size_t)b * SEQ + sc * 256;
        u.pm = idx; u.pn = 0; u.A = (const char*)(AP + tok0 * 2048 + h * 512); u.B = (const char*)(BP + ((size_t)bhsc * 512 + nt * 256) * 512); return true;
    }
};
struct GlaOEpi {
    static constexpr bool PERM = true;
    bf16_t* O; float* SSQ;
    __device__ __forceinline__ void operator()(const f32x4 (&acc)[2][2][4][2], const pg8::Unit& u, int wr, int wc, int fr, int fq) const {
        const int lane = lane_asm(); fr = lane & 15; fq = lane >> 4; (void)lane;
        const int idx = u.pm, bhsc = idx >> 1, nt = idx & 1, bh = bhsc >> 5, sc = bhsc & 31, b = bh >> 2, h = bh & 3; const size_t tok0 = (size_t)b * SEQ + sc * 256;
#pragma unroll
        for (int ai = 0; ai < 2; ++ai)
#pragma unroll
            for (int m = 0; m < 4; ++m) { const int r = ai * 128 + wr * 64 + m * 16 + fr; bf16_t* rowp = O + (tok0 + r) * 2048 + h * 512 + nt * 256; float ss = 0.f;
#pragma unroll
                for (int bj = 0; bj < 2; ++bj) { const int c0 = bj * 128 + wc * 32 + 8 * fq; const f32x4 v0 = acc[ai][bj][m][0], v1 = acc[ai][bj][m][1];
                    ss += (v0[0] * v0[0] + v0[1] * v0[1]) + (v0[2] * v0[2] + v0[3] * v0[3]) + (v1[0] * v1[0] + v1[1] * v1[1]) + (v1[2] * v1[2] + v1[3] * v1[3]);
                    u32x4 w; w.x = cvt_pk_bf16(v0[0], v0[1]); w.y = cvt_pk_bf16(v0[2], v0[3]); w.z = cvt_pk_bf16(v1[0], v1[1]); w.w = cvt_pk_bf16(v1[2], v1[3]);
                    *(u32x4*)(rowp + c0) = w; }
                ss += shx(ss, 16, lane); ss += shx(ss, 32, lane);
                if (fq == 0) atomicAdd(SSQ + (tok0 + r) * 4 + h, ss); }
    }
};

struct Params {
    const float *x, *p, *gla_w_in, *gla_w_a1, *gla_w_a2, *gla_b_a, *gla_norm_g, *gla_w_o, *pool_w, *pool_scale, *dsa_w_in, *dsa_kidx_g, *dsa_kidx_b, *dsa_w_o,
        *ln_mix_g, *ln_mix_b, *ffn_w_up, *ffn_conv_w, *ffn_conv_b, *ffn_w_down, *ple_gate_w, *ple_proj_w, *ln_ffn_g, *ln_ffn_b;
    float* out; unsigned char* ws;
};

__device__ __forceinline__ void transpose_item(const float* W, int K, int N, bf16_t* WT, int row_off, LAS unsigned* scr, int item, int lane) {
    const int nblk = (N + 63) / 64, kb = item / nblk, nb = item % nblk, k0 = 64 * kb, n0 = 64 * nb;
    const int nn = (lane & 15) * 4; const bool nok = (n0 + nn) < N;
#pragma unroll
    for (int i = 0; i < 8; ++i) { const int kk = 8 * i + 2 * (lane >> 4);
        f32x4 v0 = {0.f, 0.f, 0.f, 0.f}, v1 = v0;
        if (nok) { v0 = *(const f32x4*)(W + (size_t)(k0 + kk) * N + n0 + nn); v1 = *(const f32x4*)(W + (size_t)(k0 + kk + 1) * N + n0 + nn); }
#pragma unroll
        for (int j = 0; j < 4; ++j) scr[((nn + j) * 72 + kk) >> 1] = cvt_pk_bf16(v0[j], v1[j]); }
    asm volatile("s_waitcnt lgkmcnt(0)" ::: "memory");
#pragma unroll
    for (int j = 0; j < 8; ++j) { const int n = (lane >> 3) + 8 * j, ch = lane & 7;
        const u32x4 o = *(const LAS u32x4*)(scr + ((n * 72 + ch * 8) >> 1));
        *(u32x4*)(WT + (size_t)(row_off + n0 + n) * K + k0 + 8 * ch) = o; }
    asm volatile("s_waitcnt lgkmcnt(0)" ::: "memory");
}
#define TJOB(W, K, N, DST, ROWOFF) do { const int _ni = ((K) / 64) * (((N) + 63) / 64); for (int _it = gw; _it < _ni; _it += NGW) transpose_item((W), (K), (N), (DST), (ROWOFF), scr, _it, lane); } while (0)

__device__ __forceinline__ void row_pass(const float* src, const float* __restrict__ g, const float* __restrict__ b, float* dst32, bf16_t* __restrict__ dstb, float* __restrict__ stats, int widk) {
    IDX_SETUP
    f32x4 vn[8];
    if (gw < T) { const f32x4* xr = (const f32x4*)(src + (size_t)gw * D) + lane;
#pragma unroll
        for (int j = 0; j < 8; ++j) vn[j] = xr[64 * j]; }
    for (int r = gw; r < T; r += NGW) {
        f32x4 v[8];
#pragma unroll
        for (int j = 0; j < 8; ++j) v[j] = vn[j];
        if (r + NGW < T) { const f32x4* xr = (const f32x4*)(src + (size_t)(r + NGW) * D) + lane;
#pragma unroll
            for (int j = 0; j < 8; ++j) vn[j] = xr[64 * j]; }
        if (g) {
            float s = 0.f;
#pragma unroll
            for (int j = 0; j < 8; ++j) s += (v[j].x + v[j].y) + (v[j].z + v[j].w);
            const float mean = wave_sum(s, lane) * (1.f / D); float s2 = 0.f;
#pragma unroll
            for (int j = 0; j < 8; ++j) { v[j] = v[j] - mean; s2 += (v[j].x * v[j].x + v[j].y * v[j].y) + (v[j].z * v[j].z + v[j].w * v[j].w); }
            const float rstd = 1.0f / sqrtf(wave_sum(s2, lane) * (1.f / D) + LN_EPS);
            if (stats && lane == 0) *(f32x2*)(stats + 2 * (size_t)r) = (f32x2){mean, rstd};
#pragma unroll
            for (int j = 0; j < 8; ++j) { const f32x4 gg = ((const f32x4*)g)[lane + 64 * j], bb = ((const f32x4*)b)[lane + 64 * j]; v[j] = v[j] * rstd * gg + bb; }
        }
        if (dst32) { f32x4* o = (f32x4*)(dst32 + (size_t)r * D) + lane;
#pragma unroll
            for (int j = 0; j < 8; ++j) o[64 * j] = v[j]; }
        if (dstb) { u32x2* o = (u32x2*)(dstb + (size_t)r * D) + lane;
#pragma unroll
            for (int j = 0; j < 8; ++j) { u32x2 w; w.x = cvt_pk_bf16(v[j].x, v[j].y); w.y = cvt_pk_bf16(v[j].z, v[j].w); o[64 * j] = w; } }
    }
}

__device__ __forceinline__ void xa_pass(const bf16_t* srcb, const float* wa1, float* xa, int widk) {
    IDX_SETUP
    for (int r0 = gw * 4; r0 < T; r0 += NGW * 4) {
        f32x4 acc[4][4];
#pragma unroll
        for (int rr = 0; rr < 4; ++rr)
#pragma unroll
            for (int qd = 0; qd < 4; ++qd) acc[rr][qd] = (f32x4){0.f, 0.f, 0.f, 0.f};
#pragma unroll 2
        for (int i = 0; i < 32; ++i) { const int cc = lane + 64 * i; const f32x4* w = (const f32x4*)(wa1 + (size_t)cc * 16);
            const f32x4 w0 = w[0], w1 = w[1], w2 = w[2], w3 = w[3];
#pragma unroll
            for (int rr = 0; rr < 4; ++rr) { const float xv = bf2f(srcb[(size_t)(r0 + rr) * D + cc]);
                acc[rr][0] += w0 * xv; acc[rr][1] += w1 * xv; acc[rr][2] += w2 * xv; acc[rr][3] += w3 * xv; } }
        const bool b5 = (lane & 32) != 0, b4 = (lane & 16) != 0, b3 = (lane & 8) != 0, b2 = (lane & 4) != 0;
        const int idx = (b5 ? 8 : 0) + (b4 ? 4 : 0) + (b3 ? 2 : 0) + (b2 ? 1 : 0);
#pragma unroll
        for (int rr = 0; rr < 4; ++rr) {
            float k8[8], k4[4], k2[2];
#pragma unroll
            for (int j = 0; j < 8; ++j) { const float lo = acc[rr][j >> 2][j & 3], hi = acc[rr][2 + (j >> 2)][j & 3]; k8[j] = (b5 ? hi : lo) + shx(b5 ? lo : hi, 32, lane); }
#pragma unroll
            for (int j = 0; j < 4; ++j) k4[j] = (b4 ? k8[j + 4] : k8[j]) + shx(b4 ? k8[j] : k8[j + 4], 16, lane);
#pragma unroll
            for (int j = 0; j < 2; ++j) k2[j] = (b3 ? k4[j + 2] : k4[j]) + shx(b3 ? k4[j] : k4[j + 2], 8, lane);
            float k1 = (b2 ? k2[1] : k2[0]) + shx(b2 ? k2[0] : k2[1], 4, lane);
            k1 += shx(k1, 2, lane); k1 += shx(k1, 1, lane);
            if ((lane & 3) == 0) xa[(size_t)(r0 + rr) * 16 + idx] = k1;
        }
    }
}
__device__ __forceinline__ void conv_pass(const bf16_t* __restrict__ H, const float* __restrict__ cw, const float* __restrict__ cb, bf16_t* __restrict__ ACT, int widk) {
    IDX_SETUP
    constexpr int NCG = DFF / 8, NSEG = T / 32;
    for (int idx = gt; idx < NCG * NSEG; idx += NT) {
        const int cgi = idx % NCG, sg = idx / NCG, t0 = sg * 32, c0 = cgi * 8;
        f32x4 wg[3][2], wu[3][2], bg[2], bu[2];
#pragma unroll
        for (int j = 0; j < 3; ++j)
#pragma unroll
            for (int q = 0; q < 2; ++q) { wg[j][q] = *(const f32x4*)(cw + (size_t)j * NUP + c0 + 4 * q); wu[j][q] = *(const f32x4*)(cw + (size_t)j * NUP + DFF + c0 + 4 * q); }
#pragma unroll
        for (int q = 0; q < 2; ++q) { bg[q] = *(const f32x4*)(cb + c0 + 4 * q); bu[q] = *(const f32x4*)(cb + DFF + c0 + 4 * q); }
        f32x4 g2[2], g1[2], u2[2], u1[2];
        if ((t0 & (SEQ - 1)) == 0) {
#pragma unroll
            for (int q = 0; q < 2; ++q) { g2[q] = (f32x4){0.f, 0.f, 0.f, 0.f}; g1[q] = g2[q]; u2[q] = g2[q]; u1[q] = g2[q]; }
        } else {
            const u32x4 a = *(const u32x4*)(H + (size_t)(t0 - 2) * NUP + c0), b = *(const u32x4*)(H + (size_t)(t0 - 1) * NUP + c0);
            const u32x4 c = *(const u32x4*)(H + (size_t)(t0 - 2) * NUP + DFF + c0), d = *(const u32x4*)(H + (size_t)(t0 - 1) * NUP + DFF + c0);
            g2[0] = (f32x4){lo16(a.x), hi16(a.x), lo16(a.y), hi16(a.y)}; g2[1] = (f32x4){lo16(a.z), hi16(a.z), lo16(a.w), hi16(a.w)};
            g1[0] = (f32x4){lo16(b.x), hi16(b.x), lo16(b.y), hi16(b.y)}; g1[1] = (f32x4){lo16(b.z), hi16(b.z), lo16(b.w), hi16(b.w)};
            u2[0] = (f32x4){lo16(c.x), hi16(c.x), lo16(c.y), hi16(c.y)}; u2[1] = (f32x4){lo16(c.z), hi16(c.z), lo16(c.w), hi16(c.w)};
            u1[0] = (f32x4){lo16(d.x), hi16(d.x), lo16(d.y), hi16(d.y)}; u1[1] = (f32x4){lo16(d.z), hi16(d.z), lo16(d.w), hi16(d.w)};
        }
#pragma unroll 4
        for (int t = 0; t < 32; ++t) {
            const u32x4 a = *(const u32x4*)(H + (size_t)(t0 + t) * NUP + c0), c = *(const u32x4*)(H + (size_t)(t0 + t) * NUP + DFF + c0);
            f32x4 g0[2], u0[2];
            g0[0] = (f32x4){lo16(a.x), hi16(a.x), lo16(a.y), hi16(a.y)}; g0[1] = (f32x4){lo16(a.z), hi16(a.z), lo16(a.w), hi16(a.w)};
            u0[0] = (f32x4){lo16(c.x), hi16(c.x), lo16(c.y), hi16(c.y)}; u0[1] = (f32x4){lo16(c.z), hi16(c.z), lo16(c.w), hi16(c.w)};
            unsigned ow[4];
#pragma unroll
            for (int q = 0; q < 2; ++q) {
                const f32x4 hg = bg[q] + wg[0][q] * g2[q] + wg[1][q] * g1[q] + wg[2][q] * g0[q];
                const f32x4 hu = bu[q] + wu[0][q] * u2[q] + wu[1][q] * u1[q] + wu[2][q] * u0[q];
                const f32x2 ga = gelu_pk((f32x2){hg[0], hg[1]}), gb = gelu_pk((f32x2){hg[2], hg[3]});
                ow[2 * q] = cvt_pk_bf16(ga.x * hu[0], ga.y * hu[1]); ow[2 * q + 1] = cvt_pk_bf16(gb.x * hu[2], gb.y * hu[3]);
                g2[q] = g1[q]; g1[q] = g0[q]; u2[q] = u1[q]; u1[q] = u0[q];
            }
            *(u32x4*)(ACT + (size_t)(t0 + t) * DFF + c0) = (u32x4){ow[0], ow[1], ow[2], ow[3]};
        }
    }
}

__device__ __forceinline__ void ple_mul(bf16_t* SG, const bf16_t* PP, int widk) {
    IDX_SETUP
    for (int idx = gt; idx < T * (D / 8); idx += NT) {
        const u32x4 a = ((const u32x4*)SG)[idx], b = ((const u32x4*)PP)[idx];
        u32x4 w; w.x = cvt_pk_bf16(lo16(a.x) * lo16(b.x), hi16(a.x) * hi16(b.x)); w.y = cvt_pk_bf16(lo16(a.y) * lo16(b.y), hi16(a.y) * hi16(b.y));
        w.z = cvt_pk_bf16(lo16(a.z) * lo16(b.z), hi16(a.z) * hi16(b.z)); w.w = cvt_pk_bf16(lo16(a.w) * lo16(b.w), hi16(a.w) * hi16(b.w));
        ((u32x4*)SG)[idx] = w;
    }
}
__device__ __forceinline__ void gla_prep(const bf16_t* QKVR, const float* XA, const float* wa2, const float* ba, bf16_t* AP, bf16_t* KT, bf16_t* KTT, float* DL, LAS unsigned char* lds, int widk) {
    IDX_SETUP
    LAS float* tot = (LAS float*)lds;
    for (int it = c; it < 256; it += G) {
        const int h = it & 3, sc = (it >> 2) & 31, b = it >> 7, bh = b * 4 + h, col = h * 256 + 4 * lane;
        f32x4 w2[16];
#pragma unroll
        for (int j = 0; j < 16; ++j) w2[j] = *(const f32x4*)(wa2 + (size_t)j * 1024 + col);
        const f32x4 bav = *(const f32x4*)(ba + col);
        const size_t tokw = (size_t)b * SEQ + sc * 256 + wid * 32;
#define GLA_LA2(t, out) do { const f32x4* xa4 = (const f32x4*)(XA + (t) * 16); const f32x4 a0 = xa4[0], a1 = xa4[1], a2 = xa4[2], a3 = xa4[3]; \
            f32x4 z = bav + w2[0] * a0[0] + w2[1] * a0[1] + w2[2] * a0[2] + w2[3] * a0[3]; z += w2[4] * a1[0] + w2[5] * a1[1] + w2[6] * a1[2] + w2[7] * a1[3]; \
            z += w2[8] * a2[0] + w2[9] * a2[1] + w2[10] * a2[2] + w2[11] * a2[3]; z += w2[12] * a3[0] + w2[13] * a3[1] + w2[14] * a3[2] + w2[15] * a3[3]; \
            _Pragma("unroll") for (int _e = 0; _e < 4; ++_e) (out)[_e] = -0.0625f * __builtin_amdgcn_logf(1.0f + __builtin_amdgcn_exp2f(-z[_e] * 1.44269504f)); } while (0)
        f32x4 sum = {0.f, 0.f, 0.f, 0.f};
#pragma unroll 4
        for (int tt = 0; tt < 32; ++tt) { f32x4 la; GLA_LA2(tokw + tt, la); sum += la; }
        *(LAS f32x4*)(tot + wid * 256 + 4 * lane) = sum;
        __syncthreads();
        f32x4 bs = {0.f, 0.f, 0.f, 0.f}, ball = bs;
#pragma unroll
        for (int w = 0; w < 8; ++w) { const f32x4 tv = *(const LAS f32x4*)(tot + w * 256 + 4 * lane); if (w < wid) bs += tv; ball += tv; }
        for (int tt = 0; tt < 32; tt += 8) {
            unsigned pk[4][4];
#pragma unroll
            for (int e = 0; e < 8; e += 2) {
                f32x4 kt2[2];
#pragma unroll
                for (int e2 = 0; e2 < 2; ++e2) {
                    const size_t t = tokw + tt + e + e2;
                    f32x4 la; GLA_LA2(t, la); bs += la;
                    const u32x2 qw = *(const u32x2*)(QKVR + t * GLA_N + col), kw = *(const u32x2*)(QKVR + t * GLA_N + 1024 + col);
                    const f32x4 qv = {lo16(qw.x), hi16(qw.x), lo16(qw.y), hi16(qw.y)}, kv = {lo16(kw.x), hi16(kw.x), lo16(kw.y), hi16(kw.y)};
                    f32x4 qt, kt;
#pragma unroll
                    for (int j = 0; j < 4; ++j) { qt[j] = qv[j] * 0.0625f * __builtin_amdgcn_exp2f(bs[j]); kt[j] = kv[j] * __builtin_amdgcn_exp2f(fminf(-bs[j], 120.f)); }
                    u32x2 qo, ko; qo.x = cvt_pk_bf16(qt[0], qt[1]); qo.y = cvt_pk_bf16(qt[2], qt[3]); ko.x = cvt_pk_bf16(kt[0], kt[1]); ko.y = cvt_pk_bf16(kt[2], kt[3]);
                    *(u32x2*)(AP + t * 2048 + h * 512 + 4 * lane) = qo;
                    *(u32x2*)(KT + t * 1024 + col) = ko;
                    kt2[e2] = kt;
                }
#pragma unroll
                for (int j = 0; j < 4; ++j) pk[j][e >> 1] = cvt_pk_bf16(kt2[0][j], kt2[1][j]);
            }
#pragma unroll
            for (int j = 0; j < 4; ++j)
                *(u32x4*)(KTT + ((size_t)(bh * 256 + 4 * lane + j) * SEQ + sc * 256 + wid * 32 + tt)) = (u32x4){pk[j][0], pk[j][1], pk[j][2], pk[j][3]};
        }
        if (wid == 0) { f32x4 dl;
#pragma unroll
            for (int j = 0; j < 4; ++j) dl[j] = __builtin_amdgcn_exp2f(ball[j]);
            *(f32x4*)(DL + (size_t)(bh * 32 + sc) * 256 + 4 * lane) = dl; }
#undef GLA_LA2
        __syncthreads();
    }
}
__device__ __forceinline__ void gla_vt(const bf16_t* __restrict__ QKVR, bf16_t* __restrict__ BP, LAS unsigned char* lds, int widk) {
    IDX_SETUP
    LAS bf16_t* scr = (LAS bf16_t*)(lds + wid * 9216);
    for (int it = gw; it < 256 * 32; it += NGW) {
        const int tt = it >> 5, vt = it & 31;
        const size_t tokb = (size_t)tt * 64; const int vcol = vt * 64, h = vcol >> 9, vv0 = vcol & 511;
        const int b = (int)(tokb >> 13), tl = (int)(tokb & (SEQ - 1)), sc = tl >> 8, tloc0 = tl & 255, bhsc = (b * 4 + h) * 32 + sc;
#pragma unroll
        for (int i = 0; i < 8; ++i) { const int row = (lane >> 3) + 8 * i, ch = lane & 7;
            const u32x4 w = *(const u32x4*)(QKVR + (tokb + row) * GLA_N + 2048 + vcol + ch * 8);
            *(LAS u32x4*)(scr + row * 72 + ch * 8) = w; }
        asm volatile("s_waitcnt lgkmcnt(0)" ::: "memory");
#pragma unroll
        for (int cch = 0; cch < 8; ++cch) {
            unsigned short e[8];
#pragma unroll
            for (int j = 0; j < 8; ++j) e[j] = scr[(cch * 8 + j) * 72 + lane];
            u32x4 w; w.x = e[0] | ((unsigned)e[1] << 16); w.y = e[2] | ((unsigned)e[3] << 16); w.z = e[4] | ((unsigned)e[5] << 16); w.w = e[6] | ((unsigned)e[7] << 16);
            *(u32x4*)(BP + ((size_t)bhsc * 512 + vv0 + lane) * 512 + 256 + tloc0 + cch * 8) = w;
        }
        asm volatile("s_waitcnt lgkmcnt(0)" ::: "memory");
    }
}
__device__ __forceinline__ void gla_scan(const float* __restrict__ UT, const float* __restrict__ DL, bf16_t* __restrict__ BP, int widk) {
    IDX_SETUP
    for (int idx = gt; idx < 8 * 512 * 64; idx += NT) {
        const int k4 = idx & 63, v = (idx >> 6) & 511, bh = idx >> 15;
        f32x4 S = {0.f, 0.f, 0.f, 0.f};
#pragma unroll 4
        for (int sc = 0; sc < 32; ++sc) {
            const size_t bhsc = (size_t)bh * 32 + sc;
            u32x2 w; w.x = cvt_pk_bf16(S[0], S[1]); w.y = cvt_pk_bf16(S[2], S[3]);
            *(u32x2*)(BP + (bhsc * 512 + v) * 512 + k4 * 4) = w;
            const f32x4 dl = *(const f32x4*)(DL + bhsc * 256 + k4 * 4), uu = *(const f32x4*)(UT + (bhsc * 512 + v) * 256 + k4 * 4);
            S = dl * S + uu;
        }
    }
}
__device__ __forceinline__ void gla_gate(bf16_t* O, const float* SSQ, const bf16_t* QKVR, const float* ng, int widk) {
    IDX_SETUP
    for (int idx = gt; idx < T * (D / 8); idx += NT) {
        const int t = idx >> 8, c0 = (idx & 255) * 8, h = c0 >> 9;
        const float rs = 1.0f / sqrtf(SSQ[(size_t)t * 4 + h] * (1.f / 512.f) + LN_EPS);
        const u32x4 ov = *(const u32x4*)(O + (size_t)t * D + c0), rv = *(const u32x4*)(QKVR + (size_t)t * GLA_N + 4096 + c0);
        const f32x4 g0 = *(const f32x4*)(ng + c0), g1 = *(const f32x4*)(ng + c0 + 4);
        float o[8] = {lo16(ov.x), hi16(ov.x), lo16(ov.y), hi16(ov.y), lo16(ov.z), hi16(ov.z), lo16(ov.w), hi16(ov.w)};
        float r[8] = {lo16(rv.x), hi16(rv.x), lo16(rv.y), hi16(rv.y), lo16(rv.z), hi16(rv.z), lo16(rv.w), hi16(rv.w)};
        float gg[8] = {g0[0], g0[1], g0[2], g0[3], g1[0], g1[1], g1[2], g1[3]};
        float y[8];
#pragma unroll
        for (int j = 0; j < 8; ++j) { const float on = bf2f((unsigned short)f2bf(o[j] * rs * gg[j])); y[j] = on * (r[j] * sigmoidf_(r[j])); }
        *(u32x4*)(O + (size_t)t * D + c0) = (u32x4){cvt_pk_bf16(y[0], y[1]), cvt_pk_bf16(y[2], y[3]), cvt_pk_bf16(y[4], y[5]), cvt_pk_bf16(y[6], y[7])};
    }
}

__device__ __forceinline__ f32x4 ldbf4(const bf16_t* p) { const u32x2 w = *(const u32x2*)p; return (f32x4){lo16(w.x), hi16(w.x), lo16(w.y), hi16(w.y)}; }
__device__ __forceinline__ void pool_pass(const bf16_t* __restrict__ X, bf16_t* __restrict__ PO, int widk) {
    IDX_SETUP
    for (int idx = gt; idx < 512 * 512; idx += NT) {
        const int cg4 = idx & 511, sg = idx >> 9, c0 = cg4 * 4, w = 2 << (c0 >> 9);
        const int t0 = sg * 32, tb = t0 & (SEQ - 1);
        f32x4 sum = {0.f, 0.f, 0.f, 0.f};
        for (int j = 1; j < w; ++j) if (tb - j >= 0) sum += ldbf4(X + (size_t)(t0 - j) * D + c0);
#pragma unroll 4
        for (int t = 0; t < 32; ++t) {
            const f32x4 xv = ldbf4(X + (size_t)(t0 + t) * D + c0);
            sum += xv;
            const int tp = tb + t; const float inv = 1.0f / (float)((tp + 1) < w ? (tp + 1) : w);
            const f32x4 y = sum * inv - xv;
            u32x2 o; o.x = cvt_pk_bf16(y[0], y[1]); o.y = cvt_pk_bf16(y[2], y[3]);
            *(u32x2*)(PO + (size_t)(t0 + t) * D + c0) = o;
            if (tp - w + 1 >= 0) sum -= ldbf4(X + (size_t)(t0 + t - w + 1) * D + c0);
        }
    }
}

__device__ __forceinline__ void dsa_kin(const bf16_t* DP, const float* g, const float* b, bf16_t* KIN, int widk) {
    IDX_SETUP
    const float gg = g[lane], bb = b[lane];
    for (int r = gw; r < T; r += NGW) {
        const float v = bf2f(DP[(size_t)r * DSA_NP + 4096 + lane]);
        const float mean = wave_sum(v, lane) * (1.f / 64.f), d = v - mean, var = wave_sum(d * d, lane) * (1.f / 64.f);
        KIN[(size_t)r * 64 + lane] = (bf16_t)f2bf(d * (1.0f / sqrtf(var + LN_EPS)) * gg + bb);
    }
}
__device__ __forceinline__ unsigned f2key(float f) { const unsigned u = __float_as_uint(f); return (u & 0x80000000u) ? ~u : (u | 0x80000000u); }
__device__ __forceinline__ void topk_find_digit(const LAS unsigned* hist, int kk, int lane, int& dg, int& nk) {
    const u32x4 h4 = *(const LAS u32x4*)(hist + 4 * lane);
    const int cc = (int)(h4.x + h4.y + h4.z + h4.w);
    int suf = cc;
#pragma unroll
    for (int o = 1; o < 64; o <<= 1) { const int tv = shi(suf, (lane + o) & 63); if (lane + o < 64) suf += tv; }
    const unsigned long long bal = __ballot(suf >= kk);
    const int Lh = bal ? 63 - __builtin_clzll(bal) : 0;
    int above = suf - cc, d, k2;
    if (above + (int)h4.w >= kk) { d = 3; k2 = kk - above; }
    else { above += (int)h4.w;
        if (above + (int)h4.z >= kk) { d = 2; k2 = kk - above; }
        else { above += (int)h4.z;
            if (above + (int)h4.y >= kk) { d = 1; k2 = kk - above; }
            else { above += (int)h4.y; d = 0; k2 = kk - above; } } }
    dg = __builtin_amdgcn_readlane(4 * lane + d, Lh); nk = __builtin_amdgcn_readlane(k2, Lh);
}
__device__ __forceinline__ void dsa_topk(const bf16_t* DP, const bf16_t* KIN, int* SEL, LAS unsigned char* lds, int widk) {
    IDX_SETUP
    LAS float* scs = (LAS float*)lds;
    LAS unsigned* hist = (LAS unsigned*)(lds + 131072);
    LAS unsigned* misc = (LAS unsigned*)(lds + 131072 + 4096);
    LAS float* mmf = (LAS float*)(lds + 131072 + 4096 + 128);
    LAS unsigned* cand = (LAS unsigned*)(lds + 131072 + 4096 + 384);
    const int fr = lane & 15, fq = lane >> 4;
    for (int rr = c; rr < T / 4; rr += G) {
        const int b = rr >> 11; int blk = rr & 2047; { const int cblk = blk & 255, kb = blk >> 8; blk = (kb < 4) ? (cblk + 256 * kb) : (2047 - (cblk + 256 * (kb - 4))); }
        const int tq0 = blk * 4, n = tq0 + 4;
        const size_t tokq = (size_t)b * SEQ + tq0;
        bf16x8 Af[4][2]; float wv[4][4];
#pragma unroll
        for (int q = 0; q < 4; ++q) {
#pragma unroll
            for (int ks = 0; ks < 2; ++ks) Af[q][ks] = *(const bf16x8*)(DP + (tokq + q) * DSA_NP + 3072 + fr * 64 + ks * 32 + fq * 8);
            const u32x2 ww = *(const u32x2*)(DP + (tokq + q) * DSA_NP + 4160 + 4 * fq);
            wv[q][0] = lo16(ww.x) * 0.03125f; wv[q][1] = hi16(ww.x) * 0.03125f; wv[q][2] = lo16(ww.y) * 0.03125f; wv[q][3] = hi16(ww.y) * 0.03125f;
        }
        const int ntile = (n + 15) >> 4;
        {
            bf16x8 Bf[4][2], Bn[4][2];
#define TOPK_LOAD(dst, jbase) do { _Pragma("unroll") for (int u = 0; u < 4; ++u) { int j = (jbase) + 8 * u; j = j < 512 ? j : 511; \
                const bf16_t* kp = KIN + ((size_t)b * SEQ + j * 16 + fr) * 64 + fq * 8; dst[u][0] = *(const bf16x8*)kp; dst[u][1] = *(const bf16x8*)(kp + 32); } } while (0)
            TOPK_LOAD(Bf, wid);
            float rmn = __builtin_inff(), rmx = -__builtin_inff();
            for (int j4 = wid; j4 < ntile; j4 += 32) {
                TOPK_LOAD(Bn, j4 + 32);
#pragma unroll
                for (int u = 0; u < 4; ++u) {
                    const int j = j4 + 8 * u;
                    if (j < ntile) {
                        float myval = 0.f;
#pragma unroll
                        for (int q = 0; q < 4; ++q) {
                            f32x4 a = {0.f, 0.f, 0.f, 0.f};
                            a = __builtin_amdgcn_mfma_f32_16x16x32_bf16(Af[q][0], Bf[u][0], a, 0, 0, 0);
                            a = __builtin_amdgcn_mfma_f32_16x16x32_bf16(Af[q][1], Bf[u][1], a, 0, 0, 0);
                            float val = wv[q][0] * fmaxf(a[0], 0.f) + wv[q][1] * fmaxf(a[1], 0.f) + wv[q][2] * fmaxf(a[2], 0.f) + wv[q][3] * fmaxf(a[3], 0.f);
                            val += shx(val, 16, lane); val += shx(val, 32, lane);
                            if (fq == q) myval = val;
                        }
                        const int s = j * 16 + fr;
                        if (s > tq0 + fq) myval = -__builtin_inff(); else { rmn = fminf(rmn, myval); rmx = fmaxf(rmx, myval); }
                        scs[fq * 8192 + s] = myval;
                    }
                }
#pragma unroll
                for (int u = 0; u < 4; ++u) { Bf[u][0] = Bn[u][0]; Bf[u][1] = Bn[u][1]; }
            }
#undef TOPK_LOAD
#pragma unroll
            for (int o = 1; o < 16; o <<= 1) { rmn = fminf(rmn, shx(rmn, o, lane)); rmx = fmaxf(rmx, shx(rmx, o, lane)); }
            if (fr == 0) { mmf[wid * 8 + fq * 2] = rmn; mmf[wid * 8 + fq * 2 + 1] = rmx; }
            for (int i = tid; i < 1024; i += 512) hist[i] = 0u;
            if (tid < 32) misc[tid] = 0u;
        }
        __syncthreads();
        const int q = wid >> 1, sub = tid & 127, nq = tq0 + q + 1;
        int* selrow = SEL + (tokq + q) * 256;
        LAS float* row = scs + q * 8192;
        if (n <= 256) {
            for (int i = sub; i < 256; i += 128) selrow[i] = (i < nq) ? i : -1;
        } else {
            float mn = mmf[q * 2], mx = mmf[q * 2 + 1];
#pragma unroll
            for (int w = 1; w < 8; ++w) { mn = fminf(mn, mmf[w * 8 + q * 2]); mx = fmaxf(mx, mmf[w * 8 + q * 2 + 1]); }
            const float scale = (mx > mn) ? 255.0f / (mx - mn) : 0.f;
#define DSA_BIN(v) ({ int _b = (int)(((v) - mn) * scale); _b = _b < 0 ? 0 : _b; _b > 255 ? 255 : _b; })
            for (int sb = 0; sb < nq; sb += 512) { const int s4 = sb + 4 * sub;
                if (s4 < nq) { const f32x4 v4 = *(const LAS f32x4*)(row + s4);
#pragma unroll
                    for (int e = 0; e < 4; ++e) if (s4 + e < nq) __hip_atomic_fetch_add(hist + q * 256 + DSA_BIN(v4[e]), 1u, __ATOMIC_RELAXED, __HIP_MEMORY_SCOPE_WORKGROUP); } }
            __syncthreads();
            int bA, kkA; topk_find_digit(hist + q * 256, 256, lane, bA, kkA);
            LAS unsigned* lst = cand + q * 512;
            for (int sb = 0; sb < nq; sb += 512) { const int s4 = sb + 4 * sub; const bool in4 = s4 < nq;
                f32x4 v4 = {0.f, 0.f, 0.f, 0.f}; if (in4) v4 = *(const LAS f32x4*)(row + s4);
#pragma unroll
                for (int e = 0; e < 4; ++e) { const int s = s4 + e; const bool in = s < nq; const float v = v4[e]; const int bin = DSA_BIN(v);
                    const bool gsel = in && bin > bA;
                    const unsigned long long gm = __ballot(gsel);
                    if (gm) { const int leader = __builtin_ctzll(gm); unsigned base = 0u;
                        if (lane == leader) base = __hip_atomic_fetch_add(misc + q * 4 + 2, (unsigned)__builtin_popcountll(gm), __ATOMIC_RELAXED, __HIP_MEMORY_SCOPE_WORKGROUP);
                        base = (unsigned)__builtin_amdgcn_readlane((int)base, leader);
                        const unsigned pos = base + (unsigned)__builtin_popcountll(gm & ((1ull << lane) - 1ull));
                        if (gsel && pos < 256u) selrow[pos] = s; }
                    if (in && bin == bA) { const unsigned cp = __hip_atomic_fetch_add(misc + q * 4 + 3, 1u, __ATOMIC_RELAXED, __HIP_MEMORY_SCOPE_WORKGROUP); if (cp < 256u) { lst[2 * cp] = f2key(v); lst[2 * cp + 1] = (unsigned)s; } } }
            }
            __syncthreads();
            const int nc = (int)misc[q * 4 + 3];
            if (nc <= 256) {
                for (int i = sub; i < nc; i += 128) { const unsigned ki = lst[2 * i], si = lst[2 * i + 1]; int rank = 0;
                    for (int j = 0; j < nc; ++j) { const unsigned kj = lst[2 * j], sj = lst[2 * j + 1]; rank += (kj > ki || (kj == ki && sj < si)) ? 1 : 0; }
                    if (rank < kkA) selrow[256 - kkA + rank] = (int)si; }
            } else if ((wid & 1) == 0) {
                unsigned prefix = 0u, maskb = 0u; int kk = kkA;
#pragma unroll 1
                for (int pass = 0; pass < 4; ++pass) { const int shift = 24 - 8 * pass;
                    for (int i = lane; i < 256; i += 64) hist[q * 256 + i] = 0u;
                    asm volatile("s_waitcnt lgkmcnt(0)" ::: "memory");
                    for (int s = lane; s < nq; s += 64) { const float v = row[s]; if (DSA_BIN(v) == bA) { const unsigned key = f2key(v); if ((key & maskb) == prefix) __hip_atomic_fetch_add(hist + q * 256 + ((key >> shift) & 255u), 1u, __ATOMIC_RELAXED, __HIP_MEMORY_SCOPE_WORKGROUP); } }
                    asm volatile("s_waitcnt lgkmcnt(0)" ::: "memory");
                    int dg, nk; topk_find_digit(hist + q * 256, kk, lane, dg, nk); kk = nk;
                    prefix |= (unsigned)dg << shift; maskb |= 255u << shift; }
                int baseG = 256 - kkA, baseE = 256 - kk; const int endE = 256;
                for (int sb = 0; sb < nq; sb += 64) { const int s = sb + lane; const bool in = s < nq; const float v = in ? row[s] : 0.f; const bool inb = in && DSA_BIN(v) == bA; const unsigned key = f2key(v);
                    const bool g = inb && key > prefix, e = inb && key == prefix;
                    const unsigned long long gm = __ballot(g), em = __ballot(e), lt = (1ull << lane) - 1ull;
                    if (g) { const int pos = baseG + __builtin_popcountll(gm & lt); if (pos < 256) selrow[pos] = s; }
                    if (e) { const int pos = baseE + __builtin_popcountll(em & lt); if (pos < endE) selrow[pos] = s; }
                    baseG += __builtin_popcountll(gm); baseE += __builtin_popcountll(em); }
            }
#undef DSA_BIN
        }
        __syncthreads();
    }
}
__device__ __forceinline__ void dsa_attn(const bf16_t* DP, const int* SEL, bf16_t* O, LAS unsigned char* lds, int widk) {
    IDX_SETUP
    LAS unsigned char* pl = lds + wid * 10240;
    LAS unsigned char* vt = lds + wid * 10240 + 2048;
    const int fr = lane & 15, fq = lane >> 4;
    unsigned tra[8][2];
#pragma unroll
    for (int cb = 0; cb < 8; ++cb)
#pragma unroll
        for (int t = 0; t < 2; ++t) { const unsigned q_ = (unsigned)(fr >> 2), p_ = (unsigned)(fr & 3), row = 8u * (unsigned)fq + 4u * (unsigned)t + q_, ch = 2u * (unsigned)cb + (p_ >> 1);
            tra[cb][t] = (unsigned)(size_t)vt + 256u * row + 16u * (ch ^ (((row & 3u) << 2) | ((row >> 2) & 3u))) + 8u * (p_ & 1u); }
    for (int m = 0;; ++m) {
#ifdef ATTN_BLOCKED_XCD
        const int kk_ = wid + 8 * m; if (kk_ >= 256 || G != 256) { if (G == 256) break; }
        const int pair = c >> 5, t = (c & 31) + 32 * kk_, b = pair >> 2, g = pair & 3;
#else
        const int jdx = c + G * (wid + 8 * m); if (jdx >= T * 4) break;
        const int pair = jdx & 7, t = jdx >> 3, b = pair >> 2, g = pair & 3;
#endif
        const size_t tok = (size_t)b * SEQ + t; const int nvalid = (t + 1) < 256 ? (t + 1) : 256;
        int s0 = SEL[tok * 256 + lane], s1 = SEL[tok * 256 + 64 + lane], s2 = SEL[tok * 256 + 128 + lane], s3 = SEL[tok * 256 + 192 + lane];
        s0 = s0 < 0 ? 0 : s0; s1 = s1 < 0 ? 0 : s1; s2 = s2 < 0 ? 0 : s2; s3 = s3 < 0 ? 0 : s3;
        bf16x8 qf[4];
#pragma unroll
        for (int ks = 0; ks < 4; ++ks) { qf[ks] = (bf16x8){0, 0, 0, 0, 0, 0, 0, 0}; if (fr < 4) qf[ks] = *(const bf16x8*)(DP + tok * DSA_NP + (g * 4 + fr) * 128 + ks * 32 + fq * 8); }
        const bf16_t* kbase = DP + (size_t)b * SEQ * DSA_NP + 2048 + g * 128 + fq * 8;
        f32x4 acc[16];
#pragma unroll
        for (int j = 0; j < 16; ++j) {
            const int sreg = (j < 4) ? s0 : (j < 8) ? s1 : (j < 12) ? s2 : s3;
            const int idx = shi(sreg, (16 * j + fr) & 63);
            const bf16_t* kr = kbase + (size_t)idx * DSA_NP;
            const bf16x8 a0 = *(const bf16x8*)kr, a1 = *(const bf16x8*)(kr + 32), a2 = *(const bf16x8*)(kr + 64), a3 = *(const bf16x8*)(kr + 96);
            f32x4 a = {0.f, 0.f, 0.f, 0.f};
            a = __builtin_amdgcn_mfma_f32_16x16x32_bf16(a0, qf[0], a, 0, 0, 0);
            a = __builtin_amdgcn_mfma_f32_16x16x32_bf16(a1, qf[1], a, 0, 0, 0);
            a = __builtin_amdgcn_mfma_f32_16x16x32_bf16(a2, qf[2], a, 0, 0, 0);
            a = __builtin_amdgcn_mfma_f32_16x16x32_bf16(a3, qf[3], a, 0, 0, 0);
            acc[j] = a;
            if ((j & 7) == 7) asm volatile("" ::: "memory");
        }
        const bf16_t* vbase = DP + (size_t)b * SEQ * DSA_NP + 2560 + g * 128 + fr * 8;
        u32x4 vcur[8], vnxt[8], vnn[8];
#define ATTN_VLOAD(dst, ks) do { const int sreg_ = ((ks) < 2) ? s0 : ((ks) < 4) ? s1 : ((ks) < 6) ? s2 : s3; _Pragma("unroll") for (int i = 0; i < 8; ++i) { \
            const int idx_ = shi(sreg_, 32 * ((ks) & 1) + fq + 4 * i); dst[i] = *(const u32x4*)(vbase + (size_t)idx_ * DSA_NP); } } while (0)
        ATTN_VLOAD(vcur, 0); ATTN_VLOAD(vnxt, 1);
        float mx = -__builtin_inff();
#pragma unroll
        for (int j = 0; j < 16; ++j)
#pragma unroll
            for (int r = 0; r < 4; ++r) { const int slot = 16 * j + 4 * fq + r; const float sv = (slot < nvalid) ? acc[j][r] * 0.08838834764831845f : -__builtin_inff(); acc[j][r] = sv; mx = fmaxf(mx, sv); }
        mx = fmaxf(mx, shx(mx, 16, lane)); mx = fmaxf(mx, shx(mx, 32, lane));
        float sum = 0.f;
#pragma unroll
        for (int j = 0; j < 16; ++j)
#pragma unroll
            for (int r = 0; r < 4; ++r) { const float pv = __expf(acc[j][r] - mx); acc[j][r] = pv; sum += pv; }
        sum += shx(sum, 16, lane); sum += shx(sum, 32, lane);
        const float inv = 1.0f / sum;
        if (fr < 4) {
#pragma unroll
            for (int j = 0; j < 16; ++j) { u32x2 w; w.x = cvt_pk_bf16(acc[j][0] * inv, acc[j][1] * inv); w.y = cvt_pk_bf16(acc[j][2] * inv, acc[j][3] * inv);
                *(LAS u32x2*)(pl + (fr * 256 + 16 * j + 4 * fq) * 2) = w; }
        }
        f32x4 oc[8];
#pragma unroll
        for (int cb = 0; cb < 8; ++cb) oc[cb] = (f32x4){0.f, 0.f, 0.f, 0.f};
#pragma unroll
        for (int ks = 0; ks < 8; ++ks) {
            if (ks < 6) ATTN_VLOAD(vnn, ks + 2);
#pragma unroll
            for (int i = 0; i < 8; ++i) { const unsigned row = (unsigned)(fq + 4 * i), ch = (unsigned)fr;
                *(LAS u32x4*)(vt + 256u * row + 16u * (ch ^ (((row & 3u) << 2) | ((row >> 2) & 3u)))) = vcur[i]; }
            bf16x8 pa = (bf16x8){0, 0, 0, 0, 0, 0, 0, 0};
            asm volatile("s_waitcnt lgkmcnt(0)" ::: "memory");
            if (fr < 4) pa = *(const LAS bf16x8*)(pl + (fr * 256 + 32 * ks + 8 * fq) * 2);
            u32x2 t0[8], t1[8];
#pragma unroll
            for (int cb = 0; cb < 8; ++cb) {
                asm volatile("ds_read_b64_tr_b16 %0, %1" : "=v"(t0[cb]) : "v"(tra[cb][0]) : "memory");
                asm volatile("ds_read_b64_tr_b16 %0, %1" : "=v"(t1[cb]) : "v"(tra[cb][1]) : "memory");
            }
            asm volatile("s_waitcnt lgkmcnt(0)" : "+v"(t0[0]), "+v"(t0[1]), "+v"(t0[2]), "+v"(t0[3]), "+v"(t0[4]), "+v"(t0[5]), "+v"(t0[6]), "+v"(t0[7]),
                                                  "+v"(t1[0]), "+v"(t1[1]), "+v"(t1[2]), "+v"(t1[3]), "+v"(t1[4]), "+v"(t1[5]), "+v"(t1[6]), "+v"(t1[7]), "+v"(pa) :: "memory");
#pragma unroll
            for (int cb = 0; cb < 8; ++cb) { const u32x4 bw = {t0[cb].x, t0[cb].y, t1[cb].x, t1[cb].y};
                oc[cb] = __builtin_amdgcn_mfma_f32_16x16x32_bf16(pa, __builtin_bit_cast(bf16x8, bw), oc[cb], 0, 0, 0); }
#pragma unroll
            for (int i = 0; i < 8; ++i) { vcur[i] = vnxt[i]; vnxt[i] = vnn[i]; }
        }
#undef ATTN_VLOAD
        if (fq == 0) {
            bf16_t* op = O + tok * D + (g * 4) * 128 + fr;
#pragma unroll
            for (int cb = 0; cb < 8; ++cb)
#pragma unroll
                for (int r = 0; r < 4; ++r) op[r * 128 + 16 * cb] = (bf16_t)f2bf(oc[cb][r]);
        }
        asm volatile("s_waitcnt lgkmcnt(0)" ::: "memory");
    }
}


#define XB_TMO      128
#define XB_XCNT(j)  (256  + 64 * (j))
#define XB_XSUB(j)  (1280 + 64 * (j))
#define XB_XGEN(j)  (2304 + 64 * (j))
#define XB_TOP      3328
#define XB_TOPGEN   3392
#define XB_SPIN_CAP (1u << 22)
__device__ __forceinline__ unsigned xb_ld(unsigned* p)              { return __hip_atomic_load(p, __ATOMIC_RELAXED, __HIP_MEMORY_SCOPE_AGENT); }
__device__ __forceinline__ unsigned xb_add(unsigned* p, unsigned v) { return __hip_atomic_fetch_add(p, v, __ATOMIC_RELAXED, __HIP_MEMORY_SCOPE_AGENT); }
__device__ __forceinline__ unsigned xb_xcc_id() { return (unsigned)__builtin_amdgcn_s_getreg((3 << 11) | 20) & 0xFu; }
#define XB_SPIN(cond, bar) do { unsigned _sp = 0; while (cond) { __builtin_amdgcn_s_sleep(1); \
    if ((++_sp & 255u) == 0u) { if (xb_ld(&(bar)[XB_TMO])) break; if (_sp > XB_SPIN_CAP) { atomicAdd(&(bar)[XB_TMO], 1u); break; } } } } while (0)
__device__ __forceinline__ void xcd_barrier_complete(unsigned* bar, unsigned x, unsigned& nloc, unsigned& nx) {
    const unsigned G = gridDim.x;
    unsigned sum, cnt, mine, sp = 0u;
    for (;;) {
        sum = 0u; cnt = 0u; mine = 0u;
#pragma unroll
        for (unsigned j = 0; j < 16; ++j) { const unsigned cc = xb_ld(&bar[XB_XCNT(j)]); sum += cc; cnt += (cc > 0u) ? 1u : 0u; mine = (j == x) ? cc : mine; }
        if (sum == G) break;
        __builtin_amdgcn_s_sleep(1);
        if ((++sp & 255u) == 0u) { if (xb_ld(&bar[XB_TMO])) break; if (sp > XB_SPIN_CAP) { atomicAdd(&bar[XB_TMO], 1u); break; } }
    }
    nloc = mine > 0u ? mine : 1u; nx = cnt > 0u ? cnt : 1u;
}
__device__ __forceinline__ void xcd_barrier(unsigned* bar, volatile LAS unsigned* st, int widk) {
    asm volatile("s_waitcnt vmcnt(0)" ::: "memory");
    __syncthreads();
    if (opaque_tid(widk) == 0) {
        __builtin_amdgcn_s_waitcnt(0);
        const unsigned x = xb_xcc_id();
        unsigned nloc = st[0], nx = st[1];
        if (nloc == 0u) { xcd_barrier_complete(bar, x, nloc, nx); st[0] = nloc; st[1] = nx; }
        const unsigned old = xb_add(&bar[XB_XSUB(x)], 1u);
        const unsigned gen = old / nloc;
        if (old + 1u == (gen + 1u) * nloc) {
            __builtin_amdgcn_fence(__ATOMIC_RELEASE, "agent");
            asm volatile("s_waitcnt vmcnt(0)" ::: "memory");
            const unsigned og = xb_add(&bar[XB_TOP], 1u);
            const unsigned tg = og / nx;
            if (og + 1u == (tg + 1u) * nx) xb_add(&bar[XB_TOPGEN], 1u);
            else XB_SPIN(xb_ld(&bar[XB_TOPGEN]) == tg, bar);
            __builtin_amdgcn_fence(__ATOMIC_ACQUIRE, "agent");
            xb_add(&bar[XB_XGEN(x)], 1u);
            asm volatile("s_waitcnt vmcnt(0)" ::: "memory");
        } else {
            XB_SPIN(xb_ld(&bar[XB_XGEN(x)]) == gen, bar);
            __builtin_amdgcn_fence(__ATOMIC_ACQUIRE, "agent");
            asm volatile("s_waitcnt vmcnt(0)" ::: "memory");
        }
    }
    __syncthreads();
}
#ifndef EN_MASK
#define EN_MASK 0xFFFFFF
#endif
#define EN(b) ((EN_MASK >> (b)) & 1)
#ifndef REP_MASK
#define REP_MASK 0
#endif
#define REPN(b) (1 + ((REP_MASK >> (b)) & 1))
__device__ __forceinline__ const void* ldp(LAS unsigned char* lds, int i) {
    const LAS unsigned* q = (const LAS unsigned*)(lds + 143360) + 2 * i;
    const unsigned lo = __builtin_amdgcn_readfirstlane(q[0]), hi = __builtin_amdgcn_readfirstlane(q[1]);
    return (const void*)(((unsigned long long)hi << 32) | lo);
}
#ifdef CGSYNC
#define GSYNC() grid.sync()
#else
#define GSYNC() do { for (int _r = 0; _r < REPN(20); ++_r) xcd_barrier((unsigned*)(WSP + OFF_CTL), (volatile LAS unsigned*)(lds + LDS_BAR_OFF), widk); } while (0)
#endif

__global__ void __launch_bounds__(512, 2) mega_fwd(Params P) {
    extern __shared__ __attribute__((aligned(16))) unsigned char lds_raw[];
    LAS unsigned char* lds = (LAS unsigned char*)lds_raw;
    cg::grid_group grid = cg::this_grid();
    const int G = gridDim.x, c = blockIdx.x;
    const int widk = __builtin_amdgcn_readfirstlane(threadIdx.x >> 6);
    if (threadIdx.x == 0) { ((LAS unsigned*)(lds + LDS_BAR_OFF))[0] = 0u; ((LAS unsigned*)(lds + LDS_BAR_OFF))[1] = 0u;
        (void)xb_add((unsigned*)(P.ws + OFF_CTL) + XB_XCNT(xb_xcc_id()), 1u); }
    grid.sync();

#ifdef LDSP
    {
        LAS unsigned long long* PL = (LAS unsigned long long*)(lds + 143360);
        if (threadIdx.x == 0) { const unsigned long long* src = (const unsigned long long*)&P;
#pragma unroll
            for (int i = 0; i < 26; ++i) PL[i] = src[i]; }
        __syncthreads();
    }
#endif
#ifdef LDSP
#define PF(i) ((const float*)ldp(lds, (i)))
#else
#define PF(i) (((const float* const*)&P)[(i)])
#endif
#ifdef LDSP
#define WSP ((unsigned char*)ldp(lds, 25))
#else
#define WSP (P.ws)
#endif
#define XF ((float*)(WSP + OFF_XF))
#define XB ((bf16_t*)(WSP + OFF_XB))
#define PB ((bf16_t*)(WSP + OFF_PB))
#define PLEB ((bf16_t*)(WSP + OFF_PLE))
#define HB ((bf16_t*)(WSP + OFF_H))
#define ACTB ((bf16_t*)(WSP + OFF_ACT))
#define OB ((bf16_t*)(WSP + OFF_O))
#define KTT ((bf16_t*)(WSP + OFF_KTT))
#define SEL ((int*)(WSP + OFF_SEL))
#define XA ((float*)(WSP + OFF_XA))
#define SSQ ((float*)(WSP + OFF_SSQ))
#define DL ((float*)(WSP + OFF_DL))
#define KIN ((bf16_t*)(WSP + OFF_KIN))
#define WB ((bf16_t*)(WSP + OFF_W))
#define QKVR ((bf16_t*)(WSP + OFF_QKVR))
#define BP ((bf16_t*)(WSP + OFF_BP))
#define UT ((float*)(WSP + OFF_UT))
#define KT ((bf16_t*)(WSP + OFF_KT))
#define AP PLEB
#define STB ((float*)(WSP + OFF_ST))
#define PPB ((bf16_t*)(WSP + OFF_PP))


    for (int rep = 0; rep < REPN(12); ++rep) {
        IDX_SETUP
        LAS unsigned* scr = (LAS unsigned*)(lds + wid * 16384);
        if (EN(12)) {
#pragma unroll 1
        for (int j = 0; j < 2; ++j) {
            TJOB(PF(2) + (size_t)j * D * GLA_N, D, GLA_N, WB + W_GIN + (size_t)j * GLA_N * D, 0);
            TJOB(PF(7) + (size_t)j * D * D, D, D, WB + W_GO + (size_t)j * D * D, 0);
        }
#pragma unroll 1
        for (int g = 0; g < 4; ++g) TJOB(PF(8) + (size_t)g * 512 * 512, 512, 512, WB + W_POOL, g * 512);
        TJOB(PF(10), D, DSA_N, WB + W_DIN, 0);
        TJOB(PF(13), D, D, WB + W_DO, 0);
#pragma unroll 1
        for (int i = 0; i < 4; ++i) {
            TJOB(PF(16) + (size_t)i * D * NUP, D, NUP, WB + W_UP + (size_t)i * NUP * D, 0);
            TJOB(PF(19) + (size_t)i * DFF * D, DFF, D, WB + W_DOWN + (size_t)i * D * DFF, 0);
            TJOB(PF(20) + (size_t)i * D * D, D, D, WB + W_GATE + (size_t)i * D * D, 0);
            TJOB(PF(21) + (size_t)i * PLE * D, PLE, D, WB + W_PROJ + (size_t)i * D * PLE, 0);
        }
        }
        if (EN(13)) row_pass(PF(0), nullptr, nullptr, nullptr, XB, nullptr, widk);
        for (size_t i = (size_t)gt; i < (size_t)4 * T * PLE / 4; i += (size_t)NT) { const f32x4 v = ((const f32x4*)PF(1))[i]; u32x2 w; w.x = cvt_pk_bf16(v.x, v.y); w.y = cvt_pk_bf16(v.z, v.w); ((u32x2*)PB)[i] = w; }
    }
    GSYNC();

#pragma unroll 1
    for (int layer = 0; layer < 4; ++layer) {
        const int kind = layer % 3, jl = layer / 3;
        const float* xsrc = (layer == 0) ? PF(0) : XF;
        if (kind != 1) {
            if (kind == 0) for (int rep = 0; rep < REPN(21); ++rep) xa_pass(XB, PF(3) + (size_t)jl * D * 16, XA, widk);
            const int N = (kind == 0) ? GLA_N : DSA_NP;
            pg8::PlainSched S; S.o.init(T / 256, N / 256, G, c); S.A = (const char*)XB; S.B = (const char*)(kind == 0 ? WB + W_GIN + (size_t)jl * GLA_N * D : WB + W_DIN);
            S.tsA = (size_t)256 * D * 2; S.tsB = (size_t)256 * D * 2; S.poolmode = 0;
            pg8::EpiBf16<0> E{HB, N};
            for (int rep = 0; rep < REPN(14); ++rep) pg8::gemm_phase(lds, D, D, D, S, E, widk);
            GSYNC();
        }
        if (kind == 0) {
            for (int rep = 0; rep < REPN(0); ++rep) gla_prep(QKVR, XA, PF(4) + (size_t)jl * 16 * 1024, PF(5) + (size_t)jl * 1024, AP, KT, KTT, DL, lds, widk);
            for (int rep = 0; rep < REPN(1); ++rep) gla_vt(QKVR, BP, lds, widk);
            { IDX_SETUP for (int i = gt; i < T * 4; i += NT) SSQ[i] = 0.f; }
            GSYNC();
            for (int rep = 0; rep < REPN(2); ++rep) { GlaScoreSched S{G, c, AP, KT}; GlaScoreEpi E{AP}; pg8::gemm_phase(lds, 256, 2048, 1024, S, E, widk); }
            for (int rep = 0; rep < REPN(3); ++rep) { GlaUSched S{G, c, BP, KTT}; GlaUEpi E{UT, DL}; pg8::gemm_phase(lds, 256, 512, SEQ, S, E, widk); }
            GSYNC();
            for (int rep = 0; rep < REPN(4); ++rep) gla_scan(UT, DL, BP, widk);
            GSYNC();
            if (EN(5)) { GlaOSched S{G, c, AP, BP}; GlaOEpi E{OB, SSQ}; pg8::gemm_phase(lds, 512, 2048, 512, S, E, widk); }
            GSYNC();
            if (EN(6)) gla_gate(OB, SSQ, QKVR, PF(6) + (size_t)jl * D, widk);
            GSYNC();
        } else if (kind == 1) {
            for (int rep = 0; rep < REPN(7); ++rep) pool_pass(XB, OB, widk);
            GSYNC();
        } else {
            for (int rep = 0; rep < REPN(8); ++rep) dsa_kin(HB, PF(11), PF(12), KIN, widk);
            GSYNC();
            for (int rep = 0; rep < REPN(9); ++rep) dsa_topk(HB, KIN, SEL, lds, widk);
            GSYNC();
            for (int rep = 0; rep < REPN(10); ++rep) dsa_attn(HB, SEL, OB, lds, widk);
            GSYNC();
        }
        {
            pg8::PlainSched S; S.o.init(T / 256, D / 256, G, c); S.A = (const char*)OB;
            S.B = (const char*)(kind == 0 ? WB + W_GO + (size_t)jl * D * D : kind == 1 ? WB + W_POOL : WB + W_DO);
            const int K = (kind == 1) ? 512 : D;
            S.tsA = (size_t)256 * D * 2; S.tsB = (size_t)256 * K * 2; S.poolmode = (kind == 1);
            pg8::EpiResid E{xsrc, XF, (kind == 1) ? PF(9) : nullptr, nullptr, nullptr, (layer == 0) ? nullptr : STB, PF(22) + (size_t)(layer - 1) * D, PF(23) + (size_t)(layer - 1) * D};
            if (REPN(15) > 1) { pg8::EpiResid E2{xsrc, (float*)HB, (kind == 1) ? PF(9) : nullptr, nullptr, nullptr, (layer == 0) ? nullptr : STB, PF(22) + (size_t)(layer - 1) * D, PF(23) + (size_t)(layer - 1) * D}; pg8::gemm_phase(lds, K, D, K, S, E2, widk); }
            if (EN(15)) pg8::gemm_phase(lds, K, D, K, S, E, widk);
        }
        GSYNC();
        if (EN(13)) row_pass(XF, PF(14) + (size_t)layer * D, PF(15) + (size_t)layer * D, nullptr, XB, STB, widk);
        if (REPN(13) > 1) row_pass(XF, PF(14) + (size_t)layer * D, PF(15) + (size_t)layer * D, (float*)HB, OB, nullptr, widk);
        GSYNC();
#pragma unroll 1
        for (int gi = 0; gi < 2; ++gi) {
            const int N = gi == 0 ? NUP : D;
            pg8::PlainSched S; S.o.init(T / 256, N / 256, G, c); S.A = (const char*)XB;
            S.B = (const char*)(gi == 0 ? WB + W_UP + (size_t)layer * NUP * D : WB + W_GATE + (size_t)layer * D * D);
            S.tsA = (size_t)256 * D * 2; S.tsB = (size_t)256 * D * 2; S.poolmode = 0;
            if (gi == 0) { pg8::EpiBf16<0> E{HB, NUP}; for (int rep = 0; rep < REPN(16); ++rep) pg8::gemm_phase(lds, D, D, D, S, E, widk); }
            else { pg8::EpiBf16<2> E{PLEB, D}; for (int rep = 0; rep < REPN(17); ++rep) pg8::gemm_phase(lds, D, D, D, S, E, widk); }
        }
        {
            pg8::PlainSched S; S.o.init(T / 256, D / 256, G, c); S.A = (const char*)(PB + (size_t)layer * T * PLE); S.B = (const char*)(WB + W_PROJ + (size_t)layer * D * PLE);
            S.tsA = (size_t)256 * PLE * 2; S.tsB = (size_t)256 * PLE * 2; S.poolmode = 0;
            pg8::EpiBf16<0> E{PPB, D};
            for (int rep = 0; rep < REPN(18); ++rep) pg8::gemm_phase(lds, PLE, PLE, PLE, S, E, widk);
        }
        GSYNC();
        for (int rep = 0; rep < REPN(11); ++rep) conv_pass(HB, PF(17) + (size_t)layer * 3 * NUP, PF(18) + (size_t)layer * NUP, ACTB, widk);
        GSYNC();
        {
            pg8::PlainSched S; S.o.init(T / 256, D / 256, G, c); S.A = (const char*)ACTB; S.B = (const char*)(WB + W_DOWN + (size_t)layer * D * DFF);
            S.tsA = (size_t)256 * DFF * 2; S.tsB = (size_t)256 * DFF * 2; S.poolmode = 0;
            pg8::EpiResid E{XF, XF, nullptr, PLEB, PPB, STB, PF(14) + (size_t)layer * D, PF(15) + (size_t)layer * D};
            if (REPN(19) > 1) { pg8::EpiResid E2{XF, (float*)HB, nullptr, PLEB, PPB, STB, PF(14) + (size_t)layer * D, PF(15) + (size_t)layer * D}; pg8::gemm_phase(lds, DFF, DFF, DFF, S, E2, widk); }
            if (EN(19)) pg8::gemm_phase(lds, DFF, DFF, DFF, S, E, widk);
        }
        GSYNC();
        if (!EN(13)) {} else if (layer == 3) row_pass(XF, PF(22) + (size_t)layer * D, PF(23) + (size_t)layer * D, ((float*)PF(24)), nullptr, nullptr, widk);
        else row_pass(XF, PF(22) + (size_t)layer * D, PF(23) + (size_t)layer * D, nullptr, XB, STB, widk);
        if (layer != 3) GSYNC();
    }
}

extern "C" void kernel_launch(void* const* d_in, const int* in_sizes, int n_in, void* d_out, int out_size, void* d_ws, size_t ws_size, hipStream_t stream) {
    static int grid = 0;
    if (grid == 0) {
        if (n_in != 24 || out_size != T * D || ws_size < WS_END) { fprintf(stderr, "kernel_launch: unexpected problem (n_in %d, out %d, ws %zu < %zu)\n", n_in, out_size, ws_size, (size_t)WS_END); grid = -1; return; }
        int dev = 0, cus = 0, per_cu = 0;
        (void)hipGetDevice(&dev); (void)hipDeviceGetAttribute(&cus, hipDeviceAttributeMultiprocessorCount, dev);
        if (hipFuncSetAttribute((const void*)mega_fwd, hipFuncAttributeMaxDynamicSharedMemorySize, LDS_BYTES) != hipSuccess) { fprintf(stderr, "kernel_launch: hipFuncSetAttribute failed\n"); grid = -1; return; }
        if (hipOccupancyMaxActiveBlocksPerMultiprocessor(&per_cu, (const void*)mega_fwd, 512, LDS_BYTES) != hipSuccess || per_cu < 1) { fprintf(stderr, "kernel_launch: occupancy query says %d blocks/CU\n", per_cu); per_cu = 1; }
        (void)hipGetLastError();
        grid = cus;
    }
    if (grid < 0) return;
    if (hipMemsetAsync((char*)d_ws + OFF_CTL, 0, CTL_BYTES, stream) != hipSuccess) { fprintf(stderr, "kernel_launch: memset failed\n"); return; }
    Params p{};
    const float** pf = (const float**)&p;
    for (int i = 0; i < 24; ++i) pf[i] = (const float*)d_in[i];
    p.out = (float*)d_out; p.ws = (unsigned char*)d_ws;
    void* args[] = {&p};
    hipError_t e = hipLaunchCooperativeKernel((const void*)mega_fwd, dim3(grid), dim3(512), args, LDS_BYTES, stream);
    if (e != hipSuccess) fprintf(stderr, "kernel_launch: cooperative launch failed: %s (grid %d)\n", hipGetErrorString(e), grid);
}
```

```cpp
#include <hip/hip_runtime.h>
#include <hip/hip_cooperative_groups.h>
#include <cstdio>
namespace cg = cooperative_groups;

#define LAS __attribute__((address_space(3)))
typedef unsigned short bf16_t;
typedef short bf16x8 __attribute__((ext_vector_type(8)));
typedef float f32x4 __attribute__((ext_vector_type(4)));
typedef float f32x2 __attribute__((ext_vector_type(2)));
typedef unsigned u32x4 __attribute__((ext_vector_type(4)));
typedef unsigned u32x2 __attribute__((ext_vector_type(2)));

constexpr int T = 16384, SEQ = 8192, D = 2048, DFF = 5504, NUP = 11008, PLE = 256;
constexpr int GLA_N = 6144, DSA_N = 4176, DSA_NP = 4352;
constexpr float LN_EPS = 1e-5f;
constexpr float ALPHA = 1.681792830507429f;

constexpr size_t OFF_XF = 0;
constexpr size_t OFF_XB = OFF_XF + (size_t)T * D * 4;
constexpr size_t OFF_PB = OFF_XB + (size_t)T * D * 2;
constexpr size_t OFF_PLE = OFF_PB + (size_t)4 * T * PLE * 2;
constexpr size_t OFF_H = OFF_PLE + (size_t)T * D * 2;
constexpr size_t OFF_ACT = OFF_H + (size_t)T * NUP * 2;
constexpr size_t OFF_O = OFF_ACT + (size_t)T * DFF * 2;
constexpr size_t OFF_KTT = OFF_O + (size_t)T * D * 2;
constexpr size_t OFF_SEL = OFF_KTT + (size_t)T * 1024 * 2;
constexpr size_t OFF_XA = OFF_SEL + (size_t)T * 256 * 4;
constexpr size_t OFF_SSQ = OFF_XA + (size_t)T * 16 * 4;
constexpr size_t OFF_DL = OFF_SSQ + (size_t)T * 4 * 4;
constexpr size_t OFF_KIN = OFF_DL + (size_t)8 * 32 * 256 * 4;
constexpr size_t OFF_PP = OFF_KIN + (size_t)T * 64 * 2;
constexpr size_t OFF_CTL = OFF_PP + (size_t)T * D * 2;
constexpr size_t CTL_BYTES = 65536;
constexpr size_t OFF_ST = OFF_CTL + CTL_BYTES;
constexpr size_t OFF_W = OFF_ST + (size_t)T * 8;
constexpr size_t W_GIN = 0;
constexpr size_t W_GO = W_GIN + (size_t)2 * GLA_N * D;
constexpr size_t W_POOL = W_GO + (size_t)2 * D * D;
constexpr size_t W_DIN = W_POOL + (size_t)D * 512;
constexpr size_t W_DO = W_DIN + (size_t)DSA_NP * D;
constexpr size_t W_UP = W_DO + (size_t)D * D;
constexpr size_t W_DOWN = W_UP + (size_t)4 * NUP * D;
constexpr size_t W_GATE = W_DOWN + (size_t)4 * D * DFF;
constexpr size_t W_PROJ = W_GATE + (size_t)4 * D * D;
constexpr size_t W_END = W_PROJ + (size_t)4 * D * PLE;
constexpr size_t WS_END = OFF_W + W_END * 2;
constexpr size_t OFF_QKVR = OFF_H;
constexpr size_t OFF_BP = OFF_H + (size_t)T * GLA_N * 2;
constexpr size_t OFF_UT = OFF_ACT;
constexpr size_t OFF_KT = OFF_ACT + (size_t)8 * 32 * 512 * 256 * 4;
static_assert(OFF_BP + (size_t)8 * 32 * 512 * 512 * 2 <= OFF_ACT, "GLA overlay 1");
static_assert(OFF_KT + (size_t)T * 1024 * 2 <= OFF_O, "GLA overlay 2");

constexpr int LDS_BYTES = 147456;
constexpr int LDS_BAR_OFF = LDS_BYTES - 64;

__device__ __forceinline__ float bf2f(unsigned short b) { return __uint_as_float(((unsigned)b) << 16); }
__device__ __forceinline__ unsigned f2bf(float f) { unsigned u = __float_as_uint(f); return (u + 0x7fffu + ((u >> 16) & 1u)) >> 16; }
__device__ __forceinline__ unsigned cvt_pk_bf16(float lo, float hi) { unsigned r; asm volatile("v_cvt_pk_bf16_f32 %0, %1, %2" : "=v"(r) : "v"(lo), "v"(hi)); return r; }
__device__ __forceinline__ float lo16(unsigned w) { return __uint_as_float(w << 16); }
__device__ __forceinline__ float hi16(unsigned w) { return __uint_as_float(w & 0xffff0000u); }
__device__ __forceinline__ float shx(float v, int m, int lane) { return __int_as_float(__builtin_amdgcn_ds_bpermute((lane ^ m) << 2, __float_as_int(v))); }
__device__ __forceinline__ int shi(int v, int src) { return __builtin_amdgcn_ds_bpermute(src << 2, v); }
__device__ __forceinline__ float wave_sum(float v, int lane) {
#pragma unroll
    for (int o = 1; o < 64; o <<= 1) v += shx(v, o, lane);
    return v;
}
__device__ __forceinline__ f32x2 gelu_pk(f32x2 v) {
    const f32x2 av = __builtin_elementwise_abs(v), d = av * 0.2316418882f + 1.0f;
    f32x2 t; t.x = __builtin_amdgcn_rcpf(d.x); t.y = __builtin_amdgcn_rcpf(d.y);
    f32x2 q = t * 0.5307027145f + (-0.7265760135f); q = q * t + 0.7107068705f; q = q * t + (-0.142248368f); q = q * t + 0.127414796f; q = q * t;
    const f32x2 s = (v * v) * (-0.72134752044f);
    f32x2 e; e.x = __builtin_amdgcn_exp2f(s.x); e.y = __builtin_amdgcn_exp2f(s.y);
    const f32x2 m = v * (q * e), r = v - m;
    f32x2 o; o.x = v.x < 0.f ? m.x : r.x; o.y = v.y < 0.f ? m.y : r.y; return o;
}
__device__ __forceinline__ float sigmoidf_(float x) { return 1.0f / (1.0f + __expf(-x)); }

__device__ __forceinline__ int lane_asm() { int l; asm volatile("v_mbcnt_lo_u32_b32 %0, -1, 0\n\tv_mbcnt_hi_u32_b32 %0, -1, %0" : "=&v"(l)); return l; }
__device__ __forceinline__ int opaque_tid(int widk) { asm volatile("" : "+s"(widk)); int l; asm volatile("v_mbcnt_lo_u32_b32 %0, -1, 0\n\tv_mbcnt_hi_u32_b32 %0, -1, %0" : "=&v"(l)); return (widk << 6) | l; }
__device__ __forceinline__ int opaque_s(int v) { v = __builtin_amdgcn_readfirstlane(v); asm volatile("" : "+s"(v)); return v; }
#define IDX_SETUP const int tid = opaque_tid(widk), lane = tid & 63, wid = __builtin_amdgcn_readfirstlane(tid >> 6); const int G = opaque_s(gridDim.x), c = opaque_s(blockIdx.x); \
    const int gw = c * 8 + wid, NGW = G * 8, gt = c * 512 + tid, NT = G * 512; (void)lane; (void)wid; (void)gw; (void)NGW; (void)gt; (void)NT;
namespace pg8 {
constexpr int BM = 256, BK = 64, HALF = 128, HTB = HALF * BK * 2, NXCD = 8, WGM = 4;
__host__ __device__ __forceinline__ int lds_byte(int r, int c) { const int st = (r >> 4) * 2 + (c >> 5), rr = r & 15, cc = c & 31, ob = rr * 64 + cc * 2; return st * 1024 + (ob ^ (((ob >> 9) & 1) << 5)); }
__host__ __device__ __forceinline__ void stage_rc(int b, int& R, int& C) { const int st = b / 1024, sb = b % 1024, swz = sb ^ (((sb >> 9) & 1) << 5); R = (st >> 1) * 16 + swz / 64; C = (st & 1) * 32 + (swz % 64) / 2; }
__host__ __device__ __forceinline__ int perm32(int rho) { const int n = rho >> 4, i = rho & 15; return 8 * (i >> 2) + 4 * n + (i & 3); }

struct Unit { int pm, pn; const char* A; const char* B; };

struct TileOrder {
    int nM, nN, nwg, G, c;
    __device__ __forceinline__ void init(int nM_, int nN_, int G_, int c_) { nM = nM_; nN = nN_; nwg = nM * nN; G = G_; c = c_; }
    __device__ __forceinline__ bool next(int i, int& pm, int& pn) const {
        const long L = (long)i * G + c; if (L >= nwg) return false;
        int wgid = (int)L; { const int q = nwg / NXCD, r = nwg % NXCD, xcd = wgid % NXCD, off = wgid / NXCD; wgid = (xcd < r ? xcd * (q + 1) : r * (q + 1) + (xcd - r) * q) + off; }
        const int nig = WGM * nN, gid = wgid / nig, fm = gid * WGM, gsz = (nM - fm) < WGM ? (nM - fm) : WGM;
        pm = fm + ((wgid % nig) % gsz); pn = (wgid % nig) / gsz; return true;
    }
};
struct PlainSched {
    TileOrder o; const char* A; const char* B; size_t tsA, tsB; int poolmode;
    __device__ __forceinline__ bool next(int i, Unit& u) const {
        if (!o.next(i, u.pm, u.pn)) return false;
        u.A = A + (size_t)u.pm * tsA + (poolmode ? (size_t)(u.pn >> 1) * 1024 : 0); u.B = B + (size_t)u.pn * tsB; return true;
    }
};

template <int ACT  > struct EpiBf16 {
    static constexpr bool PERM = true;
    bf16_t* O; int ldc;
    __device__ __forceinline__ void operator()(const f32x4 (&acc)[2][2][4][2], const Unit& u, int wr, int wc, int fr, int fq) const {
        const int lane = lane_asm(); fr = lane & 15; fq = lane >> 4; (void)lane;
        const int row0 = u.pm * BM + wr * 64 + fr, col0 = u.pn * BM + wc * 32 + 8 * fq;
#pragma unroll
        for (int ai = 0; ai < 2; ++ai)
#pragma unroll
            for (int m = 0; m < 4; ++m) { bf16_t* rowp = O + (size_t)(row0 + ai * HALF + m * 16) * ldc + col0;
#pragma unroll
                for (int bj = 0; bj < 2; ++bj) { f32x4 v0 = acc[ai][bj][m][0], v1 = acc[ai][bj][m][1];
                    if (ACT == 2) {
#pragma unroll
                        for (int j = 0; j < 4; ++j) { v0[j] = sigmoidf_(v0[j]); v1[j] = sigmoidf_(v1[j]); } }
                    u32x4 w; w.x = cvt_pk_bf16(v0[0], v0[1]); w.y = cvt_pk_bf16(v0[2], v0[3]); w.z = cvt_pk_bf16(v1[0], v1[1]); w.w = cvt_pk_bf16(v1[2], v1[3]);
                    *(u32x4*)(rowp + bj * HALF) = w; } }
    }
};
struct EpiPleMul {
    static constexpr bool PERM = true;
    bf16_t* O; int ldc;
    __device__ __forceinline__ void operator()(const f32x4 (&acc)[2][2][4][2], const Unit& u, int wr, int wc, int fr, int fq) const {
        const int lane = lane_asm(); fr = lane & 15; fq = lane >> 4; (void)lane;
        const int row0 = u.pm * BM + wr * 64 + fr, col0 = u.pn * BM + wc * 32 + 8 * fq;
#pragma unroll
        for (int ai = 0; ai < 2; ++ai)
#pragma unroll
            for (int m = 0; m < 4; ++m) { bf16_t* rowp = O + (size_t)(row0 + ai * HALF + m * 16) * ldc + col0;
#pragma unroll
                for (int bj = 0; bj < 2; ++bj) { const f32x4 v0 = acc[ai][bj][m][0], v1 = acc[ai][bj][m][1];
                    const u32x4 g = *(const u32x4*)(rowp + bj * HALF);
                    u32x4 w; w.x = cvt_pk_bf16(v0[0] * lo16(g.x), v0[1] * hi16(g.x)); w.y = cvt_pk_bf16(v0[2] * lo16(g.y), v0[3] * hi16(g.y));
                    w.z = cvt_pk_bf16(v1[0] * lo16(g.z), v1[1] * hi16(g.z)); w.w = cvt_pk_bf16(v1[2] * lo16(g.w), v1[3] * hi16(g.w));
                    *(u32x4*)(rowp + bj * HALF) = w; }
                asm volatile("" ::: "memory"); }
    }
};
struct EpiResid {
    static constexpr bool PERM = false;
    const float* src; float* dst; const float* cscale; const bf16_t* ple; const bf16_t* ple2;
    const float* st; const float* lg; const float* lb;
    __device__ __forceinline__ void operator()(const f32x4 (&acc)[2][2][4][2], const Unit& u, int wr, int wc, int fr, int fq) const {
        const int lane = lane_asm(); fr = lane & 15; fq = lane >> 4; (void)lane;
        const int row0 = u.pm * BM + wr * 64 + fr, col0 = u.pn * BM + wc * 32 + 4 * fq;
#pragma unroll
        for (int ai = 0; ai < 2; ++ai)
#pragma unroll
            for (int mp = 0; mp < 2; ++mp) {
                f32x4 sv[2][2][2]; u32x2 pv[2][2][2], qv[2][2][2]; f32x2 sr[2];
#pragma unroll
                for (int mm = 0; mm < 2; ++mm) { const int m = 2 * mp + mm; const size_t rr = (size_t)(row0 + ai * HALF + m * 16), off = rr * D + col0;
                    sr[mm] = (f32x2){0.f, 1.f}; if (st) sr[mm] = *(const f32x2*)(st + 2 * rr);
#pragma unroll
                    for (int bj = 0; bj < 2; ++bj)
#pragma unroll
                        for (int n = 0; n < 2; ++n) { const size_t o2 = off + bj * HALF + n * 16; sv[mm][bj][n] = *(const f32x4*)(src + o2);
                            if (ple) { pv[mm][bj][n] = *(const u32x2*)(ple + o2); qv[mm][bj][n] = *(const u32x2*)(ple2 + o2); } } }
#pragma unroll
                for (int mm = 0; mm < 2; ++mm) { const int m = 2 * mp + mm; const size_t off = (size_t)(row0 + ai * HALF + m * 16) * D + col0;
#pragma unroll
                    for (int bj = 0; bj < 2; ++bj)
#pragma unroll
                        for (int n = 0; n < 2; ++n) { const size_t o2 = off + bj * HALF + n * 16; f32x4 a = acc[ai][bj][m][n];
                            if (cscale) a = a * *(const f32x4*)(cscale + col0 + bj * HALF + n * 16);
                            if (ple) { const u32x2 pw = pv[mm][bj][n], qw = qv[mm][bj][n];
                                a = a + (f32x4){lo16(pw.x) * lo16(qw.x), hi16(pw.x) * hi16(qw.x), lo16(pw.y) * lo16(qw.y), hi16(pw.y) * hi16(qw.y)}; }
                            f32x4 sx = sv[mm][bj][n];
                            if (st) sx = (sx - sr[mm].x) * sr[mm].y * *(const f32x4*)(lg + col0 + bj * HALF + n * 16) + *(const f32x4*)(lb + col0 + bj * HALF + n * 16);
                            *(f32x4*)(dst + o2) = sx * ALPHA + a; } }
                asm volatile("" ::: "memory");
            }
    }
};

template <class Epi, class Sched>
__device__ __forceinline__ void gemm_phase(LAS unsigned char* lds, const int K, const int lda, const int ldb, const Sched& S, const Epi& E, int widk) {
    const int tid = opaque_tid(widk), wid = __builtin_amdgcn_readfirstlane(tid >> 6), lane = tid & 63, wr = wid >> 2, wc = wid & 3, fr = lane & 15, fq = lane >> 4;
    const int nt = K / BK;
    unsigned voffA[2], voffB[2];
#pragma unroll
    for (int i = 0; i < 2; ++i) { int R, C; stage_rc(tid * 16 + i * 8192, R, C); const int Rb = Epi::PERM ? ((R & ~31) + perm32(R & 31)) : R;
        voffA[i] = (unsigned)(R * lda + C) * 2u; voffB[i] = (unsigned)(Rb * ldb + C) * 2u; }
    const size_t kstep = (size_t)(BK * 2);
    const size_t hsA = (size_t)HALF * lda * 2, hsB = (size_t)HALF * ldb * 2;
    const unsigned ldsw = (unsigned)wid * 1024u;
    const int aoff = lds_byte(wr * 64 + fr, fq * 8), boff = lds_byte(wc * 32 + fr, fq * 8);
#define PG8_SA(b, h) (((b) * 2 + (h)) * HTB)
#define PG8_SB(b, h) ((4 + (b) * 2 + (h)) * HTB)
#define PG8_STAGE(bufoff, gbase, voff) do { _Pragma("unroll") for (int _i = 0; _i < 2; ++_i) \
        __builtin_amdgcn_global_load_lds((const unsigned*)((const char*)(gbase) + (voff)[_i]), (LAS unsigned*)(lds + (bufoff) + ldsw + _i * 8192), 16, 0, 0); } while (0)
#define PG8_LDA(dst, b, h) do { _Pragma("unroll") for (int m = 0; m < 4; ++m) _Pragma("unroll") for (int k = 0; k < 2; ++k) dst[m][k] = *(const LAS bf16x8*)(lds + PG8_SA(b, h) + aoff + m * 2048 + k * 1024); } while (0)
#define PG8_LDB(dst, b, h) do { _Pragma("unroll") for (int n = 0; n < 2; ++n) _Pragma("unroll") for (int k = 0; k < 2; ++k) dst[n][k] = *(const LAS bf16x8*)(lds + PG8_SB(b, h) + boff + n * 2048 + k * 1024); } while (0)
#define PG8_MMA(ai, bj, At, Bt) do { __builtin_amdgcn_s_setprio(1); _Pragma("unroll") for (int m = 0; m < 4; ++m) _Pragma("unroll") for (int n = 0; n < 2; ++n) _Pragma("unroll") for (int k = 0; k < 2; ++k) \
        acc[ai][bj][m][n] = __builtin_amdgcn_mfma_f32_16x16x32_bf16(Bt[n][k], At[m][k], acc[ai][bj][m][n], 0, 0, 0); __builtin_amdgcn_s_setprio(0); } while (0)
#define PG8_WAIT_V(n) asm volatile("s_waitcnt vmcnt(" #n ")" ::: "memory")
#define PG8_WAIT_L(n) asm volatile("s_waitcnt lgkmcnt(" #n ")" ::: "memory")
#define PG8_BAR __builtin_amdgcn_s_barrier()
#define PG8_SCHED __builtin_amdgcn_sched_barrier(0)
    Unit cur, nxt; int ui = 0;
    if (!S.next(0, cur)) return;
    f32x4 acc[2][2][4][2];
#pragma unroll
    for (int a = 0; a < 2; ++a)
#pragma unroll
        for (int b = 0; b < 2; ++b)
#pragma unroll
            for (int m = 0; m < 4; ++m)
#pragma unroll
                for (int n = 0; n < 2; ++n) acc[a][b][m][n] = (f32x4){0.f, 0.f, 0.f, 0.f};
    bf16x8 At[4][2], B0[2][2], B1[2][2];
    const char* cA = cur.A; const char* cB = cur.B;
    PG8_STAGE(PG8_SB(0, 0), cB, voffB); PG8_STAGE(PG8_SB(0, 1), cB + hsB, voffB); PG8_STAGE(PG8_SA(0, 0), cA, voffA); PG8_STAGE(PG8_SA(0, 1), cA + hsA, voffA);
    if (wr == 1) PG8_BAR;
    PG8_WAIT_V(2); PG8_BAR;
    PG8_STAGE(PG8_SB(1, 0), cB + kstep, voffB); PG8_STAGE(PG8_SA(1, 0), cA + kstep, voffA); PG8_STAGE(PG8_SB(1, 1), cB + hsB + kstep, voffB);
    PG8_WAIT_V(6); PG8_BAR;
    for (;;) {
        const bool has_next = S.next(ui + 1, nxt);
        const char* nA = has_next ? nxt.A : cA; const char* nB = has_next ? nxt.B : cB;
        for (int t = 0; t < nt; t += 2) {
            const bool last = (t == nt - 2);
            const char* a1 = cA + (size_t)(t + 1) * kstep;
            const char* a2 = last ? nA : cA + (size_t)(t + 2) * kstep; const char* b2 = last ? nB : cB + (size_t)(t + 2) * kstep;
            const char* a3 = a2 + kstep; const char* b3 = b2 + kstep;
            PG8_LDB(B0, 0, 0); PG8_LDB(B1, 0, 1); PG8_SCHED; PG8_LDA(At, 0, 0); PG8_STAGE(PG8_SA(1, 1), a1 + hsA, voffA);
            PG8_WAIT_V(8); PG8_WAIT_L(0); PG8_BAR; PG8_MMA(0, 0, At, B0); PG8_MMA(0, 1, At, B1); PG8_BAR; PG8_SCHED;
            PG8_LDA(At, 0, 1); PG8_STAGE(PG8_SB(0, 0), b2, voffB); PG8_STAGE(PG8_SB(0, 1), b2 + hsB, voffB); PG8_STAGE(PG8_SA(0, 0), a2, voffA);
            PG8_WAIT_V(8); PG8_WAIT_L(0); PG8_BAR; PG8_MMA(1, 0, At, B0); PG8_MMA(1, 1, At, B1); PG8_BAR; PG8_SCHED;
            PG8_LDB(B0, 1, 0); PG8_LDB(B1, 1, 1); PG8_SCHED; PG8_LDA(At, 1, 0); PG8_STAGE(PG8_SA(0, 1), a2 + hsA, voffA);
            PG8_WAIT_V(8); PG8_WAIT_L(0); PG8_BAR; PG8_MMA(0, 0, At, B0); PG8_MMA(0, 1, At, B1); PG8_BAR; PG8_SCHED;
            PG8_LDA(At, 1, 1); PG8_STAGE(PG8_SB(1, 0), b3, voffB); PG8_STAGE(PG8_SB(1, 1), b3 + hsB, voffB); PG8_STAGE(PG8_SA(1, 0), a3, voffA);
            PG8_WAIT_V(8); PG8_WAIT_L(0); PG8_BAR; PG8_MMA(1, 0, At, B0); PG8_MMA(1, 1, At, B1); PG8_BAR; PG8_SCHED;
        }
        if (wr == 0) PG8_BAR;
        E(acc, cur, wr, wc, fr, fq);
        if (!has_next) break;
#pragma unroll
        for (int a = 0; a < 2; ++a)
#pragma unroll
            for (int b = 0; b < 2; ++b)
#pragma unroll
                for (int m = 0; m < 4; ++m)
#pragma unroll
                    for (int n = 0; n < 2; ++n) acc[a][b][m][n] = (f32x4){0.f, 0.f, 0.f, 0.f};
        cur = nxt; cA = nA; cB = nB; ++ui;
        if (wr == 1) PG8_BAR;
    }
    PG8_WAIT_V(0);
    PG8_BAR;
#undef PG8_SA
#undef PG8_SB
#undef PG8_STAGE
#undef PG8_LDA
#undef PG8_LDB
#undef PG8_MMA
#undef PG8_WAIT_V
#undef PG8_WAIT_L
#undef PG8_BAR
#undef PG8_SCHED
}
}

struct GlaScoreSched {
    int G, c; const bf16_t* AP; const bf16_t* KT;
    __device__ __forceinline__ bool next(int i, pg8::Unit& u) const {
        const int idx = c + i * G; if (idx >= 256) return false;
        const int bh = idx >> 5, sc = idx & 31, b = bh >> 2, h = bh & 3; const size_t tok0 = (size_t)b * SEQ + sc * 256;
        u.pm = idx; u.pn = 0; u.A = (const char*)(AP + tok0 * 2048 + h * 512); u.B = (const char*)(KT + tok0 * 1024 + h * 256); return true;
    }
};
struct GlaScoreEpi {
    static constexpr bool PERM = true;
    bf16_t* AP;
    __device__ __forceinline__ void operator()(const f32x4 (&acc)[2][2][4][2], const pg8::Unit& u, int wr, int wc, int fr, int fq) const {
        const int lane = lane_asm(); fr = lane & 15; fq = lane >> 4; (void)lane;
        const int idx = u.pm, bh = idx >> 5, sc = idx & 31, b = bh >> 2, h = bh & 3; const size_t tok0 = (size_t)b * SEQ + sc * 256;
#pragma unroll
        for (int ai = 0; ai < 2; ++ai)
#pragma unroll
            for (int m = 0; m < 4; ++m) { const int r = ai * 128 + wr * 64 + m * 16 + fr; bf16_t* rowp = AP + (tok0 + r) * 2048 + h * 512 + 256;
#pragma unroll
                for (int bj = 0; bj < 2; ++bj) { const int c0 = bj * 128 + wc * 32 + 8 * fq; f32x4 v0 = acc[ai][bj][m][0], v1 = acc[ai][bj][m][1];
#pragma unroll
                    for (int j = 0; j < 4; ++j) { if (c0 + j > r) v0[j] = 0.f; if (c0 + 4 + j > r) v1[j] = 0.f; }
                    u32x4 w; w.x = cvt_pk_bf16(v0[0], v0[1]); w.y = cvt_pk_bf16(v0[2], v0[3]); w.z = cvt_pk_bf16(v1[0], v1[1]); w.w = cvt_pk_bf16(v1[2], v1[3]);
                    *(u32x4*)(rowp + c0) = w; } }
    }
};
struct GlaUSched {
    int G, c; const bf16_t* BP; const bf16_t* KTT;
    __device__ __forceinline__ bool next(int i, pg8::Unit& u) const {
        const int idx = c + i * G; if (idx >= 512) return false;
        const int bhsc = idx >> 1, mt = idx & 1, bh = bhsc >> 5, sc = bhsc & 31;
        u.pm = idx; u.pn = 0; u.A = (const char*)(BP + ((size_t)bhsc * 512 + mt * 256) * 512 + 256); u.B = (const char*)(KTT + (size_t)bh * 256 * SEQ + sc * 256); return true;
    }
};
struct GlaUEpi {
    static constexpr bool PERM = false;
    float* UT; const float* DL;
    __device__ __forceinline__ void operator()(const f32x4 (&acc)[2][2][4][2], const pg8::Unit& u, int wr, int wc, int fr, int fq) const {
        const int lane = lane_asm(); fr = lane & 15; fq = lane >> 4; (void)lane;
        const int idx = u.pm, bhsc = idx >> 1, mt = idx & 1; const float* dl = DL + (size_t)bhsc * 256;
#pragma unroll
        for (int ai = 0; ai < 2; ++ai)
#pragma unroll
            for (int m = 0; m < 4; ++m) { const int r = mt * 256 + ai * 128 + wr * 64 + m * 16 + fr; float* rowp = UT + ((size_t)bhsc * 512 + r) * 256;
#pragma unroll
                for (int bj = 0; bj < 2; ++bj)
#pragma unroll
                    for (int n = 0; n < 2; ++n) { const int c0 = bj * 128 + wc * 32 + n * 16 + 4 * fq; *(f32x4*)(rowp + c0) = acc[ai][bj][m][n] * *(const f32x4*)(dl + c0); } }
    }
};
struct GlaOSched {
    int G, c; const bf16_t* AP; const bf16_t* BP;
    __device__ __forceinline__ bool next(int i, pg8::Unit& u) const {
        const int idx = c + i * G; if (idx >= 512) return false;
        const int bhsc = idx >> 1, nt = idx & 1, bh = bhsc >> 5, sc = bhsc & 31, b = bh >> 2, h = bh & 3; const size_t tok0 = (size_t)b * SEQ + sc * 256;
        u.pm = idx; u.pn = 0; u.A = (const char*)(AP + tok0 * 2048 + h * 512); u.B = (const char*)(BP + ((size_t)bhsc * 512 + nt * 256) * 512); return true;
    }
};
struct GlaOEpi {
    static constexpr bool PERM = true;
    bf16_t* O; float* SSQ;
    __device__ __forceinline__ void operator()(const f32x4 (&acc)[2][2][4][2], const pg8::Unit& u, int wr, int wc, int fr, int fq) const {
        const int lane = lane_asm(); fr = lane & 15; fq = lane >> 4; (void)lane;
        const int idx = u.pm, bhsc = idx >> 1, nt = idx & 1, bh = bhsc >> 5, sc = bhsc & 31, b = bh >> 2, h = bh & 3; const size_t tok0 = (size_t)b * SEQ + sc * 256;
#pragma unroll
        for (int ai = 0; ai < 2; ++ai)
#pragma unroll
            for (int m = 0; m < 4; ++m) { const int r = ai * 128 + wr * 64 + m * 16 + fr; bf16_t* rowp = O + (tok0 + r) * 2048 + h * 512 + nt * 256; float ss = 0.f;
#pragma unroll
                for (int bj = 0; bj < 2; ++bj) { const int c0 = bj * 128 + wc * 32 + 8 * fq; const f32x4 v0 = acc[ai][bj][m][0], v1 = acc[ai][bj][m][1];
                    ss += (v0[0] * v0[0] + v0[1] * v0[1]) + (v0[2] * v0[2] + v0[3] * v0[3]) + (v1[0] * v1[0] + v1[1] * v1[1]) + (v1[2] * v1[2] + v1[3] * v1[3]);
                    u32x4 w; w.x = cvt_pk_bf16(v0[0], v0[1]); w.y = cvt_pk_bf16(v0[2], v0[3]); w.z = cvt_pk_bf16(v1[0], v1[1]); w.w = cvt_pk_bf16(v1[2], v1[3]);
                    *(u32x4*)(rowp + c0) = w; }
                ss += shx(ss, 16, lane); ss += shx(ss, 32, lane);
                if (fq == 0) atomicAdd(SSQ + (tok0 + r) * 4 + h, ss); }
    }
};

struct Params {
    const float *x, *p, *gla_w_in, *gla_w_a1, *gla_w_a2, *gla_b_a, *gla_norm_g, *gla_w_o, *pool_w, *pool_scale, *dsa_w_in, *dsa_kidx_g, *dsa_kidx_b, *dsa_w_o,
        *ln_mix_g, *ln_mix_b, *ffn_w_up, *ffn_conv_w, *ffn_conv_b, *ffn_w_down, *ple_gate_w, *ple_proj_w, *ln_ffn_g, *ln_ffn_b;
    float* out; unsigned char* ws;
};

__device__ __forceinline__ void transpose_item(const float* W, int K, int N, bf16_t* WT, int row_off, LAS unsigned* scr, int item, int lane) {
    const int nblk = (N + 63) / 64, kb = item / nblk, nb = item % nblk, k0 = 64 * kb, n0 = 64 * nb;
    const int nn = (lane & 15) * 4; const bool nok = (n0 + nn) < N;
#pragma unroll
    for (int i = 0; i < 8; ++i) { const int kk = 8 * i + 2 * (lane >> 4);
        f32x4 v0 = {0.f, 0.f, 0.f, 0.f}, v1 = v0;
        if (nok) { v0 = *(const f32x4*)(W + (size_t)(k0 + kk) * N + n0 + nn); v1 = *(const f32x4*)(W + (size_t)(k0 + kk + 1) * N + n0 + nn); }
#pragma unroll
        for (int j = 0; j < 4; ++j) scr[((nn + j) * 72 + kk) >> 1] = cvt_pk_bf16(v0[j], v1[j]); }
    asm volatile("s_waitcnt lgkmcnt(0)" ::: "memory");
#pragma unroll
    for (int j = 0; j < 8; ++j) { const int n = (lane >> 3) + 8 * j, ch = lane & 7;
        const u32x4 o = *(const LAS u32x4*)(scr + ((n * 72 + ch * 8) >> 1));
        *(u32x4*)(WT + (size_t)(row_off + n0 + n) * K + k0 + 8 * ch) = o; }
    asm volatile("s_waitcnt lgkmcnt(0)" ::: "memory");
}
#define TJOB(W, K, N, DST, ROWOFF) do { const int _ni = ((K) / 64) * (((N) + 63) / 64); for (int _it = gw; _it < _ni; _it += NGW) transpose_item((W), (K), (N), (DST), (ROWOFF), scr, _it, lane); } while (0)

__device__ __forceinline__ void row_pass(const float* src, const float* __restrict__ g, const float* __restrict__ b, float* dst32, bf16_t* __restrict__ dstb, float* __restrict__ stats, int widk) {
    IDX_SETUP
    f32x4 vn[8];
    if (gw < T) { const f32x4* xr = (const f32x4*)(src + (size_t)gw * D) + lane;
#pragma unroll
        for (int j = 0; j < 8; ++j) vn[j] = xr[64 * j]; }
    for (int r = gw; r < T; r += NGW) {
        f32x4 v[8];
#pragma unroll
        for (int j = 0; j < 8; ++j) v[j] = vn[j];
        if (r + NGW < T) { const f32x4* xr = (const f32x4*)(src + (size_t)(r + NGW) * D) + lane;
#pragma unroll
            for (int j = 0; j < 8; ++j) vn[j] = xr[64 * j]; }
        if (g) {
            float s = 0.f;
#pragma unroll
            for (int j = 0; j < 8; ++j) s += (v[j].x + v[j].y) + (v[j].z + v[j].w);
            const float mean = wave_sum(s, lane) * (1.f / D); float s2 = 0.f;
#pragma unroll
            for (int j = 0; j < 8; ++j) { v[j] = v[j] - mean; s2 += (v[j].x * v[j].x + v[j].y * v[j].y) + (v[j].z * v[j].z + v[j].w * v[j].w); }
            const float rstd = 1.0f / sqrtf(wave_sum(s2, lane) * (1.f / D) + LN_EPS);
            if (stats && lane == 0) *(f32x2*)(stats + 2 * (size_t)r) = (f32x2){mean, rstd};
#pragma unroll
            for (int j = 0; j < 8; ++j) { const f32x4 gg = ((const f32x4*)g)[lane + 64 * j], bb = ((const f32x4*)b)[lane + 64 * j]; v[j] = v[j] * rstd * gg + bb; }
        }
        if (dst32) { f32x4* o = (f32x4*)(dst32 + (size_t)r * D) + lane;
#pragma unroll
            for (int j = 0; j < 8; ++j) o[64 * j] = v[j]; }
        if (dstb) { u32x2* o = (u32x2*)(dstb + (size_t)r * D) + lane;
#pragma unroll
            for (int j = 0; j < 8; ++j) { u32x2 w; w.x = cvt_pk_bf16(v[j].x, v[j].y); w.y = cvt_pk_bf16(v[j].z, v[j].w); o[64 * j] = w; } }
    }
}

__device__ __forceinline__ void xa_pass(const bf16_t* srcb, const float* wa1, float* xa, int widk) {
    IDX_SETUP
    for (int r0 = gw * 4; r0 < T; r0 += NGW * 4) {
        f32x4 acc[4][4];
#pragma unroll
        for (int rr = 0; rr < 4; ++rr)
#pragma unroll
            for (int qd = 0; qd < 4; ++qd) acc[rr][qd] = (f32x4){0.f, 0.f, 0.f, 0.f};
#pragma unroll 2
        for (int i = 0; i < 32; ++i) { const int cc = lane + 64 * i; const f32x4* w = (const f32x4*)(wa1 + (size_t)cc * 16);
            const f32x4 w0 = w[0], w1 = w[1], w2 = w[2], w3 = w[3];
#pragma unroll
            for (int rr = 0; rr < 4; ++rr) { const float xv = bf2f(srcb[(size_t)(r0 + rr) * D + cc]);
                acc[rr][0] += w0 * xv; acc[rr][1] += w1 * xv; acc[rr][2] += w2 * xv; acc[rr][3] += w3 * xv; } }
        const bool b5 = (lane & 32) != 0, b4 = (lane & 16) != 0, b3 = (lane & 8) != 0, b2 = (lane & 4) != 0;
        const int idx = (b5 ? 8 : 0) + (b4 ? 4 : 0) + (b3 ? 2 : 0) + (b2 ? 1 : 0);
#pragma unroll
        for (int rr = 0; rr < 4; ++rr) {
            float k8[8], k4[4], k2[2];
#pragma unroll
            for (int j = 0; j < 8; ++j) { const float lo = acc[rr][j >> 2][j & 3], hi = acc[rr][2 + (j >> 2)][j & 3]; k8[j] = (b5 ? hi : lo) + shx(b5 ? lo : hi, 32, lane); }
#pragma unroll
            for (int j = 0; j < 4; ++j) k4[j] = (b4 ? k8[j + 4] : k8[j]) + shx(b4 ? k8[j] : k8[j + 4], 16, lane);
#pragma unroll
            for (int j = 0; j < 2; ++j) k2[j] = (b3 ? k4[j + 2] : k4[j]) + shx(b3 ? k4[j] : k4[j + 2], 8, lane);
            float k1 = (b2 ? k2[1] : k2[0]) + shx(b2 ? k2[0] : k2[1], 4, lane);
            k1 += shx(k1, 2, lane); k1 += shx(k1, 1, lane);
            if ((lane & 3) == 0) xa[(size_t)(r0 + rr) * 16 + idx] = k1;
        }
    }
}
__device__ __forceinline__ void conv_pass(const bf16_t* __restrict__ H, const float* __restrict__ cw, const float* __restrict__ cb, bf16_t* __restrict__ ACT, int widk) {
    IDX_SETUP
    constexpr int NCG = DFF / 8, NSEG = T / 32;
    for (int idx = gt; idx < NCG * NSEG; idx += NT) {
        const int cgi = idx % NCG, sg = idx / NCG, t0 = sg * 32, c0 = cgi * 8;
        f32x4 wg[3][2], wu[3][2], bg[2], bu[2];
#pragma unroll
        for (int j = 0; j < 3; ++j)
#pragma unroll
            for (int q = 0; q < 2; ++q) { wg[j][q] = *(const f32x4*)(cw + (size_t)j * NUP + c0 + 4 * q); wu[j][q] = *(const f32x4*)(cw + (size_t)j * NUP + DFF + c0 + 4 * q); }
#pragma unroll
        for (int q = 0; q < 2; ++q) { bg[q] = *(const f32x4*)(cb + c0 + 4 * q); bu[q] = *(const f32x4*)(cb + DFF + c0 + 4 * q); }
        f32x4 g2[2], g1[2], u2[2], u1[2];
        if ((t0 & (SEQ - 1)) == 0) {
#pragma unroll
            for (int q = 0; q < 2; ++q) { g2[q] = (f32x4){0.f, 0.f, 0.f, 0.f}; g1[q] = g2[q]; u2[q] = g2[q]; u1[q] = g2[q]; }
        } else {
            const u32x4 a = *(const u32x4*)(H + (size_t)(t0 - 2) * NUP + c0), b = *(const u32x4*)(H + (size_t)(t0 - 1) * NUP + c0);
            const u32x4 c = *(const u32x4*)(H + (size_t)(t0 - 2) * NUP + DFF + c0), d = *(const u32x4*)(H + (size_t)(t0 - 1) * NUP + DFF + c0);
            g2[0] = (f32x4){lo16(a.x), hi16(a.x), lo16(a.y), hi16(a.y)}; g2[1] = (f32x4){lo16(a.z), hi16(a.z), lo16(a.w), hi16(a.w)};
            g1[0] = (f32x4){lo16(b.x), hi16(b.x), lo16(b.y), hi16(b.y)}; g1[1] = (f32x4){lo16(b.z), hi16(b.z), lo16(b.w), hi16(b.w)};
            u2[0] = (f32x4){lo16(c.x), hi16(c.x), lo16(c.y), hi16(c.y)}; u2[1] = (f32x4){lo16(c.z), hi16(c.z), lo16(c.w), hi16(c.w)};
            u1[0] = (f32x4){lo16(d.x), hi16(d.x), lo16(d.y), hi16(d.y)}; u1[1] = (f32x4){lo16(d.z), hi16(d.z), lo16(d.w), hi16(d.w)};
        }
#pragma unroll 4
        for (int t = 0; t < 32; ++t) {
            const u32x4 a = *(const u32x4*)(H + (size_t)(t0 + t) * NUP + c0), c = *(const u32x4*)(H + (size_t)(t0 + t) * NUP + DFF + c0);
            f32x4 g0[2], u0[2];
            g0[0] = (f32x4){lo16(a.x), hi16(a.x), lo16(a.y), hi16(a.y)}; g0[1] = (f32x4){lo16(a.z), hi16(a.z), lo16(a.w), hi16(a.w)};
            u0[0] = (f32x4){lo16(c.x), hi16(c.x), lo16(c.y), hi16(c.y)}; u0[1] = (f32x4){lo16(c.z), hi16(c.z), lo16(c.w), hi16(c.w)};
            unsigned ow[4];
#pragma unroll
            for (int q = 0; q < 2; ++q) {
                const f32x4 hg = bg[q] + wg[0][q] * g2[q] + wg[1][q] * g1[q] + wg[2][q] * g0[q];
                const f32x4 hu = bu[q] + wu[0][q] * u2[q] + wu[1][q] * u1[q] + wu[2][q] * u0[q];
                const f32x2 ga = gelu_pk((f32x2){hg[0], hg[1]}), gb = gelu_pk((f32x2){hg[2], hg[3]});
                ow[2 * q] = cvt_pk_bf16(ga.x * hu[0], ga.y * hu[1]); ow[2 * q + 1] = cvt_pk_bf16(gb.x * hu[2], gb.y * hu[3]);
                g2[q] = g1[q]; g1[q] = g0[q]; u2[q] = u1[q]; u1[q] = u0[q];
            }
            *(u32x4*)(ACT + (size_t)(t0 + t) * DFF + c0) = (u32x4){ow[0], ow[1], ow[2], ow[3]};
        }
    }
}

__device__ __forceinline__ void ple_mul(bf16_t* SG, const bf16_t* PP, int widk) {
    IDX_SETUP
    for (int idx = gt; idx < T * (D / 8); idx += NT) {
        const u32x4 a = ((const u32x4*)SG)[idx], b = ((const u32x4*)PP)[idx];
        u32x4 w; w.x = cvt_pk_bf16(lo16(a.x) * lo16(b.x), hi16(a.x) * hi16(b.x)); w.y = cvt_pk_bf16(lo16(a.y) * lo16(b.y), hi16(a.y) * hi16(b.y));
        w.z = cvt_pk_bf16(lo16(a.z) * lo16(b.z), hi16(a.z) * hi16(b.z)); w.w = cvt_pk_bf16(lo16(a.w) * lo16(b.w), hi16(a.w) * hi16(b.w));
        ((u32x4*)SG)[idx] = w;
    }
}
__device__ __forceinline__ void gla_prep(const bf16_t* QKVR, const float* XA, const float* wa2, const float* ba, bf16_t* AP, bf16_t* KT, bf16_t* KTT, float* DL, LAS unsigned char* lds, int widk) {
    IDX_SETUP
    LAS float* tot = (LAS float*)lds;
    for (int it = c; it < 256; it += G) {
        const int h = it & 3, sc = (it >> 2) & 31, b = it >> 7, bh = b * 4 + h, col = h * 256 + 4 * lane;
        f32x4 w2[16];
#pragma unroll
        for (int j = 0; j < 16; ++j) w2[j] = *(const f32x4*)(wa2 + (size_t)j * 1024 + col);
        const f32x4 bav = *(const f32x4*)(ba + col);
        const size_t tokw = (size_t)b * SEQ + sc * 256 + wid * 32;
#define GLA_LA2(t, out) do { const f32x4* xa4 = (const f32x4*)(XA + (t) * 16); const f32x4 a0 = xa4[0], a1 = xa4[1], a2 = xa4[2], a3 = xa4[3]; \
            f32x4 z = bav + w2[0] * a0[0] + w2[1] * a0[1] + w2[2] * a0[2] + w2[3] * a0[3]; z += w2[4] * a1[0] + w2[5] * a1[1] + w2[6] * a1[2] + w2[7] * a1[3]; \
            z += w2[8] * a2[0] + w2[9] * a2[1] + w2[10] * a2[2] + w2[11] * a2[3]; z += w2[12] * a3[0] + w2[13] * a3[1] + w2[14] * a3[2] + w2[15] * a3[3]; \
            _Pragma("unroll") for (int _e = 0; _e < 4; ++_e) (out)[_e] = -0.0625f * __builtin_amdgcn_logf(1.0f + __builtin_amdgcn_exp2f(-z[_e] * 1.44269504f)); } while (0)
        f32x4 sum = {0.f, 0.f, 0.f, 0.f};
#pragma unroll 4
        for (int tt = 0; tt < 32; ++tt) { f32x4 la; GLA_LA2(tokw + tt, la); sum += la; }
        *(LAS f32x4*)(tot + wid * 256 + 4 * lane) = sum;
        __syncthreads();
        f32x4 bs = {0.f, 0.f, 0.f, 0.f}, ball = bs;
#pragma unroll
        for (int w = 0; w < 8; ++w) { const f32x4 tv = *(const LAS f32x4*)(tot + w * 256 + 4 * lane); if (w < wid) bs += tv; ball += tv; }
        for (int tt = 0; tt < 32; tt += 8) {
            unsigned pk[4][4];
#pragma unroll
            for (int e = 0; e < 8; e += 2) {
                f32x4 kt2[2];
#pragma unroll
                for (int e2 = 0; e2 < 2; ++e2) {
                    const size_t t = tokw + tt + e + e2;
                    f32x4 la; GLA_LA2(t, la); bs += la;
                    const u32x2 qw = *(const u32x2*)(QKVR + t * GLA_N + col), kw = *(const u32x2*)(QKVR + t * GLA_N + 1024 + col);
                    const f32x4 qv = {lo16(qw.x), hi16(qw.x), lo16(qw.y), hi16(qw.y)}, kv = {lo16(kw.x), hi16(kw.x), lo16(kw.y), hi16(kw.y)};
                    f32x4 qt, kt;
#pragma unroll
                    for (int j = 0; j < 4; ++j) { qt[j] = qv[j] * 0.0625f * __builtin_amdgcn_exp2f(bs[j]); kt[j] = kv[j] * __builtin_amdgcn_exp2f(fminf(-bs[j], 120.f)); }
                    u32x2 qo, ko; qo.x = cvt_pk_bf16(qt[0], qt[1]); qo.y = cvt_pk_bf16(qt[2], qt[3]); ko.x = cvt_pk_bf16(kt[0], kt[1]); ko.y = cvt_pk_bf16(kt[2], kt[3]);
                    *(u32x2*)(AP + t * 2048 + h * 512 + 4 * lane) = qo;
                    *(u32x2*)(KT + t * 1024 + col) = ko;
                    kt2[e2] = kt;
                }
#pragma unroll
                for (int j = 0; j < 4; ++j) pk[j][e >> 1] = cvt_pk_bf16(kt2[0][j], kt2[1][j]);
            }
#pragma unroll
            for (int j = 0; j < 4; ++j)
                *(u32x4*)(KTT + ((size_t)(bh * 256 + 4 * lane + j) * SEQ + sc * 256 + wid * 32 + tt)) = (u32x4){pk[j][0], pk[j][1], pk[j][2], pk[j][3]};
        }
        if (wid == 0) { f32x4 dl;
#pragma unroll
            for (int j = 0; j < 4; ++j) dl[j] = __builtin_amdgcn_exp2f(ball[j]);
            *(f32x4*)(DL + (size_t)(bh * 32 + sc) * 256 + 4 * lane) = dl; }
#undef GLA_LA2
        __syncthreads();
    }
}
__device__ __forceinline__ void gla_vt(const bf16_t* __restrict__ QKVR, bf16_t* __restrict__ BP, LAS unsigned char* lds, int widk) {
    IDX_SETUP
    LAS bf16_t* scr = (LAS bf16_t*)(lds + wid * 9216);
    for (int it = gw; it < 256 * 32; it += NGW) {
        const int tt = it >> 5, vt = it & 31;
        const size_t tokb = (size_t)tt * 64; const int vcol = vt * 64, h = vcol >> 9, vv0 = vcol & 511;
        const int b = (int)(tokb >> 13), tl = (int)(tokb & (SEQ - 1)), sc = tl >> 8, tloc0 = tl & 255, bhsc = (b * 4 + h) * 32 + sc;
#pragma unroll
        for (int i = 0; i < 8; ++i) { const int row = (lane >> 3) + 8 * i, ch = lane & 7;
            const u32x4 w = *(const u32x4*)(QKVR + (tokb + row) * GLA_N + 2048 + vcol + ch * 8);
            *(LAS u32x4*)(scr + row * 72 + ch * 8) = w; }
        asm volatile("s_waitcnt lgkmcnt(0)" ::: "memory");
#pragma unroll
        for (int cch = 0; cch < 8; ++cch) {
            unsigned short e[8];
#pragma unroll
            for (int j = 0; j < 8; ++j) e[j] = scr[(cch * 8 + j) * 72 + lane];
            u32x4 w; w.x = e[0] | ((unsigned)e[1] << 16); w.y = e[2] | ((unsigned)e[3] << 16); w.z = e[4] | ((unsigned)e[5] << 16); w.w = e[6] | ((unsigned)e[7] << 16);
            *(u32x4*)(BP + ((size_t)bhsc * 512 + vv0 + lane) * 512 + 256 + tloc0 + cch * 8) = w;
        }
        asm volatile("s_waitcnt lgkmcnt(0)" ::: "memory");
    }
}
__device__ __forceinline__ void gla_scan(const float* __restrict__ UT, const float* __restrict__ DL, bf16_t* __restrict__ BP, int widk) {
    IDX_SETUP
    for (int idx = gt; idx < 8 * 512 * 64; idx += NT) {
        const int k4 = idx & 63, v = (idx >> 6) & 511, bh = idx >> 15;
        f32x4 S = {0.f, 0.f, 0.f, 0.f};
#pragma unroll 4
        for (int sc = 0; sc < 32; ++sc) {
            const size_t bhsc = (size_t)bh * 32 + sc;
            u32x2 w; w.x = cvt_pk_bf16(S[0], S[1]); w.y = cvt_pk_bf16(S[2], S[3]);
            *(u32x2*)(BP + (bhsc * 512 + v) * 512 + k4 * 4) = w;
            const f32x4 dl = *(const f32x4*)(DL + bhsc * 256 + k4 * 4), uu = *(const f32x4*)(UT + (bhsc * 512 + v) * 256 + k4 * 4);
            S = dl * S + uu;
        }
    }
}
__device__ __forceinline__ void gla_gate(bf16_t* O, const float* SSQ, const bf16_t* QKVR, const float* ng, int widk) {
    IDX_SETUP
    for (int idx = gt; idx < T * (D / 8); idx += NT) {
        const int t = idx >> 8, c0 = (idx & 255) * 8, h = c0 >> 9;
        const float rs = 1.0f / sqrtf(SSQ[(size_t)t * 4 + h] * (1.f / 512.f) + LN_EPS);
        const u32x4 ov = *(const u32x4*)(O + (size_t)t * D + c0), rv = *(const u32x4*)(QKVR + (size_t)t * GLA_N + 4096 + c0);
        const f32x4 g0 = *(const f32x4*)(ng + c0), g1 = *(const f32x4*)(ng + c0 + 4);
        float o[8] = {lo16(ov.x), hi16(ov.x), lo16(ov.y), hi16(ov.y), lo16(ov.z), hi16(ov.z), lo16(ov.w), hi16(ov.w)};
        float r[8] = {lo16(rv.x), hi16(rv.x), lo16(rv.y), hi16(rv.y), lo16(rv.z), hi16(rv.z), lo16(rv.w), hi16(rv.w)};
        float gg[8] = {g0[0], g0[1], g0[2], g0[3], g1[0], g1[1], g1[2], g1[3]};
        float y[8];
#pragma unroll
        for (int j = 0; j < 8; ++j) { const float on = bf2f((unsigned short)f2bf(o[j] * rs * gg[j])); y[j] = on * (r[j] * sigmoidf_(r[j])); }
        *(u32x4*)(O + (size_t)t * D + c0) = (u32x4){cvt_pk_bf16(y[0], y[1]), cvt_pk_bf16(y[2], y[3]), cvt_pk_bf16(y[4], y[5]), cvt_pk_bf16(y[6], y[7])};
    }
}

__device__ __forceinline__ f32x4 ldbf4(const bf16_t* p) { const u32x2 w = *(const u32x2*)p; return (f32x4){lo16(w.x), hi16(w.x), lo16(w.y), hi16(w.y)}; }
__device__ __forceinline__ void pool_pass(const bf16_t* __restrict__ X, bf16_t* __restrict__ PO, int widk) {
    IDX_SETUP
    for (int idx = gt; idx < 512 * 512; idx += NT) {
        const int cg4 = idx & 511, sg = idx >> 9, c0 = cg4 * 4, w = 2 << (c0 >> 9);
        const int t0 = sg * 32, tb = t0 & (SEQ - 1);
        f32x4 sum = {0.f, 0.f, 0.f, 0.f};
        for (int j = 1; j < w; ++j) if (tb - j >= 0) sum += ldbf4(X + (size_t)(t0 - j) * D + c0);
#pragma unroll 4
        for (int t = 0; t < 32; ++t) {
            const f32x4 xv = ldbf4(X + (size_t)(t0 + t) * D + c0);
            sum += xv;
            const int tp = tb + t; const float inv = 1.0f / (float)((tp + 1) < w ? (tp + 1) : w);
            const f32x4 y = sum * inv - xv;
            u32x2 o; o.x = cvt_pk_bf16(y[0], y[1]); o.y = cvt_pk_bf16(y[2], y[3]);
            *(u32x2*)(PO + (size_t)(t0 + t) * D + c0) = o;
            if (tp - w + 1 >= 0) sum -= ldbf4(X + (size_t)(t0 + t - w + 1) * D + c0);
        }
    }
}

__device__ __forceinline__ void dsa_kin(const bf16_t* DP, const float* g, const float* b, bf16_t* KIN, int widk) {
    IDX_SETUP
    const float gg = g[lane], bb = b[lane];
    for (int r = gw; r < T; r += NGW) {
        const float v = bf2f(DP[(size_t)r * DSA_NP + 4096 + lane]);
        const float mean = wave_sum(v, lane) * (1.f / 64.f), d = v - mean, var = wave_sum(d * d, lane) * (1.f / 64.f);
        KIN[(size_t)r * 64 + lane] = (bf16_t)f2bf(d * (1.0f / sqrtf(var + LN_EPS)) * gg + bb);
    }
}
__device__ __forceinline__ unsigned f2key(float f) { const unsigned u = __float_as_uint(f); return (u & 0x80000000u) ? ~u : (u | 0x80000000u); }
__device__ __forceinline__ void topk_find_digit(const LAS unsigned* hist, int kk, int lane, int& dg, int& nk) {
    const u32x4 h4 = *(const LAS u32x4*)(hist + 4 * lane);
    const int cc = (int)(h4.x + h4.y + h4.z + h4.w);
    int suf = cc;
#pragma unroll
    for (int o = 1; o < 64; o <<= 1) { const int tv = shi(suf, (lane + o) & 63); if (lane + o < 64) suf += tv; }
    const unsigned long long bal = __ballot(suf >= kk);
    const int Lh = bal ? 63 - __builtin_clzll(bal) : 0;
    int above = suf - cc, d, k2;
    if (above + (int)h4.w >= kk) { d = 3; k2 = kk - above; }
    else { above += (int)h4.w;
        if (above + (int)h4.z >= kk) { d = 2; k2 = kk - above; }
        else { above += (int)h4.z;
            if (above + (int)h4.y >= kk) { d = 1; k2 = kk - above; }
            else { above += (int)h4.y; d = 0; k2 = kk - above; } } }
    dg = __builtin_amdgcn_readlane(4 * lane + d, Lh); nk = __builtin_amdgcn_readlane(k2, Lh);
}
__device__ __forceinline__ void dsa_topk(const bf16_t* DP, const bf16_t* KIN, int* SEL, LAS unsigned char* lds, int widk) {
    IDX_SETUP
    LAS float* scs = (LAS float*)lds;
    LAS unsigned* hist = (LAS unsigned*)(lds + 131072);
    LAS unsigned* misc = (LAS unsigned*)(lds + 131072 + 4096);
    LAS float* mmf = (LAS float*)(lds + 131072 + 4096 + 128);
    LAS unsigned* cand = (LAS unsigned*)(lds + 131072 + 4096 + 384);
    const int fr = lane & 15, fq = lane >> 4;
    for (int rr = c; rr < T / 4; rr += G) {
        const int b = rr >> 11; int blk = rr & 2047; { const int cblk = blk & 255, kb = blk >> 8; blk = (kb < 4) ? (cblk + 256 * kb) : (2047 - (cblk + 256 * (kb - 4))); }
        const int tq0 = blk * 4, n = tq0 + 4;
        const size_t tokq = (size_t)b * SEQ + tq0;
        bf16x8 Af[4][2]; float wv[4][4];
#pragma unroll
        for (int q = 0; q < 4; ++q) {
#pragma unroll
            for (int ks = 0; ks < 2; ++ks) Af[q][ks] = *(const bf16x8*)(DP + (tokq + q) * DSA_NP + 3072 + fr * 64 + ks * 32 + fq * 8);
            const u32x2 ww = *(const u32x2*)(DP + (tokq + q) * DSA_NP + 4160 + 4 * fq);
            wv[q][0] = lo16(ww.x) * 0.03125f; wv[q][1] = hi16(ww.x) * 0.03125f; wv[q][2] = lo16(ww.y) * 0.03125f; wv[q][3] = hi16(ww.y) * 0.03125f;
        }
        const int ntile = (n + 15) >> 4;
        {
            bf16x8 Bf[4][2], Bn[4][2];
#define TOPK_LOAD(dst, jbase) do { _Pragma("unroll") for (int u = 0; u < 4; ++u) { int j = (jbase) + 8 * u; j = j < 512 ? j : 511; \
                const bf16_t* kp = KIN + ((size_t)b * SEQ + j * 16 + fr) * 64 + fq * 8; dst[u][0] = *(const bf16x8*)kp; dst[u][1] = *(const bf16x8*)(kp + 32); } } while (0)
            TOPK_LOAD(Bf, wid);
            float rmn = __builtin_inff(), rmx = -__builtin_inff();
            for (int j4 = wid; j4 < ntile; j4 += 32) {
                TOPK_LOAD(Bn, j4 + 32);
#pragma unroll
                for (int u = 0; u < 4; ++u) {
                    const int j = j4 + 8 * u;
                    if (j < ntile) {
                        float myval = 0.f;
#pragma unroll
                        for (int q = 0; q < 4; ++q) {
                            f32x4 a = {0.f, 0.f, 0.f, 0.f};
                            a = __builtin_amdgcn_mfma_f32_16x16x32_bf16(Af[q][0], Bf[u][0], a, 0, 0, 0);
                            a = __builtin_amdgcn_mfma_f32_16x16x32_bf16(Af[q][1], Bf[u][1], a, 0, 0, 0);
                            float val = wv[q][0] * fmaxf(a[0], 0.f) + wv[q][1] * fmaxf(a[1], 0.f) + wv[q][2] * fmaxf(a[2], 0.f) + wv[q][3] * fmaxf(a[3], 0.f);
                            val += shx(val, 16, lane); val += shx(val, 32, lane);
                            if (fq == q) myval = val;
                        }
                        const int s = j * 16 + fr;
                        if (s > tq0 + fq) myval = -__builtin_inff(); else { rmn = fminf(rmn, myval); rmx = fmaxf(rmx, myval); }
                        scs[fq * 8192 + s] = myval;
                    }
                }
#pragma unroll
                for (int u = 0; u < 4; ++u) { Bf[u][0] = Bn[u][0]; Bf[u][1] = Bn[u][1]; }
            }
#undef TOPK_LOAD
#pragma unroll
            for (int o = 1; o < 16; o <<= 1) { rmn = fminf(rmn, shx(rmn, o, lane)); rmx = fmaxf(rmx, shx(rmx, o, lane)); }
            if (fr == 0) { mmf[wid * 8 + fq * 2] = rmn; mmf[wid * 8 + fq * 2 + 1] = rmx; }
            for (int i = tid; i < 1024; i += 512) hist[i] = 0u;
            if (tid < 32) misc[tid] = 0u;
        }
        __syncthreads();
        const int q = wid >> 1, sub = tid & 127, nq = tq0 + q + 1;
        int* selrow = SEL + (tokq + q) * 256;
        LAS float* row = scs + q * 8192;
        if (n <= 256) {
            for (int i = sub; i < 256; i += 128) selrow[i] = (i < nq) ? i : -1;
        } else {
            float mn = mmf[q * 2], mx = mmf[q * 2 + 1];
#pragma unroll
            for (int w = 1; w < 8; ++w) { mn = fminf(mn, mmf[w * 8 + q * 2]); mx = fmaxf(mx, mmf[w * 8 + q * 2 + 1]); }
            const float scale = (mx > mn) ? 255.0f / (mx - mn) : 0.f;
#define DSA_BIN(v) ({ int _b = (int)(((v) - mn) * scale); _b = _b < 0 ? 0 : _b; _b > 255 ? 255 : _b; })
            for (int sb = 0; sb < nq; sb += 512) { const int s4 = sb + 4 * sub;
                if (s4 < nq) { const f32x4 v4 = *(const LAS f32x4*)(row + s4);
#pragma unroll
                    for (int e = 0; e < 4; ++e) if (s4 + e < nq) __hip_atomic_fetch_add(hist + q * 256 + DSA_BIN(v4[e]), 1u, __ATOMIC_RELAXED, __HIP_MEMORY_SCOPE_WORKGROUP); } }
            __syncthreads();
            int bA, kkA; topk_find_digit(hist + q * 256, 256, lane, bA, kkA);
            LAS unsigned* lst = cand + q * 512;
            for (int sb = 0; sb < nq; sb += 512) { const int s4 = sb + 4 * sub; const bool in4 = s4 < nq;
                f32x4 v4 = {0.f, 0.f, 0.f, 0.f}; if (in4) v4 = *(const LAS f32x4*)(row + s4);
#pragma unroll
                for (int e = 0; e < 4; ++e) { const int s = s4 + e; const bool in = s < nq; const float v = v4[e]; const int bin = DSA_BIN(v);
                    const bool gsel = in && bin > bA;
                    const unsigned long long gm = __ballot(gsel);
                    if (gm) { const int leader = __builtin_ctzll(gm); unsigned base = 0u;
                        if (lane == leader) base = __hip_atomic_fetch_add(misc + q * 4 + 2, (unsigned)__builtin_popcountll(gm), __ATOMIC_RELAXED, __HIP_MEMORY_SCOPE_WORKGROUP);
                        base = (unsigned)__builtin_amdgcn_readlane((int)base, leader);
                        const unsigned pos = base + (unsigned)__builtin_popcountll(gm & ((1ull << lane) - 1ull));
                        if (gsel && pos < 256u) selrow[pos] = s; }
                    if (in && bin == bA) { const unsigned cp = __hip_atomic_fetch_add(misc + q * 4 + 3, 1u, __ATOMIC_RELAXED, __HIP_MEMORY_SCOPE_WORKGROUP); if (cp < 256u) { lst[2 * cp] = f2key(v); lst[2 * cp + 1] = (unsigned)s; } } }
            }
            __syncthreads();
            const int nc = (int)misc[q * 4 + 3];
            if (nc <= 256) {
                for (int i = sub; i < nc; i += 128) { const unsigned ki = lst[2 * i], si = lst[2 * i + 1]; int rank = 0;
                    for (int j = 0; j < nc; ++j) { const unsigned kj = lst[2 * j], sj = lst[2 * j + 1]; rank += (kj > ki || (kj == ki && sj < si)) ? 1 : 0; }
                    if (rank < kkA) selrow[256 - kkA + rank] = (int)si; }
            } else if ((wid & 1) == 0) {
                unsigned prefix = 0u, maskb = 0u; int kk = kkA;
#pragma unroll 1
                for (int pass = 0; pass < 4; ++pass) { const int shift = 24 - 8 * pass;
                    for (int i = lane; i < 256; i += 64) hist[q * 256 + i] = 0u;
                    asm volatile("s_waitcnt lgkmcnt(0)" ::: "memory");
                    for (int s = lane; s < nq; s += 64) { const float v = row[s]; if (DSA_BIN(v) == bA) { const unsigned key = f2key(v); if ((key & maskb) == prefix) __hip_atomic_fetch_add(hist + q * 256 + ((key >> shift) & 255u), 1u, __ATOMIC_RELAXED, __HIP_MEMORY_SCOPE_WORKGROUP); } }
                    asm volatile("s_waitcnt lgkmcnt(0)" ::: "memory");
                    int dg, nk; topk_find_digit(hist + q * 256, kk, lane, dg, nk); kk = nk;
                    prefix |= (unsigned)dg << shift; maskb |= 255u << shift; }
                int baseG = 256 - kkA, baseE = 256 - kk; const int endE = 256;
                for (int sb = 0; sb < nq; sb += 64) { const int s = sb + lane; const bool in = s < nq; const float v = in ? row[s] : 0.f; const bool inb = in && DSA_BIN(v) == bA; const unsigned key = f2key(v);
                    const bool g = inb && key > prefix, e = inb && key == prefix;
                    const unsigned long long gm = __ballot(g), em = __ballot(e), lt = (1ull << lane) - 1ull;
                    if (g) { const int pos = baseG + __builtin_popcountll(gm & lt); if (pos < 256) selrow[pos] = s; }
                    if (e) { const int pos = baseE + __builtin_popcountll(em & lt); if (pos < endE) selrow[pos] = s; }
                    baseG += __builtin_popcountll(gm); baseE += __builtin_popcountll(em); }
            }
#undef DSA_BIN
        }
        __syncthreads();
    }
}
__device__ __forceinline__ void dsa_attn(const bf16_t* DP, const int* SEL, bf16_t* O, LAS unsigned char* lds, int widk) {
    IDX_SETUP
    LAS unsigned char* pl = lds + wid * 10240;
    LAS unsigned char* vt = lds + wid * 10240 + 2048;
    const int fr = lane & 15, fq = lane >> 4;
    unsigned tra[8][2];
#pragma unroll
    for (int cb = 0; cb < 8; ++cb)
#pragma unroll
        for (int t = 0; t < 2; ++t) { const unsigned q_ = (unsigned)(fr >> 2), p_ = (unsigned)(fr & 3), row = 8u * (unsigned)fq + 4u * (unsigned)t + q_, ch = 2u * (unsigned)cb + (p_ >> 1);
            tra[cb][t] = (unsigned)(size_t)vt + 256u * row + 16u * (ch ^ (((row & 3u) << 2) | ((row >> 2) & 3u))) + 8u * (p_ & 1u); }
    for (int m = 0;; ++m) {
#ifdef ATTN_BLOCKED_XCD
        const int kk_ = wid + 8 * m; if (kk_ >= 256 || G != 256) { if (G == 256) break; }
        const int pair = c >> 5, t = (c & 31) + 32 * kk_, b = pair >> 2, g = pair & 3;
#else
        const int jdx = c + G * (wid + 8 * m); if (jdx >= T * 4) break;
        const int pair = jdx & 7, t = jdx >> 3, b = pair >> 2, g = pair & 3;
#endif
        const size_t tok = (size_t)b * SEQ + t; const int nvalid = (t + 1) < 256 ? (t + 1) : 256;
        int s0 = SEL[tok * 256 + lane], s1 = SEL[tok * 256 + 64 + lane], s2 = SEL[tok * 256 + 128 + lane], s3 = SEL[tok * 256 + 192 + lane];
        s0 = s0 < 0 ? 0 : s0; s1 = s1 < 0 ? 0 : s1; s2 = s2 < 0 ? 0 : s2; s3 = s3 < 0 ? 0 : s3;
        bf16x8 qf[4];
#pragma unroll
        for (int ks = 0; ks < 4; ++ks) { qf[ks] = (bf16x8){0, 0, 0, 0, 0, 0, 0, 0}; if (fr < 4) qf[ks] = *(const bf16x8*)(DP + tok * DSA_NP + (g * 4 + fr) * 128 + ks * 32 + fq * 8); }
        const bf16_t* kbase = DP + (size_t)b * SEQ * DSA_NP + 2048 + g * 128 + fq * 8;
        f32x4 acc[16];
#pragma unroll
        for (int j = 0; j < 16; ++j) {
            const int sreg = (j < 4) ? s0 : (j < 8) ? s1 : (j < 12) ? s2 : s3;
            const int idx = shi(sreg, (16 * j + fr) & 63);
            const bf16_t* kr = kbase + (size_t)idx * DSA_NP;
            const bf16x8 a0 = *(const bf16x8*)kr, a1 = *(const bf16x8*)(kr + 32), a2 = *(const bf16x8*)(kr + 64), a3 = *(const bf16x8*)(kr + 96);
            f32x4 a = {0.f, 0.f, 0.f, 0.f};
            a = __builtin_amdgcn_mfma_f32_16x16x32_bf16(a0, qf[0], a, 0, 0, 0);
            a = __builtin_amdgcn_mfma_f32_16x16x32_bf16(a1, qf[1], a, 0, 0, 0);
            a = __builtin_amdgcn_mfma_f32_16x16x32_bf16(a2, qf[2], a, 0, 0, 0);
            a = __builtin_amdgcn_mfma_f32_16x16x32_bf16(a3, qf[3], a, 0, 0, 0);
            acc[j] = a;
            if ((j & 7) == 7) asm volatile("" ::: "memory");
        }
        const bf16_t* vbase = DP + (size_t)b * SEQ * DSA_NP + 2560 + g * 128 + fr * 8;
        u32x4 vcur[8], vnxt[8], vnn[8];
#define ATTN_VLOAD(dst, ks) do { const int sreg_ = ((ks) < 2) ? s0 : ((ks) < 4) ? s1 : ((ks) < 6) ? s2 : s3; _Pragma("unroll") for (int i = 0; i < 8; ++i) { \
            const int idx_ = shi(sreg_, 32 * ((ks) & 1) + fq + 4 * i); dst[i] = *(const u32x4*)(vbase + (size_t)idx_ * DSA_NP); } } while (0)
        ATTN_VLOAD(vcur, 0); ATTN_VLOAD(vnxt, 1);
        float mx = -__builtin_inff();
#pragma unroll
        for (int j = 0; j < 16; ++j)
#pragma unroll
            for (int r = 0; r < 4; ++r) { const int slot = 16 * j + 4 * fq + r; const float sv = (slot < nvalid) ? acc[j][r] * 0.08838834764831845f : -__builtin_inff(); acc[j][r] = sv; mx = fmaxf(mx, sv); }
        mx = fmaxf(mx, shx(mx, 16, lane)); mx = fmaxf(mx, shx(mx, 32, lane));
        float sum = 0.f;
#pragma unroll
        for (int j = 0; j < 16; ++j)
#pragma unroll
            for (int r = 0; r < 4; ++r) { const float pv = __expf(acc[j][r] - mx); acc[j][r] = pv; sum += pv; }
        sum += shx(sum, 16, lane); sum += shx(sum, 32, lane);
        const float inv = 1.0f / sum;
        if (fr < 4) {
#pragma unroll
            for (int j = 0; j < 16; ++j) { u32x2 w; w.x = cvt_pk_bf16(acc[j][0] * inv, acc[j][1] * inv); w.y = cvt_pk_bf16(acc[j][2] * inv, acc[j][3] * inv);
                *(LAS u32x2*)(pl + (fr * 256 + 16 * j + 4 * fq) * 2) = w; }
        }
        f32x4 oc[8];
#pragma unroll
        for (int cb = 0; cb < 8; ++cb) oc[cb] = (f32x4){0.f, 0.f, 0.f, 0.f};
#pragma unroll
        for (int ks = 0; ks < 8; ++ks) {
            if (ks < 6) ATTN_VLOAD(vnn, ks + 2);
#pragma unroll
            for (int i = 0; i < 8; ++i) { const unsigned row = (unsigned)(fq + 4 * i), ch = (unsigned)fr;
                *(LAS u32x4*)(vt + 256u * row + 16u * (ch ^ (((row & 3u) << 2) | ((row >> 2) & 3u)))) = vcur[i]; }
            bf16x8 pa = (bf16x8){0, 0, 0, 0, 0, 0, 0, 0};
            asm volatile("s_waitcnt lgkmcnt(0)" ::: "memory");
            if (fr < 4) pa = *(const LAS bf16x8*)(pl + (fr * 256 + 32 * ks + 8 * fq) * 2);
            u32x2 t0[8], t1[8];
#pragma unroll
            for (int cb = 0; cb < 8; ++cb) {
                asm volatile("ds_read_b64_tr_b16 %0, %1" : "=v"(t0[cb]) : "v"(tra[cb][0]) : "memory");
                asm volatile("ds_read_b64_tr_b16 %0, %1" : "=v"(t1[cb]) : "v"(tra[cb][1]) : "memory");
            }
            asm volatile("s_waitcnt lgkmcnt(0)" : "+v"(t0[0]), "+v"(t0[1]), "+v"(t0[2]), "+v"(t0[3]), "+v"(t0[4]), "+v"(t0[5]), "+v"(t0[6]), "+v"(t0[7]),
                                                  "+v"(t1[0]), "+v"(t1[1]), "+v"(t1[2]), "+v"(t1[3]), "+v"(t1[4]), "+v"(t1[5]), "+v"(t1[6]), "+v"(t1[7]), "+v"(pa) :: "memory");
#pragma unroll
            for (int cb = 0; cb < 8; ++cb) { const u32x4 bw = {t0[cb].x, t0[cb].y, t1[cb].x, t1[cb].y};
                oc[cb] = __builtin_amdgcn_mfma_f32_16x16x32_bf16(pa, __builtin_bit_cast(bf16x8, bw), oc[cb], 0, 0, 0); }
#pragma unroll
            for (int i = 0; i < 8; ++i) { vcur[i] = vnxt[i]; vnxt[i] = vnn[i]; }
        }
#undef ATTN_VLOAD
        if (fq == 0) {
            bf16_t* op = O + tok * D + (g * 4) * 128 + fr;
#pragma unroll
            for (int cb = 0; cb < 8; ++cb)
#pragma unroll
                for (int r = 0; r < 4; ++r) op[r * 128 + 16 * cb] = (bf16_t)f2bf(oc[cb][r]);
        }
        asm volatile("s_waitcnt lgkmcnt(0)" ::: "memory");
    }
}


#define XB_TMO      128
#define XB_XCNT(j)  (256  + 64 * (j))
#define XB_XSUB(j)  (1280 + 64 * (j))
#define XB_XGEN(j)  (2304 + 64 * (j))
#define XB_TOP      3328
#define XB_TOPGEN   3392
#define XB_SPIN_CAP (1u << 22)
__device__ __forceinline__ unsigned xb_ld(unsigned* p)              { return __hip_atomic_load(p, __ATOMIC_RELAXED, __HIP_MEMORY_SCOPE_AGENT); }
__device__ __forceinline__ unsigned xb_add(unsigned* p, unsigned v) { return __hip_atomic_fetch_add(p, v, __ATOMIC_RELAXED, __HIP_MEMORY_SCOPE_AGENT); }
__device__ __forceinline__ unsigned xb_xcc_id() { return (unsigned)__builtin_amdgcn_s_getreg((3 << 11) | 20) & 0xFu; }
#define XB_SPIN(cond, bar) do { unsigned _sp = 0; while (cond) { __builtin_amdgcn_s_sleep(1); \
    if ((++_sp & 255u) == 0u) { if (xb_ld(&(bar)[XB_TMO])) break; if (_sp > XB_SPIN_CAP) { atomicAdd(&(bar)[XB_TMO], 1u); break; } } } } while (0)
__device__ __forceinline__ void xcd_barrier_complete(unsigned* bar, unsigned x, unsigned& nloc, unsigned& nx) {
    const unsigned G = gridDim.x;
    unsigned sum, cnt, mine, sp = 0u;
    for (;;) {
        sum = 0u; cnt = 0u; mine = 0u;
#pragma unroll
        for (unsigned j = 0; j < 16; ++j) { const unsigned cc = xb_ld(&bar[XB_XCNT(j)]); sum += cc; cnt += (cc > 0u) ? 1u : 0u; mine = (j == x) ? cc : mine; }
        if (sum == G) break;
        __builtin_amdgcn_s_sleep(1);
        if ((++sp & 255u) == 0u) { if (xb_ld(&bar[XB_TMO])) break; if (sp > XB_SPIN_CAP) { atomicAdd(&bar[XB_TMO], 1u); break; } }
    }
    nloc = mine > 0u ? mine : 1u; nx = cnt > 0u ? cnt : 1u;
}
__device__ __forceinline__ void xcd_barrier(unsigned* bar, volatile LAS unsigned* st, int widk) {
    asm volatile("s_waitcnt vmcnt(0)" ::: "memory");
    __syncthreads();
    if (opaque_tid(widk) == 0) {
        __builtin_amdgcn_s_waitcnt(0);
        const unsigned x = xb_xcc_id();
        unsigned nloc = st[0], nx = st[1];
        if (nloc == 0u) { xcd_barrier_complete(bar, x, nloc, nx); st[0] = nloc; st[1] = nx; }
        const unsigned old = xb_add(&bar[XB_XSUB(x)], 1u);
        const unsigned gen = old / nloc;
        if (old + 1u == (gen + 1u) * nloc) {
            __builtin_amdgcn_fence(__ATOMIC_RELEASE, "agent");
            asm volatile("s_waitcnt vmcnt(0)" ::: "memory");
            const unsigned og = xb_add(&bar[XB_TOP], 1u);
            const unsigned tg = og / nx;
            if (og + 1u == (tg + 1u) * nx) xb_add(&bar[XB_TOPGEN], 1u);
            else XB_SPIN(xb_ld(&bar[XB_TOPGEN]) == tg, bar);
            __builtin_amdgcn_fence(__ATOMIC_ACQUIRE, "agent");
            xb_add(&bar[XB_XGEN(x)], 1u);
            asm volatile("s_waitcnt vmcnt(0)" ::: "memory");
        } else {
            XB_SPIN(xb_ld(&bar[XB_XGEN(x)]) == gen, bar);
            __builtin_amdgcn_fence(__ATOMIC_ACQUIRE, "agent");
            asm volatile("s_waitcnt vmcnt(0)" ::: "memory");
        }
    }
    __syncthreads();
}
#ifndef EN_MASK
#define EN_MASK 0xFFFFFF
#endif
#define EN(b) ((EN_MASK >> (b)) & 1)
#ifndef REP_MASK
#define REP_MASK 0
#endif
#define REPN(b) (1 + ((REP_MASK >> (b)) & 1))
__device__ __forceinline__ const void* ldp(LAS unsigned char* lds, int i) {
    const LAS unsigned* q = (const LAS unsigned*)(lds + 143360) + 2 * i;
    const unsigned lo = __builtin_amdgcn_readfirstlane(q[0]), hi = __builtin_amdgcn_readfirstlane(q[1]);
    return (const void*)(((unsigned long long)hi << 32) | lo);
}
#ifdef CGSYNC
#define GSYNC() grid.sync()
#else
#define GSYNC() do { for (int _r = 0; _r < REPN(20); ++_r) xcd_barrier((unsigned*)(WSP + OFF_CTL), (volatile LAS unsigned*)(lds + LDS_BAR_OFF), widk); } while (0)
#endif

__global__ void __launch_bounds__(512, 2) mega_fwd(Params P) {
    extern __shared__ __attribute__((aligned(16))) unsigned char lds_raw[];
    LAS unsigned char* lds = (LAS unsigned char*)lds_raw;
    cg::grid_group grid = cg::this_grid();
    const int G = gridDim.x, c = blockIdx.x;
    const int widk = __builtin_amdgcn_readfirstlane(threadIdx.x >> 6);
    if (threadIdx.x == 0) { ((LAS unsigned*)(lds + LDS_BAR_OFF))[0] = 0u; ((LAS unsigned*)(lds + LDS_BAR_OFF))[1] = 0u; }
    if (blockIdx.x == 0) for (int i = threadIdx.x; i < 3456; i += 512) __hip_atomic_store((unsigned*)(P.ws + OFF_CTL) + i, 0u, __ATOMIC_RELAXED, __HIP_MEMORY_SCOPE_AGENT);
    grid.sync();
    if (threadIdx.x == 0) (void)xb_add((unsigned*)(P.ws + OFF_CTL) + XB_XCNT(xb_xcc_id()), 1u);

#ifdef LDSP
    {
        LAS unsigned long long* PL = (LAS unsigned long long*)(lds + 143360);
        if (threadIdx.x == 0) { const unsigned long long* src = (const unsigned long long*)&P;
#pragma unroll
            for (int i = 0; i < 26; ++i) PL[i] = src[i]; }
        __syncthreads();
    }
#endif
#ifdef LDSP
#define PF(i) ((const float*)ldp(lds, (i)))
#else
#define PF(i) (((const float* const*)&P)[(i)])
#endif
#ifdef LDSP
#define WSP ((unsigned char*)ldp(lds, 25))
#else
#define WSP (P.ws)
#endif
#define XF ((float*)(WSP + OFF_XF))
#define XB ((bf16_t*)(WSP + OFF_XB))
#define PB ((bf16_t*)(WSP + OFF_PB))
#define PLEB ((bf16_t*)(WSP + OFF_PLE))
#define HB ((bf16_t*)(WSP + OFF_H))
#define ACTB ((bf16_t*)(WSP + OFF_ACT))
#define OB ((bf16_t*)(WSP + OFF_O))
#define KTT ((bf16_t*)(WSP + OFF_KTT))
#define SEL ((int*)(WSP + OFF_SEL))
#define XA ((float*)(WSP + OFF_XA))
#define SSQ ((float*)(WSP + OFF_SSQ))
#define DL ((float*)(WSP + OFF_DL))
#define KIN ((bf16_t*)(WSP + OFF_KIN))
#define WB ((bf16_t*)(WSP + OFF_W))
#define QKVR ((bf16_t*)(WSP + OFF_QKVR))
#define BP ((bf16_t*)(WSP + OFF_BP))
#define UT ((float*)(WSP + OFF_UT))
#define KT ((bf16_t*)(WSP + OFF_KT))
#define AP PLEB
#define STB ((float*)(WSP + OFF_ST))
#define PPB ((bf16_t*)(WSP + OFF_PP))


    for (int rep = 0; rep < REPN(12); ++rep) {
        IDX_SETUP
        LAS unsigned* scr = (LAS unsigned*)(lds + wid * 16384);
        if (EN(12)) {
#pragma unroll 1
        for (int j = 0; j < 2; ++j) {
            TJOB(PF(2) + (size_t)j * D * GLA_N, D, GLA_N, WB + W_GIN + (size_t)j * GLA_N * D, 0);
            TJOB(PF(7) + (size_t)j * D * D, D, D, WB + W_GO + (size_t)j * D * D, 0);
        }
#pragma unroll 1
        for (int g = 0; g < 4; ++g) TJOB(PF(8) + (size_t)g * 512 * 512, 512, 512, WB + W_POOL, g * 512);
        TJOB(PF(10), D, DSA_N, WB + W_DIN, 0);
        TJOB(PF(13), D, D, WB + W_DO, 0);
#pragma unroll 1
        for (int i = 0; i < 4; ++i) {
            TJOB(PF(16) + (size_t)i * D * NUP, D, NUP, WB + W_UP + (size_t)i * NUP * D, 0);
            TJOB(PF(19) + (size_t)i * DFF * D, DFF, D, WB + W_DOWN + (size_t)i * D * DFF, 0);
            TJOB(PF(20) + (size_t)i * D * D, D, D, WB + W_GATE + (size_t)i * D * D, 0);
            TJOB(PF(21) + (size_t)i * PLE * D, PLE, D, WB + W_PROJ + (size_t)i * D * PLE, 0);
        }
        }
        if (EN(13)) row_pass(PF(0), nullptr, nullptr, nullptr, XB, nullptr, widk);
        for (size_t i = (size_t)gt; i < (size_t)4 * T * PLE / 4; i += (size_t)NT) { const f32x4 v = ((const f32x4*)PF(1))[i]; u32x2 w; w.x = cvt_pk_bf16(v.x, v.y); w.y = cvt_pk_bf16(v.z, v.w); ((u32x2*)PB)[i] = w; }
    }
    GSYNC();

#pragma unroll 1
    for (int layer = 0; layer < 4; ++layer) {
        const int kind = layer % 3, jl = layer / 3;
        const float* xsrc = (layer == 0) ? PF(0) : XF;
        if (kind != 1) {
            if (kind == 0) for (int rep = 0; rep < REPN(21); ++rep) xa_pass(XB, PF(3) + (size_t)jl * D * 16, XA, widk);
            const int N = (kind == 0) ? GLA_N : DSA_NP;
            pg8::PlainSched S; S.o.init(T / 256, N / 256, G, c); S.A = (const char*)XB; S.B = (const char*)(kind == 0 ? WB + W_GIN + (size_t)jl * GLA_N * D : WB + W_DIN);
            S.tsA = (size_t)256 * D * 2; S.tsB = (size_t)256 * D * 2; S.poolmode = 0;
            pg8::EpiBf16<0> E{HB, N};
            for (int rep = 0; rep < REPN(14); ++rep) pg8::gemm_phase(lds, D, D, D, S, E, widk);
            GSYNC();
        }
        if (kind == 0) {
            for (int rep = 0; rep < REPN(0); ++rep) gla_prep(QKVR, XA, PF(4) + (size_t)jl * 16 * 1024, PF(5) + (size_t)jl * 1024, AP, KT, KTT, DL, lds, widk);
            for (int rep = 0; rep < REPN(1); ++rep) gla_vt(QKVR, BP, lds, widk);
            { IDX_SETUP for (int i = gt; i < T * 4; i += NT) SSQ[i] = 0.f; }
            GSYNC();
            for (int rep = 0; rep < REPN(2); ++rep) { GlaScoreSched S{G, c, AP, KT}; GlaScoreEpi E{AP}; pg8::gemm_phase(lds, 256, 2048, 1024, S, E, widk); }
            for (int rep = 0; rep < REPN(3); ++rep) { GlaUSched S{G, c, BP, KTT}; GlaUEpi E{UT, DL}; pg8::gemm_phase(lds, 256, 512, SEQ, S, E, widk); }
            GSYNC();
            for (int rep = 0; rep < REPN(4); ++rep) gla_scan(UT, DL, BP, widk);
            GSYNC();
            if (EN(5)) { GlaOSched S{G, c, AP, BP}; GlaOEpi E{OB, SSQ}; pg8::gemm_phase(lds, 512, 2048, 512, S, E, widk); }
            GSYNC();
            if (EN(6)) gla_gate(OB, SSQ, QKVR, PF(6) + (size_t)jl * D, widk);
            GSYNC();
        } else if (kind == 1) {
            for (int rep = 0; rep < REPN(7); ++rep) pool_pass(XB, OB, widk);
            GSYNC();
        } else {
            for (int rep = 0; rep < REPN(8); ++rep) dsa_kin(HB, PF(11), PF(12), KIN, widk);
            GSYNC();
            for (int rep = 0; rep < REPN(9); ++rep) dsa_topk(HB, KIN, SEL, lds, widk);
            GSYNC();
            for (int rep = 0; rep < REPN(10); ++rep) dsa_attn(HB, SEL, OB, lds, widk);
            GSYNC();
        }
        {
            pg8::PlainSched S; S.o.init(T / 256, D / 256, G, c); S.A = (const char*)OB;
            S.B = (const char*)(kind == 0 ? WB + W_GO + (size_t)jl * D * D : kind == 1 ? WB + W_POOL : WB + W_DO);
            const int K = (kind == 1) ? 512 : D;
            S.tsA = (size_t)256 * D * 2; S.tsB = (size_t)256 * K * 2; S.poolmode = (kind == 1);
            pg8::EpiResid E{xsrc, XF, (kind == 1) ? PF(9) : nullptr, nullptr, nullptr, (layer == 0) ? nullptr : STB, PF(22) + (size_t)(layer - 1) * D, PF(23) + (size_t)(layer - 1) * D};
            if (REPN(15) > 1) { pg8::EpiResid E2{xsrc, (float*)HB, (kind == 1) ? PF(9) : nullptr, nullptr, nullptr, (layer == 0) ? nullptr : STB, PF(22) + (size_t)(layer - 1) * D, PF(23) + (size_t)(layer - 1) * D}; pg8::gemm_phase(lds, K, D, K, S, E2, widk); }
            if (EN(15)) pg8::gemm_phase(lds, K, D, K, S, E, widk);
        }
        GSYNC();
        if (EN(13)) row_pass(XF, PF(14) + (size_t)layer * D, PF(15) + (size_t)layer * D, nullptr, XB, STB, widk);
        if (REPN(13) > 1) row_pass(XF, PF(14) + (size_t)layer * D, PF(15) + (size_t)layer * D, (float*)HB, OB, nullptr, widk);
        GSYNC();
#pragma unroll 1
        for (int gi = 0; gi < 2; ++gi) {
            const int N = gi == 0 ? NUP : D;
            pg8::PlainSched S; S.o.init(T / 256, N / 256, G, c); S.A = (const char*)XB;
            S.B = (const char*)(gi == 0 ? WB + W_UP + (size_t)layer * NUP * D : WB + W_GATE + (size_t)layer * D * D);
            S.tsA = (size_t)256 * D * 2; S.tsB = (size_t)256 * D * 2; S.poolmode = 0;
            if (gi == 0) { pg8::EpiBf16<0> E{HB, NUP}; for (int rep = 0; rep < REPN(16); ++rep) pg8::gemm_phase(lds, D, D, D, S, E, widk); }
            else { pg8::EpiBf16<2> E{PLEB, D}; for (int rep = 0; rep < REPN(17); ++rep) pg8::gemm_phase(lds, D, D, D, S, E, widk); }
        }
        {
            pg8::PlainSched S; S.o.init(T / 256, D / 256, G, c); S.A = (const char*)(PB + (size_t)layer * T * PLE); S.B = (const char*)(WB + W_PROJ + (size_t)layer * D * PLE);
            S.tsA = (size_t)256 * PLE * 2; S.tsB = (size_t)256 * PLE * 2; S.poolmode = 0;
            pg8::EpiBf16<0> E{PPB, D};
            for (int rep = 0; rep < REPN(18); ++rep) pg8::gemm_phase(lds, PLE, PLE, PLE, S, E, widk);
        }
        GSYNC();
        for (int rep = 0; rep < REPN(11); ++rep) conv_pass(HB, PF(17) + (size_t)layer * 3 * NUP, PF(18) + (size_t)layer * NUP, ACTB, widk);
        GSYNC();
        {
            pg8::PlainSched S; S.o.init(T / 256, D / 256, G, c); S.A = (const char*)ACTB; S.B = (const char*)(WB + W_DOWN + (size_t)layer * D * DFF);
            S.tsA = (size_t)256 * DFF * 2; S.tsB = (size_t)256 * DFF * 2; S.poolmode = 0;
            pg8::EpiResid E{XF, XF, nullptr, PLEB, PPB, STB, PF(14) + (size_t)layer * D, PF(15) + (size_t)layer * D};
            if (REPN(19) > 1) { pg8::EpiResid E2{XF, (float*)HB, nullptr, PLEB, PPB, STB, PF(14) + (size_t)layer * D, PF(15) + (size_t)layer * D}; pg8::gemm_phase(lds, DFF, DFF, DFF, S, E2, widk); }
            if (EN(19)) pg8::gemm_phase(lds, DFF, DFF, DFF, S, E, widk);
        }
        GSYNC();
        if (!EN(13)) {} else if (layer == 3) row_pass(XF, PF(22) + (size_t)layer * D, PF(23) + (size_t)layer * D, ((float*)PF(24)), nullptr, nullptr, widk);
        else row_pass(XF, PF(22) + (size_t)layer * D, PF(23) + (size_t)layer * D, nullptr, XB, STB, widk);
        if (layer != 3) GSYNC();
    }
}

extern "C" void kernel_launch(void* const* d_in, const int* in_sizes, int n_in, void* d_out, int out_size, void* d_ws, size_t ws_size, hipStream_t stream) {
    static int grid = 0;
    if (grid == 0) {
        if (n_in != 24 || out_size != T * D || ws_size < WS_END) { fprintf(stderr, "kernel_launch: unexpected problem (n_in %d, out %d, ws %zu < %zu)\n", n_in, out_size, ws_size, (size_t)WS_END); grid = -1; return; }
        int dev = 0, cus = 0, per_cu = 0;
        (void)hipGetDevice(&dev); (void)hipDeviceGetAttribute(&cus, hipDeviceAttributeMultiprocessorCount, dev);
        if (hipFuncSetAttribute((const void*)mega_fwd, hipFuncAttributeMaxDynamicSharedMemorySize, LDS_BYTES) != hipSuccess) { fprintf(stderr, "kernel_launch: hipFuncSetAttribute failed\n"); grid = -1; return; }
        if (hipOccupancyMaxActiveBlocksPerMultiprocessor(&per_cu, (const void*)mega_fwd, 512, LDS_BYTES) != hipSuccess || per_cu < 1) { fprintf(stderr, "kernel_launch: occupancy query says %d blocks/CU\n", per_cu); per_cu = 1; }
        (void)hipGetLastError();
        grid = cus;
    }
    if (grid < 0) return;
    Params p{};
    const float** pf = (const float**)&p;
    for (int i = 0; i < 24; ++i) pf[i] = (const float*)d_in[i];
    p.out = (float*)d_out; p.ws = (unsigned char*)d_ws;
    void* args[] = {&p};
    hipError_t e = hipLaunchCooperativeKernel((const void*)mega_fwd, dim3(grid), dim3(512), args, LDS_BYTES, stream);
    if (e != hipSuccess) fprintf(stderr, "kernel_launch: cooperative launch failed: %s (grid %d)\n", hipGetErrorString(e), grid);
}
```

```cpp
#include <hip/hip_runtime.h>
#include <hip/hip_cooperative_groups.h>
#include <cstdio>
namespace cg = cooperative_groups;

#define LAS __attribute__((address_space(3)))
typedef unsigned short bf16_t;
typedef short bf16x8 __attribute__((ext_vector_type(8)));
typedef float f32x4 __attribute__((ext_vector_type(4)));
typedef float f32x2 __attribute__((ext_vector_type(2)));
typedef unsigned u32x4 __attribute__((ext_vector_type(4)));
typedef unsigned u32x2 __attribute__((ext_vector_type(2)));

constexpr int T = 16384, SEQ = 8192, D = 2048, DFF = 5504, NUP = 11008, PLE = 256;
constexpr int GLA_N = 6144, DSA_N = 4176, DSA_NP = 4352;
constexpr float LN_EPS = 1e-5f;
constexpr float ALPHA = 1.681792830507429f;

constexpr size_t OFF_XF = 0;
constexpr size_t OFF_XB = OFF_XF + (size_t)T * D * 4;
constexpr size_t OFF_PB = OFF_XB + (size_t)T * D * 2;
constexpr size_t OFF_PLE = OFF_PB + (size_t)4 * T * PLE * 2;
constexpr size_t OFF_H = OFF_PLE + (size_t)T * D * 2;
constexpr size_t OFF_ACT = OFF_H + (size_t)T * NUP * 2;
constexpr size_t OFF_O = OFF_ACT + (size_t)T * DFF * 2;
constexpr size_t OFF_KTT = OFF_O + (size_t)T * D * 2;
constexpr size_t OFF_SEL = OFF_KTT + (size_t)T * 1024 * 2;
constexpr size_t OFF_XA = OFF_SEL + (size_t)T * 256 * 4;
constexpr size_t OFF_SSQ = OFF_XA + (size_t)T * 16 * 4;
constexpr size_t OFF_DL = OFF_SSQ + (size_t)T * 4 * 4;
constexpr size_t OFF_KIN = OFF_DL + (size_t)8 * 32 * 256 * 4;
constexpr size_t OFF_PP = OFF_KIN + (size_t)T * 64 * 2;
constexpr size_t OFF_CTL = OFF_PP + (size_t)T * D * 2;
constexpr size_t CTL_BYTES = 65536;
constexpr size_t OFF_ST = OFF_CTL + CTL_BYTES;
constexpr size_t OFF_W = OFF_ST + (size_t)T * 8;
constexpr size_t W_GIN = 0;
constexpr size_t W_GO = W_GIN + (size_t)2 * GLA_N * D;
constexpr size_t W_POOL = W_GO + (size_t)2 * D * D;
constexpr size_t W_DIN = W_POOL + (size_t)D * 512;
constexpr size_t W_DO = W_DIN + (size_t)DSA_NP * D;
constexpr size_t W_UP = W_DO + (size_t)D * D;
constexpr size_t W_DOWN = W_UP + (size_t)4 * NUP * D;
constexpr size_t W_GATE = W_DOWN + (size_t)4 * D * DFF;
constexpr size_t W_PROJ = W_GATE + (size_t)4 * D * D;
constexpr size_t W_END = W_PROJ + (size_t)4 * D * PLE;
constexpr size_t WS_END = OFF_W + W_END * 2;
constexpr size_t OFF_QKVR = OFF_H;
constexpr size_t OFF_BP = OFF_H + (size_t)T * GLA_N * 2;
constexpr size_t OFF_UT = OFF_ACT;
constexpr size_t OFF_KT = OFF_ACT + (size_t)8 * 32 * 512 * 256 * 4;
static_assert(OFF_BP + (size_t)8 * 32 * 512 * 512 * 2 <= OFF_ACT, "GLA overlay 1");
static_assert(OFF_KT + (size_t)T * 1024 * 2 <= OFF_O, "GLA overlay 2");

constexpr int LDS_BYTES = 147456;
constexpr int LDS_BAR_OFF = LDS_BYTES - 64;

__device__ __forceinline__ float bf2f(unsigned short b) { return __uint_as_float(((unsigned)b) << 16); }
__device__ __forceinline__ unsigned f2bf(float f) { unsigned u = __float_as_uint(f); return (u + 0x7fffu + ((u >> 16) & 1u)) >> 16; }
__device__ __forceinline__ unsigned cvt_pk_bf16(float lo, float hi) { unsigned r; asm volatile("v_cvt_pk_bf16_f32 %0, %1, %2" : "=v"(r) : "v"(lo), "v"(hi)); return r; }
__device__ __forceinline__ float lo16(unsigned w) { return __uint_as_float(w << 16); }
__device__ __forceinline__ float hi16(unsigned w) { return __uint_as_float(w & 0xffff0000u); }
__device__ __forceinline__ float shx(float v, int m, int lane) { return __int_as_float(__builtin_amdgcn_ds_bpermute((lane ^ m) << 2, __float_as_int(v))); }
__device__ __forceinline__ int shi(int v, int src) { return __builtin_amdgcn_ds_bpermute(src << 2, v); }
__device__ __forceinline__ float wave_sum(float v, int lane) {
#pragma unroll
    for (int o = 1; o < 64; o <<= 1) v += shx(v, o, lane);
    return v;
}
__device__ __forceinline__ f32x2 gelu_pk(f32x2 v) {
    const f32x2 av = __builtin_elementwise_abs(v), d = av * 0.2316418882f + 1.0f;
    f32x2 t; t.x = __builtin_amdgcn_rcpf(d.x); t.y = __builtin_amdgcn_rcpf(d.y);
    f32x2 q = t * 0.5307027145f + (-0.7265760135f); q = q * t + 0.7107068705f; q = q * t + (-0.142248368f); q = q * t + 0.127414796f; q = q * t;
    const f32x2 s = (v * v) * (-0.72134752044f);
    f32x2 e; e.x = __builtin_amdgcn_exp2f(s.x); e.y = __builtin_amdgcn_exp2f(s.y);
    const f32x2 m = v * (q * e), r = v - m;
    f32x2 o; o.x = v.x < 0.f ? m.x : r.x; o.y = v.y < 0.f ? m.y : r.y; return o;
}
__device__ __forceinline__ float sigmoidf_(float x) { return 1.0f / (1.0f + __expf(-x)); }

__device__ __forceinline__ int lane_asm() { int l; asm volatile("v_mbcnt_lo_u32_b32 %0, -1, 0\n\tv_mbcnt_hi_u32_b32 %0, -1, %0" : "=&v"(l)); return l; }
__device__ __forceinline__ int opaque_tid(int widk) { asm volatile("" : "+s"(widk)); int l; asm volatile("v_mbcnt_lo_u32_b32 %0, -1, 0\n\tv_mbcnt_hi_u32_b32 %0, -1, %0" : "=&v"(l)); return (widk << 6) | l; }
__device__ __forceinline__ int opaque_s(int v) { v = __builtin_amdgcn_readfirstlane(v); asm volatile("" : "+s"(v)); return v; }
#define IDX_SETUP const int tid = opaque_tid(widk), lane = tid & 63, wid = __builtin_amdgcn_readfirstlane(tid >> 6); const int G = opaque_s(gridDim.x), c = opaque_s(blockIdx.x); \
    const int gw = c * 8 + wid, NGW = G * 8, gt = c * 512 + tid, NT = G * 512; (void)lane; (void)wid; (void)gw; (void)NGW; (void)gt; (void)NT;
namespace pg8 {
constexpr int BM = 256, BK = 64, HALF = 128, HTB = HALF * BK * 2, NXCD = 8, WGM = 4;
__host__ __device__ __forceinline__ int lds_byte(int r, int c) { const int st = (r >> 4) * 2 + (c >> 5), rr = r & 15, cc = c & 31, ob = rr * 64 + cc * 2; return st * 1024 + (ob ^ (((ob >> 9) & 1) << 5)); }
__host__ __device__ __forceinline__ void stage_rc(int b, int& R, int& C) { const int st = b / 1024, sb = b % 1024, swz = sb ^ (((sb >> 9) & 1) << 5); R = (st >> 1) * 16 + swz / 64; C = (st & 1) * 32 + (swz % 64) / 2; }
__host__ __device__ __forceinline__ int perm32(int rho) { const int n = rho >> 4, i = rho & 15; return 8 * (i >> 2) + 4 * n + (i & 3); }

struct Unit { int pm, pn; const char* A; const char* B; };

struct TileOrder {
    int nM, nN, nwg, G, c;
    __device__ __forceinline__ void init(int nM_, int nN_, int G_, int c_) { nM = nM_; nN = nN_; nwg = nM * nN; G = G_; c = c_; }
    __device__ __forceinline__ bool next(int i, int& pm, int& pn) const {
        const long L = (long)i * G + c; if (L >= nwg) return false;
        int wgid = (int)L; { const int q = nwg / NXCD, r = nwg % NXCD, xcd = wgid % NXCD, off = wgid / NXCD; wgid = (xcd < r ? xcd * (q + 1) : r * (q + 1) + (xcd - r) * q) + off; }
        const int nig = WGM * nN, gid = wgid / nig, fm = gid * WGM, gsz = (nM - fm) < WGM ? (nM - fm) : WGM;
        pm = fm + ((wgid % nig) % gsz); pn = (wgid % nig) / gsz; return true;
    }
};
struct PlainSched {
    TileOrder o; const char* A; const char* B; size_t tsA, tsB; int poolmode;
    __device__ __forceinline__ bool next(int i, Unit& u) const {
        if (!o.next(i, u.pm, u.pn)) return false;
        u.A = A + (size_t)u.pm * tsA + (poolmode ? (size_t)(u.pn >> 1) * 1024 : 0); u.B = B + (size_t)u.pn * tsB; return true;
    }
};

template <int ACT  > struct EpiBf16 {
    static constexpr bool PERM = true;
    bf16_t* O; int ldc;
    __device__ __forceinline__ void operator()(const f32x4 (&acc)[2][2][4][2], const Unit& u, int wr, int wc, int fr, int fq) const {
        const int lane = lane_asm(); fr = lane & 15; fq = lane >> 4; (void)lane;
        const int row0 = u.pm * BM + wr * 64 + fr, col0 = u.pn * BM + wc * 32 + 8 * fq;
#pragma unroll
        for (int ai = 0; ai < 2; ++ai)
#pragma unroll
            for (int m = 0; m < 4; ++m) { bf16_t* rowp = O + (size_t)(row0 + ai * HALF + m * 16) * ldc + col0;
#pragma unroll
                for (int bj = 0; bj < 2; ++bj) { f32x4 v0 = acc[ai][bj][m][0], v1 = acc[ai][bj][m][1];
                    if (ACT == 2) {
#pragma unroll
                        for (int j = 0; j < 4; ++j) { v0[j] = sigmoidf_(v0[j]); v1[j] = sigmoidf_(v1[j]); } }
                    u32x4 w; w.x = cvt_pk_bf16(v0[0], v0[1]); w.y = cvt_pk_bf16(v0[2], v0[3]); w.z = cvt_pk_bf16(v1[0], v1[1]); w.w = cvt_pk_bf16(v1[2], v1[3]);
                    *(u32x4*)(rowp + bj * HALF) = w; } }
    }
};
struct EpiPleMul {
    static constexpr bool PERM = true;
    bf16_t* O; int ldc;
    __device__ __forceinline__ void operator()(const f32x4 (&acc)[2][2][4][2], const Unit& u, int wr, int wc, int fr, int fq) const {
        const int lane = lane_asm(); fr = lane & 15; fq = lane >> 4; (void)lane;
        const int row0 = u.pm * BM + wr * 64 + fr, col0 = u.pn * BM + wc * 32 + 8 * fq;
#pragma unroll
        for (int ai = 0; ai < 2; ++ai)
#pragma unroll
            for (int m = 0; m < 4; ++m) { bf16_t* rowp = O + (size_t)(row0 + ai * HALF + m * 16) * ldc + col0;
#pragma unroll
                for (int bj = 0; bj < 2; ++bj) { const f32x4 v0 = acc[ai][bj][m][0], v1 = acc[ai][bj][m][1];
                    const u32x4 g = *(const u32x4*)(rowp + bj * HALF);
                    u32x4 w; w.x = cvt_pk_bf16(v0[0] * lo16(g.x), v0[1] * hi16(g.x)); w.y = cvt_pk_bf16(v0[2] * lo16(g.y), v0[3] * hi16(g.y));
                    w.z = cvt_pk_bf16(v1[0] * lo16(g.z), v1[1] * hi16(g.z)); w.w = cvt_pk_bf16(v1[2] * lo16(g.w), v1[3] * hi16(g.w));
                    *(u32x4*)(rowp + bj * HALF) = w; }
                asm volatile("" ::: "memory"); }
    }
};
template <int NB  > struct EpiResidT {
    static constexpr bool PERM = false;
    const float* src; float* dst; const float* cscale; const bf16_t* ple; const bf16_t* ple2;
    const float* st; const float* lg; const float* lb;
    __device__ __forceinline__ void operator()(const f32x4 (&acc)[2][2][4][2], const Unit& u, int wr, int wc, int fr, int fq) const {
        const int lane = lane_asm(); fr = lane & 15; fq = lane >> 4; (void)lane;
        const int row0 = u.pm * BM + wr * 64 + fr, col0 = u.pn * BM + wc * 32 + 4 * fq;
#pragma unroll
        for (int ai = 0; ai < 2; ++ai)
#pragma unroll
            for (int mp = 0; mp < 4 / NB; ++mp) {
                f32x4 sv[NB][2][2]; u32x2 pv[NB][2][2], qv[NB][2][2]; f32x2 sr[NB];
#pragma unroll
                for (int mm = 0; mm < NB; ++mm) { const int m = NB * mp + mm; const size_t rr = (size_t)(row0 + ai * HALF + m * 16), off = rr * D + col0;
                    sr[mm] = (f32x2){0.f, 1.f}; if (st) sr[mm] = *(const f32x2*)(st + 2 * rr);
#pragma unroll
                    for (int bj = 0; bj < 2; ++bj)
#pragma unroll
                        for (int n = 0; n < 2; ++n) { const size_t o2 = off + bj * HALF + n * 16; sv[mm][bj][n] = *(const f32x4*)(src + o2);
                            if (NB == 2 && ple) { pv[mm][bj][n] = *(const u32x2*)(ple + o2); qv[mm][bj][n] = *(const u32x2*)(ple2 + o2); } } }
#pragma unroll
                for (int mm = 0; mm < NB; ++mm) { const int m = NB * mp + mm; const size_t off = (size_t)(row0 + ai * HALF + m * 16) * D + col0;
#pragma unroll
                    for (int bj = 0; bj < 2; ++bj)
#pragma unroll
                        for (int n = 0; n < 2; ++n) { const size_t o2 = off + bj * HALF + n * 16; f32x4 a = acc[ai][bj][m][n];
                            if (cscale) a = a * *(const f32x4*)(cscale + col0 + bj * HALF + n * 16);
                            if (NB == 2 && ple) { const u32x2 pw = pv[mm][bj][n], qw = qv[mm][bj][n];
                                a = a + (f32x4){lo16(pw.x) * lo16(qw.x), hi16(pw.x) * hi16(qw.x), lo16(pw.y) * lo16(qw.y), hi16(pw.y) * hi16(qw.y)}; }
                            f32x4 sx = sv[mm][bj][n];
                            if (st) sx = (sx - sr[mm].x) * sr[mm].y * *(const f32x4*)(lg + col0 + bj * HALF + n * 16) + *(const f32x4*)(lb + col0 + bj * HALF + n * 16);
                            *(f32x4*)(dst + o2) = sx * ALPHA + a; } }
                asm volatile("" ::: "memory");
            }
    }
};

typedef EpiResidT<2> EpiResid;

template <class Epi, class Sched>
__device__ __forceinline__ void gemm_phase(LAS unsigned char* lds, const int K, const int lda, const int ldb, const Sched& S, const Epi& E, int widk) {
    const int tid = opaque_tid(widk), wid = __builtin_amdgcn_readfirstlane(tid >> 6), lane = tid & 63, wr = wid >> 2, wc = wid & 3, fr = lane & 15, fq = lane >> 4;
    const int nt = K / BK;
    unsigned voffA[2], voffB[2];
#pragma unroll
    for (int i = 0; i < 2; ++i) { int R, C; stage_rc(tid * 16 + i * 8192, R, C); const int Rb = Epi::PERM ? ((R & ~31) + perm32(R & 31)) : R;
        voffA[i] = (unsigned)(R * lda + C) * 2u; voffB[i] = (unsigned)(Rb * ldb + C) * 2u; }
    const size_t kstep = (size_t)(BK * 2);
    const size_t hsA = (size_t)HALF * lda * 2, hsB = (size_t)HALF * ldb * 2;
    const unsigned ldsw = (unsigned)wid * 1024u;
    const int aoff = lds_byte(wr * 64 + fr, fq * 8), boff = lds_byte(wc * 32 + fr, fq * 8);
#define PG8_SA(b, h) (((b) * 2 + (h)) * HTB)
#define PG8_SB(b, h) ((4 + (b) * 2 + (h)) * HTB)
#define PG8_STAGE(bufoff, gbase, voff) do { _Pragma("unroll") for (int _i = 0; _i < 2; ++_i) \
        __builtin_amdgcn_global_load_lds((const unsigned*)((const char*)(gbase) + (voff)[_i]), (LAS unsigned*)(lds + (bufoff) + ldsw + _i * 8192), 16, 0, 0); } while (0)
#define PG8_LDA(dst, b, h) do { _Pragma("unroll") for (int m = 0; m < 4; ++m) _Pragma("unroll") for (int k = 0; k < 2; ++k) dst[m][k] = *(const LAS bf16x8*)(lds + PG8_SA(b, h) + aoff + m * 2048 + k * 1024); } while (0)
#define PG8_LDB(dst, b, h) do { _Pragma("unroll") for (int n = 0; n < 2; ++n) _Pragma("unroll") for (int k = 0; k < 2; ++k) dst[n][k] = *(const LAS bf16x8*)(lds + PG8_SB(b, h) + boff + n * 2048 + k * 1024); } while (0)
#define PG8_MMA(ai, bj, At, Bt) do { __builtin_amdgcn_s_setprio(1); _Pragma("unroll") for (int m = 0; m < 4; ++m) _Pragma("unroll") for (int n = 0; n < 2; ++n) _Pragma("unroll") for (int k = 0; k < 2; ++k) \
        acc[ai][bj][m][n] = __builtin_amdgcn_mfma_f32_16x16x32_bf16(Bt[n][k], At[m][k], acc[ai][bj][m][n], 0, 0, 0); __builtin_amdgcn_s_setprio(0); } while (0)
#define PG8_WAIT_V(n) asm volatile("s_waitcnt vmcnt(" #n ")" ::: "memory")
#define PG8_WAIT_L(n) asm volatile("s_waitcnt lgkmcnt(" #n ")" ::: "memory")
#define PG8_BAR __builtin_amdgcn_s_barrier()
#define PG8_SCHED __builtin_amdgcn_sched_barrier(0)
    Unit cur, nxt; int ui = 0;
    if (!S.next(0, cur)) return;
    f32x4 acc[2][2][4][2];
#pragma unroll
    for (int a = 0; a < 2; ++a)
#pragma unroll
        for (int b = 0; b < 2; ++b)
#pragma unroll
            for (int m = 0; m < 4; ++m)
#pragma unroll
                for (int n = 0; n < 2; ++n) acc[a][b][m][n] = (f32x4){0.f, 0.f, 0.f, 0.f};
    bf16x8 At[4][2], B0[2][2], B1[2][2];
    const char* cA = cur.A; const char* cB = cur.B;
    PG8_STAGE(PG8_SB(0, 0), cB, voffB); PG8_STAGE(PG8_SB(0, 1), cB + hsB, voffB); PG8_STAGE(PG8_SA(0, 0), cA, voffA); PG8_STAGE(PG8_SA(0, 1), cA + hsA, voffA);
    if (wr == 1) PG8_BAR;
    PG8_WAIT_V(2); PG8_BAR;
    PG8_STAGE(PG8_SB(1, 0), cB + kstep, voffB); PG8_STAGE(PG8_SA(1, 0), cA + kstep, voffA); PG8_STAGE(PG8_SB(1, 1), cB + hsB + kstep, voffB);
    PG8_WAIT_V(6); PG8_BAR;
    for (;;) {
        const bool has_next = S.next(ui + 1, nxt);
        const char* nA = has_next ? nxt.A : cA; const char* nB = has_next ? nxt.B : cB;
        for (int t = 0; t < nt; t += 2) {
            const bool last = (t == nt - 2);
            const char* a1 = cA + (size_t)(t + 1) * kstep;
            const char* a2 = last ? nA : cA + (size_t)(t + 2) * kstep; const char* b2 = last ? nB : cB + (size_t)(t + 2) * kstep;
            const char* a3 = a2 + kstep; const char* b3 = b2 + kstep;
            PG8_LDB(B0, 0, 0); PG8_LDB(B1, 0, 1); PG8_SCHED; PG8_LDA(At, 0, 0); PG8_STAGE(PG8_SA(1, 1), a1 + hsA, voffA);
            PG8_WAIT_V(8); PG8_WAIT_L(0); PG8_BAR; PG8_MMA(0, 0, At, B0); PG8_MMA(0, 1, At, B1); PG8_BAR; PG8_SCHED;
            PG8_LDA(At, 0, 1); PG8_STAGE(PG8_SB(0, 0), b2, voffB); PG8_STAGE(PG8_SB(0, 1), b2 + hsB, voffB); PG8_STAGE(PG8_SA(0, 0), a2, voffA);
            PG8_WAIT_V(8); PG8_WAIT_L(0); PG8_BAR; PG8_MMA(1, 0, At, B0); PG8_MMA(1, 1, At, B1); PG8_BAR; PG8_SCHED;
            PG8_LDB(B0, 1, 0); PG8_LDB(B1, 1, 1); PG8_SCHED; PG8_LDA(At, 1, 0); PG8_STAGE(PG8_SA(0, 1), a2 + hsA, voffA);
            PG8_WAIT_V(8); PG8_WAIT_L(0); PG8_BAR; PG8_MMA(0, 0, At, B0); PG8_MMA(0, 1, At, B1); PG8_BAR; PG8_SCHED;
            PG8_LDA(At, 1, 1); PG8_STAGE(PG8_SB(1, 0), b3, voffB); PG8_STAGE(PG8_SB(1, 1), b3 + hsB, voffB); PG8_STAGE(PG8_SA(1, 0), a3, voffA);
            PG8_WAIT_V(8); PG8_WAIT_L(0); PG8_BAR; PG8_MMA(1, 0, At, B0); PG8_MMA(1, 1, At, B1); PG8_BAR; PG8_SCHED;
        }
        if (wr == 0) PG8_BAR;
        E(acc, cur, wr, wc, fr, fq);
        if (!has_next) break;
#pragma unroll
        for (int a = 0; a < 2; ++a)
#pragma unroll
            for (int b = 0; b < 2; ++b)
#pragma unroll
                for (int m = 0; m < 4; ++m)
#pragma unroll
                    for (int n = 0; n < 2; ++n) acc[a][b][m][n] = (f32x4){0.f, 0.f, 0.f, 0.f};
        cur = nxt; cA = nA; cB = nB; ++ui;
        if (wr == 1) PG8_BAR;
    }
    PG8_WAIT_V(0);
    PG8_BAR;
#undef PG8_SA
#undef PG8_SB
#undef PG8_STAGE
#undef PG8_LDA
#undef PG8_LDB
#undef PG8_MMA
#undef PG8_WAIT_V
#undef PG8_WAIT_L
#undef PG8_BAR
#undef PG8_SCHED
}
}

struct GlaScoreSched {
    int G, c; const bf16_t* AP; const bf16_t* KT;
    __device__ __forceinline__ bool next(int i, pg8::Unit& u) const {
        const int idx = c + i * G; if (idx >= 256) return false;
        const int bh = idx >> 5, sc = idx & 31, b = bh >> 2, h = bh & 3; const size_t tok0 = (size_t)b * SEQ + sc * 256;
        u.pm = idx; u.pn = 0; u.A = (const char*)(AP + tok0 * 2048 + h * 512); u.B = (const char*)(KT + tok0 * 1024 + h * 256); return true;
    }
};
struct GlaScoreEpi {
    static constexpr bool PERM = true;
    bf16_t* AP;
    __device__ __forceinline__ void operator()(const f32x4 (&acc)[2][2][4][2], const pg8::Unit& u, int wr, int wc, int fr, int fq) const {
        const int lane = lane_asm(); fr = lane & 15; fq = lane >> 4; (void)lane;
        const int idx = u.pm, bh = idx >> 5, sc = idx & 31, b = bh >> 2, h = bh & 3; const size_t tok0 = (size_t)b * SEQ + sc * 256;
#pragma unroll
        for (int ai = 0; ai < 2; ++ai)
#pragma unroll
            for (int m = 0; m < 4; ++m) { const int r = ai * 128 + wr * 64 + m * 16 + fr; bf16_t* rowp = AP + (tok0 + r) * 2048 + h * 512 + 256;
#pragma unroll
                for (int bj = 0; bj < 2; ++bj) { const int c0 = bj * 128 + wc * 32 + 8 * fq; f32x4 v0 = acc[ai][bj][m][0], v1 = acc[ai][bj][m][1];
#pragma unroll
                    for (int j = 0; j < 4; ++j) { if (c0 + j > r) v0[j] = 0.f; if (c0 + 4 + j > r) v1[j] = 0.f; }
                    u32x4 w; w.x = cvt_pk_bf16(v0[0], v0[1]); w.y = cvt_pk_bf16(v0[2], v0[3]); w.z = cvt_pk_bf16(v1[0], v1[1]); w.w = cvt_pk_bf16(v1[2], v1[3]);
                    *(u32x4*)(rowp + c0) = w; } }
    }
};
struct GlaUSched {
    int G, c; const bf16_t* BP; const bf16_t* KTT;
    __device__ __forceinline__ bool next(int i, pg8::Unit& u) const {
        const int idx = c + i * G; if (idx >= 512) return false;
        const int bhsc = idx >> 1, mt = idx & 1, bh = bhsc >> 5, sc = bhsc & 31;
        u.pm = idx; u.pn = 0; u.A = (const char*)(BP + ((size_t)bhsc * 512 + mt * 256) * 512 + 256); u.B = (const char*)(KTT + (size_t)bh * 256 * SEQ + sc * 256); return true;
    }
};
struct GlaUEpi {
    static constexpr bool PERM = false;
    float* UT; const float* DL;
    __device__ __forceinline__ void operator()(const f32x4 (&acc)[2][2][4][2], const pg8::Unit& u, int wr, int wc, int fr, int fq) const {
        const int lane = lane_asm(); fr = lane & 15; fq = lane >> 4; (void)lane;
        const int idx = u.pm, bhsc = idx >> 1, mt = idx & 1; const float* dl = DL + (size_t)bhsc * 256;
#pragma unroll
        for (int ai = 0; ai < 2; ++ai)
#pragma unroll
            for (int m = 0; m < 4; ++m) { const int r = mt * 256 + ai * 128 + wr * 64 + m * 16 + fr; float* rowp = UT + ((size_t)bhsc * 512 + r) * 256;
#pragma unroll
                for (int bj = 0; bj < 2; ++bj)
#pragma unroll
                    for (int n = 0; n < 2; ++n) { const int c0 = bj * 128 + wc * 32 + n * 16 + 4 * fq; *(f32x4*)(rowp + c0) = acc[ai][bj][m][n] * *(const f32x4*)(dl + c0); } }
    }
};
struct GlaOSched {
    int G, c; const bf16_t* AP; const bf16_t* BP;
    __device__ __forceinline__ bool next(int i, pg8::Unit& u) const {
        const int idx = c + i * G; if (idx >= 512) return false;
        const int bhsc = idx >> 1, nt = idx & 1, bh = bhsc >> 5, sc = bhsc & 31, b = bh >> 2, h = bh & 3; const size_t tok0 = (size_t)b * SEQ + sc * 256;
        u.pm = idx; u.pn = 0; u.A = (const char*)(AP + tok0 * 2048 + h * 512); u.B = (const char*)(BP + ((size_t)bhsc * 512 + nt * 256) * 512); return true;
    }
};
struct GlaOEpi {
    static constexpr bool PERM = true;
    bf16_t* O; float* SSQ;
    __device__ __forceinline__ void operator()(const f32x4 (&acc)[2][2][4][2], const pg8::Unit& u, int wr, int wc, int fr, int fq) const {
        const int lane = lane_asm(); fr = lane & 15; fq = lane >> 4; (void)lane;
        const int idx = u.pm, bhsc = idx >> 1, nt = idx & 1, bh = bhsc >> 5, sc = bhsc & 31, b = bh >> 2, h = bh & 3; const size_t tok0 = (size_t)b * SEQ + sc * 256;
#pragma unroll
        for (int ai = 0; ai < 2; ++ai)
#pragma unroll
            for (int m = 0; m < 4; ++m) { const int r = ai * 128 + wr * 64 + m * 16 + fr; bf16_t* rowp = O + (tok0 + r) * 2048 + h * 512 + nt * 256; float ss = 0.f;
#pragma unroll
                for (int bj = 0; bj < 2; ++bj) { const int c0 = bj * 128 + wc * 32 + 8 * fq; const f32x4 v0 = acc[ai][bj][m][0], v1 = acc[ai][bj][m][1];
                    ss += (v0[0] * v0[0] + v0[1] * v0[1]) + (v0[2] * v0[2] + v0[3] * v0[3]) + (v1[0] * v1[0] + v1[1] * v1[1]) + (v1[2] * v1[2] + v1[3] * v1[3]);
                    u32x4 w; w.x = cvt_pk_bf16(v0[0], v0[1]); w.y = cvt_pk_bf16(v0[2], v0[3]); w.z = cvt_pk_bf16(v1[0], v1[1]); w.w = cvt_pk_bf16(v1[2], v1[3]);
                    *(u32x4*)(rowp + c0) = w; }
                ss += shx(ss, 16, lane); ss += shx(ss, 32, lane);
                if (fq == 0) atomicAdd(SSQ + (tok0 + r) * 4 + h, ss); }
    }
};

struct Params {
    const float *x, *p, *gla_w_in, *gla_w_a1, *gla_w_a2, *gla_b_a, *gla_norm_g, *gla_w_o, *pool_w, *pool_scale, *dsa_w_in, *dsa_kidx_g, *dsa_kidx_b, *dsa_w_o,
        *ln_mix_g, *ln_mix_b, *ffn_w_up, *ffn_conv_w, *ffn_conv_b, *ffn_w_down, *ple_gate_w, *ple_proj_w, *ln_ffn_g, *ln_ffn_b;
    float* out; unsigned char* ws;
};

__device__ __forceinline__ void transpose_item(const float* W, int K, int N, bf16_t* WT, int row_off, LAS unsigned* scr, int item, int lane) {
    const int nblk = (N + 63) / 64, kb = item / nblk, nb = item % nblk, k0 = 64 * kb, n0 = 64 * nb;
    const int nn = (lane & 15) * 4; const bool nok = (n0 + nn) < N;
#pragma unroll
    for (int i = 0; i < 8; ++i) { const int kk = 8 * i + 2 * (lane >> 4);
        f32x4 v0 = {0.f, 0.f, 0.f, 0.f}, v1 = v0;
        if (nok) { v0 = *(const f32x4*)(W + (size_t)(k0 + kk) * N + n0 + nn); v1 = *(const f32x4*)(W + (size_t)(k0 + kk + 1) * N + n0 + nn); }
#pragma unroll
        for (int j = 0; j < 4; ++j) scr[((nn + j) * 72 + kk) >> 1] = cvt_pk_bf16(v0[j], v1[j]); }
    asm volatile("s_waitcnt lgkmcnt(0)" ::: "memory");
#pragma unroll
    for (int j = 0; j < 8; ++j) { const int n = (lane >> 3) + 8 * j, ch = lane & 7;
        const u32x4 o = *(const LAS u32x4*)(scr + ((n * 72 + ch * 8) >> 1));
        *(u32x4*)(WT + (size_t)(row_off + n0 + n) * K + k0 + 8 * ch) = o; }
    asm volatile("s_waitcnt lgkmcnt(0)" ::: "memory");
}
#define TJOB(W, K, N, DST, ROWOFF) do { const int _ni = ((K) / 64) * (((N) + 63) / 64); for (int _it = gw; _it < _ni; _it += NGW) transpose_item((W), (K), (N), (DST), (ROWOFF), scr, _it, lane); } while (0)

__device__ __forceinline__ void row_pass(const float* src, const float* __restrict__ g, const float* __restrict__ b, float* dst32, bf16_t* __restrict__ dstb, float* __restrict__ stats, int widk) {
    IDX_SETUP
    f32x4 vn[8];
    if (gw < T) { const f32x4* xr = (const f32x4*)(src + (size_t)gw * D) + lane;
#pragma unroll
        for (int j = 0; j < 8; ++j) vn[j] = xr[64 * j]; }
    for (int r = gw; r < T; r += NGW) {
        f32x4 v[8];
#pragma unroll
        for (int j = 0; j < 8; ++j) v[j] = vn[j];
        if (r + NGW < T) { const f32x4* xr = (const f32x4*)(src + (size_t)(r + NGW) * D) + lane;
#pragma unroll
            for (int j = 0; j < 8; ++j) vn[j] = xr[64 * j]; }
        if (g) {
            float s = 0.f;
#pragma unroll
            for (int j = 0; j < 8; ++j) s += (v[j].x + v[j].y) + (v[j].z + v[j].w);
            const float mean = wave_sum(s, lane) * (1.f / D); float s2 = 0.f;
#pragma unroll
            for (int j = 0; j < 8; ++j) { v[j] = v[j] - mean; s2 += (v[j].x * v[j].x + v[j].y * v[j].y) + (v[j].z * v[j].z + v[j].w * v[j].w); }
            const float rstd = 1.0f / sqrtf(wave_sum(s2, lane) * (1.f / D) + LN_EPS);
            if (stats && lane == 0) *(f32x2*)(stats + 2 * (size_t)r) = (f32x2){mean, rstd};
#pragma unroll
            for (int j = 0; j < 8; ++j) { const f32x4 gg = ((const f32x4*)g)[lane + 64 * j], bb = ((const f32x4*)b)[lane + 64 * j]; v[j] = v[j] * rstd * gg + bb; }
        }
        if (dst32) { f32x4* o = (f32x4*)(dst32 + (size_t)r * D) + lane;
#pragma unroll
            for (int j = 0; j < 8; ++j) o[64 * j] = v[j]; }
        if (dstb) { u32x2* o = (u32x2*)(dstb + (size_t)r * D) + lane;
#pragma unroll
            for (int j = 0; j < 8; ++j) { u32x2 w; w.x = cvt_pk_bf16(v[j].x, v[j].y); w.y = cvt_pk_bf16(v[j].z, v[j].w); o[64 * j] = w; } }
    }
}

__device__ __forceinline__ void xa_pass(const bf16_t* srcb, const float* wa1, float* xa, int widk) {
    IDX_SETUP
    for (int r0 = gw * 4; r0 < T; r0 += NGW * 4) {
        f32x4 acc[4][4];
#pragma unroll
        for (int rr = 0; rr < 4; ++rr)
#pragma unroll
            for (int qd = 0; qd < 4; ++qd) acc[rr][qd] = (f32x4){0.f, 0.f, 0.f, 0.f};
#pragma unroll 2
        for (int i = 0; i < 32; ++i) { const int cc = lane + 64 * i; const f32x4* w = (const f32x4*)(wa1 + (size_t)cc * 16);
            const f32x4 w0 = w[0], w1 = w[1], w2 = w[2], w3 = w[3];
#pragma unroll
            for (int rr = 0; rr < 4; ++rr) { const float xv = bf2f(srcb[(size_t)(r0 + rr) * D + cc]);
                acc[rr][0] += w0 * xv; acc[rr][1] += w1 * xv; acc[rr][2] += w2 * xv; acc[rr][3] += w3 * xv; } }
        const bool b5 = (lane & 32) != 0, b4 = (lane & 16) != 0, b3 = (lane & 8) != 0, b2 = (lane & 4) != 0;
        const int idx = (b5 ? 8 : 0) + (b4 ? 4 : 0) + (b3 ? 2 : 0) + (b2 ? 1 : 0);
#pragma unroll
        for (int rr = 0; rr < 4; ++rr) {
            float k8[8], k4[4], k2[2];
#pragma unroll
            for (int j = 0; j < 8; ++j) { const float lo = acc[rr][j >> 2][j & 3], hi = acc[rr][2 + (j >> 2)][j & 3]; k8[j] = (b5 ? hi : lo) + shx(b5 ? lo : hi, 32, lane); }
#pragma unroll
            for (int j = 0; j < 4; ++j) k4[j] = (b4 ? k8[j + 4] : k8[j]) + shx(b4 ? k8[j] : k8[j + 4], 16, lane);
#pragma unroll
            for (int j = 0; j < 2; ++j) k2[j] = (b3 ? k4[j + 2] : k4[j]) + shx(b3 ? k4[j] : k4[j + 2], 8, lane);
            float k1 = (b2 ? k2[1] : k2[0]) + shx(b2 ? k2[0] : k2[1], 4, lane);
            k1 += shx(k1, 2, lane); k1 += shx(k1, 1, lane);
            if ((lane & 3) == 0) xa[(size_t)(r0 + rr) * 16 + idx] = k1;
        }
    }
}
__device__ __forceinline__ void conv_pass(const bf16_t* __restrict__ H, const float* __restrict__ cw, const float* __restrict__ cb, bf16_t* __restrict__ ACT, int widk) {
    IDX_SETUP
    constexpr int NCG = DFF / 8, NSEG = T / 32;
    for (int idx = gt; idx < NCG * NSEG; idx += NT) {
        const int cgi = idx % NCG, sg = idx / NCG, t0 = sg * 32, c0 = cgi * 8;
        f32x4 wg[3][2], wu[3][2], bg[2], bu[2];
#pragma unroll
        for (int j = 0; j < 3; ++j)
#pragma unroll
            for (int q = 0; q < 2; ++q) { wg[j][q] = *(const f32x4*)(cw + (size_t)j * NUP + c0 + 4 * q); wu[j][q] = *(const f32x4*)(cw + (size_t)j * NUP + DFF + c0 + 4 * q); }
#pragma unroll
        for (int q = 0; q < 2; ++q) { bg[q] = *(const f32x4*)(cb + c0 + 4 * q); bu[q] = *(const f32x4*)(cb + DFF + c0 + 4 * q); }
        f32x4 g2[2], g1[2], u2[2], u1[2];
        if ((t0 & (SEQ - 1)) == 0) {
#pragma unroll
            for (int q = 0; q < 2; ++q) { g2[q] = (f32x4){0.f, 0.f, 0.f, 0.f}; g1[q] = g2[q]; u2[q] = g2[q]; u1[q] = g2[q]; }
        } else {
            const u32x4 a = *(const u32x4*)(H + (size_t)(t0 - 2) * NUP + c0), b = *(const u32x4*)(H + (size_t)(t0 - 1) * NUP + c0);
            const u32x4 c = *(const u32x4*)(H + (size_t)(t0 - 2) * NUP + DFF + c0), d = *(const u32x4*)(H + (size_t)(t0 - 1) * NUP + DFF + c0);
            g2[0] = (f32x4){lo16(a.x), hi16(a.x), lo16(a.y), hi16(a.y)}; g2[1] = (f32x4){lo16(a.z), hi16(a.z), lo16(a.w), hi16(a.w)};
            g1[0] = (f32x4){lo16(b.x), hi16(b.x), lo16(b.y), hi16(b.y)}; g1[1] = (f32x4){lo16(b.z), hi16(b.z), lo16(b.w), hi16(b.w)};
            u2[0] = (f32x4){lo16(c.x), hi16(c.x), lo16(c.y), hi16(c.y)}; u2[1] = (f32x4){lo16(c.z), hi16(c.z), lo16(c.w), hi16(c.w)};
            u1[0] = (f32x4){lo16(d.x), hi16(d.x), lo16(d.y), hi16(d.y)}; u1[1] = (f32x4){lo16(d.z), hi16(d.z), lo16(d.w), hi16(d.w)};
        }
#pragma unroll 4
        for (int t = 0; t < 32; ++t) {
            const u32x4 a = *(const u32x4*)(H + (size_t)(t0 + t) * NUP + c0), c = *(const u32x4*)(H + (size_t)(t0 + t) * NUP + DFF + c0);
            f32x4 g0[2], u0[2];
            g0[0] = (f32x4){lo16(a.x), hi16(a.x), lo16(a.y), hi16(a.y)}; g0[1] = (f32x4){lo16(a.z), hi16(a.z), lo16(a.w), hi16(a.w)};
            u0[0] = (f32x4){lo16(c.x), hi16(c.x), lo16(c.y), hi16(c.y)}; u0[1] = (f32x4){lo16(c.z), hi16(c.z), lo16(c.w), hi16(c.w)};
            unsigned ow[4];
#pragma unroll
            for (int q = 0; q < 2; ++q) {
                const f32x4 hg = bg[q] + wg[0][q] * g2[q] + wg[1][q] * g1[q] + wg[2][q] * g0[q];
                const f32x4 hu = bu[q] + wu[0][q] * u2[q] + wu[1][q] * u1[q] + wu[2][q] * u0[q];
                const f32x2 ga = gelu_pk((f32x2){hg[0], hg[1]}), gb = gelu_pk((f32x2){hg[2], hg[3]});
                ow[2 * q] = cvt_pk_bf16(ga.x * hu[0], ga.y * hu[1]); ow[2 * q + 1] = cvt_pk_bf16(gb.x * hu[2], gb.y * hu[3]);
                g2[q] = g1[q]; g1[q] = g0[q]; u2[q] = u1[q]; u1[q] = u0[q];
            }
            *(u32x4*)(ACT + (size_t)(t0 + t) * DFF + c0) = (u32x4){ow[0], ow[1], ow[2], ow[3]};
        }
    }
}

__device__ __forceinline__ void ple_mul(bf16_t* SG, const bf16_t* PP, int widk) {
    IDX_SETUP
    for (int idx = gt; idx < T * (D / 8); idx += NT) {
        const u32x4 a = ((const u32x4*)SG)[idx], b = ((const u32x4*)PP)[idx];
        u32x4 w; w.x = cvt_pk_bf16(lo16(a.x) * lo16(b.x), hi16(a.x) * hi16(b.x)); w.y = cvt_pk_bf16(lo16(a.y) * lo16(b.y), hi16(a.y) * hi16(b.y));
        w.z = cvt_pk_bf16(lo16(a.z) * lo16(b.z), hi16(a.z) * hi16(b.z)); w.w = cvt_pk_bf16(lo16(a.w) * lo16(b.w), hi16(a.w) * hi16(b.w));
        ((u32x4*)SG)[idx] = w;
    }
}
__device__ __forceinline__ void gla_prep(const bf16_t* QKVR, const float* XA, const float* wa2, const float* ba, bf16_t* AP, bf16_t* KT, bf16_t* KTT, float* DL, LAS unsigned char* lds, int widk) {
    IDX_SETUP
    LAS float* tot = (LAS float*)lds;
    for (int it = c; it < 256; it += G) {
        const int h = it & 3, sc = (it >> 2) & 31, b = it >> 7, bh = b * 4 + h, col = h * 256 + 4 * lane;
        f32x4 w2[16];
#pragma unroll
        for (int j = 0; j < 16; ++j) w2[j] = *(const f32x4*)(wa2 + (size_t)j * 1024 + col);
        const f32x4 bav = *(const f32x4*)(ba + col);
        const size_t tokw = (size_t)b * SEQ + sc * 256 + wid * 32;
#define GLA_LA2(t, out) do { const f32x4* xa4 = (const f32x4*)(XA + (t) * 16); const f32x4 a0 = xa4[0], a1 = xa4[1], a2 = xa4[2], a3 = xa4[3]; \
            f32x4 z = bav + w2[0] * a0[0] + w2[1] * a0[1] + w2[2] * a0[2] + w2[3] * a0[3]; z += w2[4] * a1[0] + w2[5] * a1[1] + w2[6] * a1[2] + w2[7] * a1[3]; \
            z += w2[8] * a2[0] + w2[9] * a2[1] + w2[10] * a2[2] + w2[11] * a2[3]; z += w2[12] * a3[0] + w2[13] * a3[1] + w2[14] * a3[2] + w2[15] * a3[3]; \
            _Pragma("unroll") for (int _e = 0; _e < 4; ++_e) (out)[_e] = -0.0625f * __builtin_amdgcn_logf(1.0f + __builtin_amdgcn_exp2f(-z[_e] * 1.44269504f)); } while (0)
        f32x4 sum = {0.f, 0.f, 0.f, 0.f};
#pragma unroll 4
        for (int tt = 0; tt < 32; ++tt) { f32x4 la; GLA_LA2(tokw + tt, la); sum += la; }
        *(LAS f32x4*)(tot + wid * 256 + 4 * lane) = sum;
        __syncthreads();
        f32x4 bs = {0.f, 0.f, 0.f, 0.f}, ball = bs;
#pragma unroll
        for (int w = 0; w < 8; ++w) { const f32x4 tv = *(const LAS f32x4*)(tot + w * 256 + 4 * lane); if (w < wid) bs += tv; ball += tv; }
        for (int tt = 0; tt < 32; tt += 8) {
            unsigned pk[4][4];
#pragma unroll
            for (int e = 0; e < 8; e += 2) {
                f32x4 kt2[2];
#pragma unroll
                for (int e2 = 0; e2 < 2; ++e2) {
                    const size_t t = tokw + tt + e + e2;
                    f32x4 la; GLA_LA2(t, la); bs += la;
                    const u32x2 qw = *(const u32x2*)(QKVR + t * GLA_N + col), kw = *(const u32x2*)(QKVR + t * GLA_N + 1024 + col);
                    const f32x4 qv = {lo16(qw.x), hi16(qw.x), lo16(qw.y), hi16(qw.y)}, kv = {lo16(kw.x), hi16(kw.x), lo16(kw.y), hi16(kw.y)};
                    f32x4 qt, kt;
#pragma unroll
                    for (int j = 0; j < 4; ++j) { qt[j] = qv[j] * 0.0625f * __builtin_amdgcn_exp2f(bs[j]); kt[j] = kv[j] * __builtin_amdgcn_exp2f(fminf(-bs[j], 120.f)); }
                    u32x2 qo, ko; qo.x = cvt_pk_bf16(qt[0], qt[1]); qo.y = cvt_pk_bf16(qt[2], qt[3]); ko.x = cvt_pk_bf16(kt[0], kt[1]); ko.y = cvt_pk_bf16(kt[2], kt[3]);
                    *(u32x2*)(AP + t * 2048 + h * 512 + 4 * lane) = qo;
                    *(u32x2*)(KT + t * 1024 + col) = ko;
                    kt2[e2] = kt;
                }
#pragma unroll
                for (int j = 0; j < 4; ++j) pk[j][e >> 1] = cvt_pk_bf16(kt2[0][j], kt2[1][j]);
            }
#pragma unroll
            for (int j = 0; j < 4; ++j)
                *(u32x4*)(KTT + ((size_t)(bh * 256 + 4 * lane + j) * SEQ + sc * 256 + wid * 32 + tt)) = (u32x4){pk[j][0], pk[j][1], pk[j][2], pk[j][3]};
        }
        if (wid == 0) { f32x4 dl;
#pragma unroll
            for (int j = 0; j < 4; ++j) dl[j] = __builtin_amdgcn_exp2f(ball[j]);
            *(f32x4*)(DL + (size_t)(bh * 32 + sc) * 256 + 4 * lane) = dl; }
#undef GLA_LA2
        __syncthreads();
    }
}
__device__ __forceinline__ void gla_vt(const bf16_t* __restrict__ QKVR, bf16_t* __restrict__ BP, LAS unsigned char* lds, int widk) {
    IDX_SETUP
    LAS bf16_t* scr = (LAS bf16_t*)(lds + wid * 9216);
    for (int it = gw; it < 256 * 32; it += NGW) {
        const int tt = it >> 5, vt = it & 31;
        const size_t tokb = (size_t)tt * 64; const int vcol = vt * 64, h = vcol >> 9, vv0 = vcol & 511;
        const int b = (int)(tokb >> 13), tl = (int)(tokb & (SEQ - 1)), sc = tl >> 8, tloc0 = tl & 255, bhsc = (b * 4 + h) * 32 + sc;
#pragma unroll
        for (int i = 0; i < 8; ++i) { const int row = (lane >> 3) + 8 * i, ch = lane & 7;
            const u32x4 w = *(const u32x4*)(QKVR + (tokb + row) * GLA_N + 2048 + vcol + ch * 8);
            *(LAS u32x4*)(scr + row * 72 + ch * 8) = w; }
        asm volatile("s_waitcnt lgkmcnt(0)" ::: "memory");
#pragma unroll
        for (int cch = 0; cch < 8; ++cch) {
            unsigned short e[8];
#pragma unroll
            for (int j = 0; j < 8; ++j) e[j] = scr[(cch * 8 + j) * 72 + lane];
            u32x4 w; w.x = e[0] | ((unsigned)e[1] << 16); w.y = e[2] | ((unsigned)e[3] << 16); w.z = e[4] | ((unsigned)e[5] << 16); w.w = e[6] | ((unsigned)e[7] << 16);
            *(u32x4*)(BP + ((size_t)bhsc * 512 + vv0 + lane) * 512 + 256 + tloc0 + cch * 8) = w;
        }
        asm volatile("s_waitcnt lgkmcnt(0)" ::: "memory");
    }
}
__device__ __forceinline__ void gla_scan(const float* __restrict__ UT, const float* __restrict__ DL, bf16_t* __restrict__ BP, int widk) {
    IDX_SETUP
    for (int idx = gt; idx < 8 * 512 * 64; idx += NT) {
        const int k4 = idx & 63, v = (idx >> 6) & 511, bh = idx >> 15;
        f32x4 S = {0.f, 0.f, 0.f, 0.f};
#pragma unroll 4
        for (int sc = 0; sc < 32; ++sc) {
            const size_t bhsc = (size_t)bh * 32 + sc;
            u32x2 w; w.x = cvt_pk_bf16(S[0], S[1]); w.y = cvt_pk_bf16(S[2], S[3]);
            *(u32x2*)(BP + (bhsc * 512 + v) * 512 + k4 * 4) = w;
            const f32x4 dl = *(const f32x4*)(DL + bhsc * 256 + k4 * 4), uu = *(const f32x4*)(UT + (bhsc * 512 + v) * 256 + k4 * 4);
            S = dl * S + uu;
        }
    }
}
__device__ __forceinline__ void gla_gate(bf16_t* O, const float* SSQ, const bf16_t* QKVR, const float* ng, int widk) {
    IDX_SETUP
    for (int idx = gt; idx < T * (D / 8); idx += NT) {
        const int t = idx >> 8, c0 = (idx & 255) * 8, h = c0 >> 9;
        const float rs = 1.0f / sqrtf(SSQ[(size_t)t * 4 + h] * (1.f / 512.f) + LN_EPS);
        const u32x4 ov = *(const u32x4*)(O + (size_t)t * D + c0), rv = *(const u32x4*)(QKVR + (size_t)t * GLA_N + 4096 + c0);
        const f32x4 g0 = *(const f32x4*)(ng + c0), g1 = *(const f32x4*)(ng + c0 + 4);
        float o[8] = {lo16(ov.x), hi16(ov.x), lo16(ov.y), hi16(ov.y), lo16(ov.z), hi16(ov.z), lo16(ov.w), hi16(ov.w)};
        float r[8] = {lo16(rv.x), hi16(rv.x), lo16(rv.y), hi16(rv.y), lo16(rv.z), hi16(rv.z), lo16(rv.w), hi16(rv.w)};
        float gg[8] = {g0[0], g0[1], g0[2], g0[3], g1[0], g1[1], g1[2], g1[3]};
        float y[8];
#pragma unroll
        for (int j = 0; j < 8; ++j) { const float on = bf2f((unsigned short)f2bf(o[j] * rs * gg[j])); y[j] = on * (r[j] * sigmoidf_(r[j])); }
        *(u32x4*)(O + (size_t)t * D + c0) = (u32x4){cvt_pk_bf16(y[0], y[1]), cvt_pk_bf16(y[2], y[3]), cvt_pk_bf16(y[4], y[5]), cvt_pk_bf16(y[6], y[7])};
    }
}

__device__ __forceinline__ f32x4 ldbf4(const bf16_t* p) { const u32x2 w = *(const u32x2*)p; return (f32x4){lo16(w.x), hi16(w.x), lo16(w.y), hi16(w.y)}; }
__device__ __forceinline__ void pool_pass(const bf16_t* __restrict__ X, bf16_t* __restrict__ PO, int widk) {
    IDX_SETUP
    for (int idx = gt; idx < 512 * 512; idx += NT) {
        const int cg4 = idx & 511, sg = idx >> 9, c0 = cg4 * 4, w = 2 << (c0 >> 9);
        const int t0 = sg * 32, tb = t0 & (SEQ - 1);
        f32x4 sum = {0.f, 0.f, 0.f, 0.f};
        for (int j = 1; j < w; ++j) if (tb - j >= 0) sum += ldbf4(X + (size_t)(t0 - j) * D + c0);
#pragma unroll 4
        for (int t = 0; t < 32; ++t) {
            const f32x4 xv = ldbf4(X + (size_t)(t0 + t) * D + c0);
            sum += xv;
            const int tp = tb + t; const float inv = 1.0f / (float)((tp + 1) < w ? (tp + 1) : w);
            const f32x4 y = sum * inv - xv;
            u32x2 o; o.x = cvt_pk_bf16(y[0], y[1]); o.y = cvt_pk_bf16(y[2], y[3]);
            *(u32x2*)(PO + (size_t)(t0 + t) * D + c0) = o;
            if (tp - w + 1 >= 0) sum -= ldbf4(X + (size_t)(t0 + t - w + 1) * D + c0);
        }
    }
}

__device__ __forceinline__ void dsa_kin(const bf16_t* DP, const float* g, const float* b, bf16_t* KIN, int widk) {
    IDX_SETUP
    const float gg = g[lane], bb = b[lane];
    for (int r = gw; r < T; r += NGW) {
        const float v = bf2f(DP[(size_t)r * DSA_NP + 4096 + lane]);
        const float mean = wave_sum(v, lane) * (1.f / 64.f), d = v - mean, var = wave_sum(d * d, lane) * (1.f / 64.f);
        KIN[(size_t)r * 64 + lane] = (bf16_t)f2bf(d * (1.0f / sqrtf(var + LN_EPS)) * gg + bb);
    }
}
__device__ __forceinline__ unsigned f2key(float f) { const unsigned u = __float_as_uint(f); return (u & 0x80000000u) ? ~u : (u | 0x80000000u); }
__device__ __forceinline__ void topk_find_digit(const LAS unsigned* hist, int kk, int lane, int& dg, int& nk) {
    const u32x4 h4 = *(const LAS u32x4*)(hist + 4 * lane);
    const int cc = (int)(h4.x + h4.y + h4.z + h4.w);
    int suf = cc;
#pragma unroll
    for (int o = 1; o < 64; o <<= 1) { const int tv = shi(suf, (lane + o) & 63); if (lane + o < 64) suf += tv; }
    const unsigned long long bal = __ballot(suf >= kk);
    const int Lh = bal ? 63 - __builtin_clzll(bal) : 0;
    int above = suf - cc, d, k2;
    if (above + (int)h4.w >= kk) { d = 3; k2 = kk - above; }
    else { above += (int)h4.w;
        if (above + (int)h4.z >= kk) { d = 2; k2 = kk - above; }
        else { above += (int)h4.z;
            if (above + (int)h4.y >= kk) { d = 1; k2 = kk - above; }
            else { above += (int)h4.y; d = 0; k2 = kk - above; } } }
    dg = __builtin_amdgcn_readlane(4 * lane + d, Lh); nk = __builtin_amdgcn_readlane(k2, Lh);
}
__device__ __forceinline__ void dsa_topk(const bf16_t* DP, const bf16_t* KIN, int* SEL, LAS unsigned char* lds, int widk) {
    IDX_SETUP
    LAS float* scs = (LAS float*)lds;
    LAS unsigned* hist = (LAS unsigned*)(lds + 131072);
    LAS unsigned* misc = (LAS unsigned*)(lds + 131072 + 4096);
    LAS float* mmf = (LAS float*)(lds + 131072 + 4096 + 128);
    LAS unsigned* cand = (LAS unsigned*)(lds + 131072 + 4096 + 384);
    const int fr = lane & 15, fq = lane >> 4;
    for (int rr = c; rr < T / 4; rr += G) {
        const int b = rr >> 11; int blk = rr & 2047; { const int cblk = blk & 255, kb = blk >> 8; blk = (kb < 4) ? (cblk + 256 * kb) : (2047 - (cblk + 256 * (kb - 4))); }
        const int tq0 = blk * 4, n = tq0 + 4;
        const size_t tokq = (size_t)b * SEQ + tq0;
        bf16x8 Af[4][2]; float wv[4][4];
#pragma unroll
        for (int q = 0; q < 4; ++q) {
#pragma unroll
            for (int ks = 0; ks < 2; ++ks) Af[q][ks] = *(const bf16x8*)(DP + (tokq + q) * DSA_NP + 3072 + fr * 64 + ks * 32 + fq * 8);
            const u32x2 ww = *(const u32x2*)(DP + (tokq + q) * DSA_NP + 4160 + 4 * fq);
            wv[q][0] = lo16(ww.x) * 0.03125f; wv[q][1] = hi16(ww.x) * 0.03125f; wv[q][2] = lo16(ww.y) * 0.03125f; wv[q][3] = hi16(ww.y) * 0.03125f;
        }
        const int ntile = (n + 15) >> 4;
        {
            bf16x8 Bf[4][2], Bn[4][2];
#define TOPK_LOAD(dst, jbase) do { _Pragma("unroll") for (int u = 0; u < 4; ++u) { int j = (jbase) + 8 * u; j = j < 512 ? j : 511; \
                const bf16_t* kp = KIN + ((size_t)b * SEQ + j * 16 + fr) * 64 + fq * 8; dst[u][0] = *(const bf16x8*)kp; dst[u][1] = *(const bf16x8*)(kp + 32); } } while (0)
            TOPK_LOAD(Bf, wid);
            float rmn = __builtin_inff(), rmx = -__builtin_inff();
            for (int j4 = wid; j4 < ntile; j4 += 32) {
                TOPK_LOAD(Bn, j4 + 32);
#pragma unroll
                for (int u = 0; u < 4; ++u) {
                    const int j = j4 + 8 * u;
                    if (j < ntile) {
                        float myval = 0.f;
#pragma unroll
                        for (int q = 0; q < 4; ++q) {
                            f32x4 a = {0.f, 0.f, 0.f, 0.f};
                            a = __builtin_amdgcn_mfma_f32_16x16x32_bf16(Af[q][0], Bf[u][0], a, 0, 0, 0);
                            a = __builtin_amdgcn_mfma_f32_16x16x32_bf16(Af[q][1], Bf[u][1], a, 0, 0, 0);
                            float val = wv[q][0] * fmaxf(a[0], 0.f) + wv[q][1] * fmaxf(a[1], 0.f) + wv[q][2] * fmaxf(a[2], 0.f) + wv[q][3] * fmaxf(a[3], 0.f);
                            val += shx(val, 16, lane); val += shx(val, 32, lane);
                            if (fq == q) myval = val;
                        }
                        const int s = j * 16 + fr;
                        if (s > tq0 + fq) myval = -__builtin_inff(); else { rmn = fminf(rmn, myval); rmx = fmaxf(rmx, myval); }
                        scs[fq * 8192 + s] = myval;
                    }
                }
#pragma unroll
                for (int u = 0; u < 4; ++u) { Bf[u][0] = Bn[u][0]; Bf[u][1] = Bn[u][1]; }
            }
#undef TOPK_LOAD
#pragma unroll
            for (int o = 1; o < 16; o <<= 1) { rmn = fminf(rmn, shx(rmn, o, lane)); rmx = fmaxf(rmx, shx(rmx, o, lane)); }
            if (fr == 0) { mmf[wid * 8 + fq * 2] = rmn; mmf[wid * 8 + fq * 2 + 1] = rmx; }
            for (int i = tid; i < 1024; i += 512) hist[i] = 0u;
            if (tid < 32) misc[tid] = 0u;
        }
        __syncthreads();
        const int q = wid >> 1, sub = tid & 127, nq = tq0 + q + 1;
        int* selrow = SEL + (tokq + q) * 256;
        LAS float* row = scs + q * 8192;
        if (n <= 256) {
            for (int i = sub; i < 256; i += 128) selrow[i] = (i < nq) ? i : -1;
        } else {
            float mn = mmf[q * 2], mx = mmf[q * 2 + 1];
#pragma unroll
            for (int w = 1; w < 8; ++w) { mn = fminf(mn, mmf[w * 8 + q * 2]); mx = fmaxf(mx, mmf[w * 8 + q * 2 + 1]); }
            const float scale = (mx > mn) ? 255.0f / (mx - mn) : 0.f;
#define DSA_BIN(v) ({ int _b = (int)(((v) - mn) * scale); _b = _b < 0 ? 0 : _b; _b > 255 ? 255 : _b; })
            for (int sb = 0; sb < nq; sb += 512) { const int s4 = sb + 4 * sub;
                if (s4 < nq) { const f32x4 v4 = *(const LAS f32x4*)(row + s4);
#pragma unroll
                    for (int e = 0; e < 4; ++e) if (s4 + e < nq) __hip_atomic_fetch_add(hist + q * 256 + DSA_BIN(v4[e]), 1u, __ATOMIC_RELAXED, __HIP_MEMORY_SCOPE_WORKGROUP); } }
            __syncthreads();
            int bA, kkA; topk_find_digit(hist + q * 256, 256, lane, bA, kkA);
            LAS unsigned* lst = cand + q * 512;
            for (int sb = 0; sb < nq; sb += 512) { const int s4 = sb + 4 * sub; const bool in4 = s4 < nq;
                f32x4 v4 = {0.f, 0.f, 0.f, 0.f}; if (in4) v4 = *(const LAS f32x4*)(row + s4);
#pragma unroll
                for (int e = 0; e < 4; ++e) { const int s = s4 + e; const bool in = s < nq; const float v = v4[e]; const int bin = DSA_BIN(v);
                    const bool gsel = in && bin > bA;
                    const unsigned long long gm = __ballot(gsel);
                    if (gm) { const int leader = __builtin_ctzll(gm); unsigned base = 0u;
                        if (lane == leader) base = __hip_atomic_fetch_add(misc + q * 4 + 2, (unsigned)__builtin_popcountll(gm), __ATOMIC_RELAXED, __HIP_MEMORY_SCOPE_WORKGROUP);
                        base = (unsigned)__builtin_amdgcn_readlane((int)base, leader);
                        const unsigned pos = base + (unsigned)__builtin_popcountll(gm & ((1ull << lane) - 1ull));
                        if (gsel && pos < 256u) selrow[pos] = s; }
                    if (in && bin == bA) { const unsigned cp = __hip_atomic_fetch_add(misc + q * 4 + 3, 1u, __ATOMIC_RELAXED, __HIP_MEMORY_SCOPE_WORKGROUP); if (cp < 256u) { lst[2 * cp] = f2key(v); lst[2 * cp + 1] = (unsigned)s; } } }
            }
            __syncthreads();
            const int nc = (int)misc[q * 4 + 3];
            if (nc <= 256) {
                for (int i = sub; i < nc; i += 128) { const unsigned ki = lst[2 * i], si = lst[2 * i + 1]; int rank = 0;
                    for (int j = 0; j < nc; ++j) { const unsigned kj = lst[2 * j], sj = lst[2 * j + 1]; rank += (kj > ki || (kj == ki && sj < si)) ? 1 : 0; }
                    if (rank < kkA) selrow[256 - kkA + rank] = (int)si; }
            } else if ((wid & 1) == 0) {
                unsigned prefix = 0u, maskb = 0u; int kk = kkA;
#pragma unroll 1
                for (int pass = 0; pass < 4; ++pass) { const int shift = 24 - 8 * pass;
                    for (int i = lane; i < 256; i += 64) hist[q * 256 + i] = 0u;
                    asm volatile("s_waitcnt lgkmcnt(0)" ::: "memory");
                    for (int s = lane; s < nq; s += 64) { const float v = row[s]; if (DSA_BIN(v) == bA) { const unsigned key = f2key(v); if ((key & maskb) == prefix) __hip_atomic_fetch_add(hist + q * 256 + ((key >> shift) & 255u), 1u, __ATOMIC_RELAXED, __HIP_MEMORY_SCOPE_WORKGROUP); } }
                    asm volatile("s_waitcnt lgkmcnt(0)" ::: "memory");
                    int dg, nk; topk_find_digit(hist + q * 256, kk, lane, dg, nk); kk = nk;
                    prefix |= (unsigned)dg << shift; maskb |= 255u << shift; }
                int baseG = 256 - kkA, baseE = 256 - kk; const int endE = 256;
                for (int sb = 0; sb < nq; sb += 64) { const int s = sb + lane; const bool in = s < nq; const float v = in ? row[s] : 0.f; const bool inb = in && DSA_BIN(v) == bA; const unsigned key = f2key(v);
                    const bool g = inb && key > prefix, e = inb && key == prefix;
                    const unsigned long long gm = __ballot(g), em = __ballot(e), lt = (1ull << lane) - 1ull;
                    if (g) { const int pos = baseG + __builtin_popcountll(gm & lt); if (pos < 256) selrow[pos] = s; }
                    if (e) { const int pos = baseE + __builtin_popcountll(em & lt); if (pos < endE) selrow[pos] = s; }
                    baseG += __builtin_popcountll(gm); baseE += __builtin_popcountll(em); }
            }
#undef DSA_BIN
        }
        __syncthreads();
    }
}
__device__ __forceinline__ void dsa_attn(const bf16_t* DP, const int* SEL, bf16_t* O, LAS unsigned char* lds, int widk) {
    IDX_SETUP
    LAS unsigned char* pl = lds + wid * 10240;
    LAS unsigned char* vt = lds + wid * 10240 + 2048;
    const int fr = lane & 15, fq = lane >> 4;
    unsigned tra[8][2];
#pragma unroll
    for (int cb = 0; cb < 8; ++cb)
#pragma unroll
        for (int t = 0; t < 2; ++t) { const unsigned q_ = (unsigned)(fr >> 2), p_ = (unsigned)(fr & 3), row = 8u * (unsigned)fq + 4u * (unsigned)t + q_, ch = 2u * (unsigned)cb + (p_ >> 1);
            tra[cb][t] = (unsigned)(size_t)vt + 256u * row + 16u * (ch ^ (((row & 3u) << 2) | ((row >> 2) & 3u))) + 8u * (p_ & 1u); }
    for (int m = 0;; ++m) {
#ifdef ATTN_BLOCKED_XCD
        const int kk_ = wid + 8 * m; if (kk_ >= 256 || G != 256) { if (G == 256) break; }
        const int pair = c >> 5, t = (c & 31) + 32 * kk_, b = pair >> 2, g = pair & 3;
#else
        const int jdx = c + G * (wid + 8 * m); if (jdx >= T * 4) break;
        const int pair = jdx & 7, t = jdx >> 3, b = pair >> 2, g = pair & 3;
#endif
        const size_t tok = (size_t)b * SEQ + t; const int nvalid = (t + 1) < 256 ? (t + 1) : 256;
        int s0 = SEL[tok * 256 + lane], s1 = SEL[tok * 256 + 64 + lane], s2 = SEL[tok * 256 + 128 + lane], s3 = SEL[tok * 256 + 192 + lane];
        s0 = s0 < 0 ? 0 : s0; s1 = s1 < 0 ? 0 : s1; s2 = s2 < 0 ? 0 : s2; s3 = s3 < 0 ? 0 : s3;
        bf16x8 qf[4];
#pragma unroll
        for (int ks = 0; ks < 4; ++ks) { qf[ks] = (bf16x8){0, 0, 0, 0, 0, 0, 0, 0}; if (fr < 4) qf[ks] = *(const bf16x8*)(DP + tok * DSA_NP + (g * 4 + fr) * 128 + ks * 32 + fq * 8); }
        const bf16_t* kbase = DP + (size_t)b * SEQ * DSA_NP + 2048 + g * 128 + fq * 8;
        f32x4 acc[16];
#pragma unroll
        for (int j = 0; j < 16; ++j) {
            const int sreg = (j < 4) ? s0 : (j < 8) ? s1 : (j < 12) ? s2 : s3;
            const int idx = shi(sreg, (16 * j + fr) & 63);
            const bf16_t* kr = kbase + (size_t)idx * DSA_NP;
            const bf16x8 a0 = *(const bf16x8*)kr, a1 = *(const bf16x8*)(kr + 32), a2 = *(const bf16x8*)(kr + 64), a3 = *(const bf16x8*)(kr + 96);
            f32x4 a = {0.f, 0.f, 0.f, 0.f};
            a = __builtin_amdgcn_mfma_f32_16x16x32_bf16(a0, qf[0], a, 0, 0, 0);
            a = __builtin_amdgcn_mfma_f32_16x16x32_bf16(a1, qf[1], a, 0, 0, 0);
            a = __builtin_amdgcn_mfma_f32_16x16x32_bf16(a2, qf[2], a, 0, 0, 0);
            a = __builtin_amdgcn_mfma_f32_16x16x32_bf16(a3, qf[3], a, 0, 0, 0);
            acc[j] = a;
            if ((j & 7) == 7) asm volatile("" ::: "memory");
        }
        const bf16_t* vbase = DP + (size_t)b * SEQ * DSA_NP + 2560 + g * 128 + fr * 8;
        u32x4 vcur[8], vnxt[8], vnn[8];
#define ATTN_VLOAD(dst, ks) do { const int sreg_ = ((ks) < 2) ? s0 : ((ks) < 4) ? s1 : ((ks) < 6) ? s2 : s3; _Pragma("unroll") for (int i = 0; i < 8; ++i) { \
            const int idx_ = shi(sreg_, 32 * ((ks) & 1) + fq + 4 * i); dst[i] = *(const u32x4*)(vbase + (size_t)idx_ * DSA_NP); } } while (0)
        ATTN_VLOAD(vcur, 0); ATTN_VLOAD(vnxt, 1);
        float mx = -__builtin_inff();
#pragma unroll
        for (int j = 0; j < 16; ++j)
#pragma unroll
            for (int r = 0; r < 4; ++r) { const int slot = 16 * j + 4 * fq + r; const float sv = (slot < nvalid) ? acc[j][r] * 0.08838834764831845f : -__builtin_inff(); acc[j][r] = sv; mx = fmaxf(mx, sv); }
        mx = fmaxf(mx, shx(mx, 16, lane)); mx = fmaxf(mx, shx(mx, 32, lane));
        float sum = 0.f;
#pragma unroll
        for (int j = 0; j < 16; ++j)
#pragma unroll
            for (int r = 0; r < 4; ++r) { const float pv = __expf(acc[j][r] - mx); acc[j][r] = pv; sum += pv; }
        sum += shx(sum, 16, lane); sum += shx(sum, 32, lane);
        const float inv = 1.0f / sum;
        if (fr < 4) {
#pragma unroll
            for (int j = 0; j < 16; ++j) { u32x2 w; w.x = cvt_pk_bf16(acc[j][0] * inv, acc[j][1] * inv); w.y = cvt_pk_bf16(acc[j][2] * inv, acc[j][3] * inv);
                *(LAS u32x2*)(pl + (fr * 256 + 16 * j + 4 * fq) * 2) = w; }
        }
        f32x4 oc[8];
#pragma unroll
        for (int cb = 0; cb < 8; ++cb) oc[cb] = (f32x4){0.f, 0.f, 0.f, 0.f};
#pragma unroll
        for (int ks = 0; ks < 8; ++ks) {
            if (ks < 6) ATTN_VLOAD(vnn, ks + 2);
#pragma unroll
            for (int i = 0; i < 8; ++i) { const unsigned row = (unsigned)(fq + 4 * i), ch = (unsigned)fr;
                *(LAS u32x4*)(vt + 256u * row + 16u * (ch ^ (((row & 3u) << 2) | ((row >> 2) & 3u)))) = vcur[i]; }
            bf16x8 pa = (bf16x8){0, 0, 0, 0, 0, 0, 0, 0};
            asm volatile("s_waitcnt lgkmcnt(0)" ::: "memory");
            if (fr < 4) pa = *(const LAS bf16x8*)(pl + (fr * 256 + 32 * ks + 8 * fq) * 2);
            u32x2 t0[8], t1[8];
#pragma unroll
            for (int cb = 0; cb < 8; ++cb) {
                asm volatile("ds_read_b64_tr_b16 %0, %1" : "=v"(t0[cb]) : "v"(tra[cb][0]) : "memory");
                asm volatile("ds_read_b64_tr_b16 %0, %1" : "=v"(t1[cb]) : "v"(tra[cb][1]) : "memory");
            }
            asm volatile("s_waitcnt lgkmcnt(0)" : "+v"(t0[0]), "+v"(t0[1]), "+v"(t0[2]), "+v"(t0[3]), "+v"(t0[4]), "+v"(t0[5]), "+v"(t0[6]), "+v"(t0[7]),
                                                  "+v"(t1[0]), "+v"(t1[1]), "+v"(t1[2]), "+v"(t1[3]), "+v"(t1[4]), "+v"(t1[5]), "+v"(t1[6]), "+v"(t1[7]), "+v"(pa) :: "memory");
#pragma unroll
            for (int cb = 0; cb < 8; ++cb) { const u32x4 bw = {t0[cb].x, t0[cb].y, t1[cb].x, t1[cb].y};
                oc[cb] = __builtin_amdgcn_mfma_f32_16x16x32_bf16(pa, __builtin_bit_cast(bf16x8, bw), oc[cb], 0, 0, 0); }
#pragma unroll
            for (int i = 0; i < 8; ++i) { vcur[i] = vnxt[i]; vnxt[i] = vnn[i]; }
        }
#undef ATTN_VLOAD
        if (fq == 0) {
            bf16_t* op = O + tok * D + (g * 4) * 128 + fr;
#pragma unroll
            for (int cb = 0; cb < 8; ++cb)
#pragma unroll
                for (int r = 0; r < 4; ++r) op[r * 128 + 16 * cb] = (bf16_t)f2bf(oc[cb][r]);
        }
        asm volatile("s_waitcnt lgkmcnt(0)" ::: "memory");
    }
}


#define XB_TMO      128
#define XB_XCNT(j)  (256  + 64 * (j))
#define XB_XSUB(j)  (1280 + 64 * (j))
#define XB_XGEN(j)  (2304 + 64 * (j))
#define XB_TOP      3328
#define XB_TOPGEN   3392
#define XB_SPIN_CAP (1u << 22)
__device__ __forceinline__ unsigned xb_ld(unsigned* p)              { return __hip_atomic_load(p, __ATOMIC_RELAXED, __HIP_MEMORY_SCOPE_AGENT); }
__device__ __forceinline__ unsigned xb_add(unsigned* p, unsigned v) { return __hip_atomic_fetch_add(p, v, __ATOMIC_RELAXED, __HIP_MEMORY_SCOPE_AGENT); }
__device__ __forceinline__ unsigned xb_xcc_id() { return (unsigned)__builtin_amdgcn_s_getreg((3 << 11) | 20) & 0xFu; }
#define XB_SPIN(cond, bar) do { unsigned _sp = 0; while (cond) { __builtin_amdgcn_s_sleep(1); \
    if ((++_sp & 255u) == 0u) { if (xb_ld(&(bar)[XB_TMO])) break; if (_sp > XB_SPIN_CAP) { atomicAdd(&(bar)[XB_TMO], 1u); break; } } } } while (0)
__device__ __forceinline__ void xcd_barrier_complete(unsigned* bar, unsigned x, unsigned& nloc, unsigned& nx) {
    const unsigned G = gridDim.x;
    unsigned sum, cnt, mine, sp = 0u;
    for (;;) {
        sum = 0u; cnt = 0u; mine = 0u;
#pragma unroll
        for (unsigned j = 0; j < 16; ++j) { const unsigned cc = xb_ld(&bar[XB_XCNT(j)]); sum += cc; cnt += (cc > 0u) ? 1u : 0u; mine = (j == x) ? cc : mine; }
        if (sum == G) break;
        __builtin_amdgcn_s_sleep(1);
        if ((++sp & 255u) == 0u) { if (xb_ld(&bar[XB_TMO])) break; if (sp > XB_SPIN_CAP) { atomicAdd(&bar[XB_TMO], 1u); break; } }
    }
    nloc = mine > 0u ? mine : 1u; nx = cnt > 0u ? cnt : 1u;
}
__device__ __forceinline__ void xcd_barrier(unsigned* bar, volatile LAS unsigned* st, int widk) {
    asm volatile("s_waitcnt vmcnt(0)" ::: "memory");
    __syncthreads();
    if (opaque_tid(widk) == 0) {
        __builtin_amdgcn_s_waitcnt(0);
        const unsigned x = xb_xcc_id();
        unsigned nloc = st[0], nx = st[1];
        if (nloc == 0u) { xcd_barrier_complete(bar, x, nloc, nx); st[0] = nloc; st[1] = nx; }
        const unsigned old = xb_add(&bar[XB_XSUB(x)], 1u);
        const unsigned gen = old / nloc;
        if (old + 1u == (gen + 1u) * nloc) {
            __builtin_amdgcn_fence(__ATOMIC_RELEASE, "agent");
            asm volatile("s_waitcnt vmcnt(0)" ::: "memory");
            const unsigned og = xb_add(&bar[XB_TOP], 1u);
            const unsigned tg = og / nx;
            if (og + 1u == (tg + 1u) * nx) xb_add(&bar[XB_TOPGEN], 1u);
            else XB_SPIN(xb_ld(&bar[XB_TOPGEN]) == tg, bar);
            __builtin_amdgcn_fence(__ATOMIC_ACQUIRE, "agent");
            xb_add(&bar[XB_XGEN(x)], 1u);
            asm volatile("s_waitcnt vmcnt(0)" ::: "memory");
        } else {
            XB_SPIN(xb_ld(&bar[XB_XGEN(x)]) == gen, bar);
            __builtin_amdgcn_fence(__ATOMIC_ACQUIRE, "agent");
            asm volatile("s_waitcnt vmcnt(0)" ::: "memory");
        }
    }
    __syncthreads();
}
#ifndef EN_MASK
#define EN_MASK 0xFFFFFF
#endif
#define EN(b) ((EN_MASK >> (b)) & 1)
#ifndef REP_MASK
#define REP_MASK 0
#endif
#define REPN(b) (1 + ((REP_MASK >> (b)) & 1))
__device__ __forceinline__ const void* ldp(LAS unsigned char* lds, int i) {
    const LAS unsigned* q = (const LAS unsigned*)(lds + 143360) + 2 * i;
    const unsigned lo = __builtin_amdgcn_readfirstlane(q[0]), hi = __builtin_amdgcn_readfirstlane(q[1]);
    return (const void*)(((unsigned long long)hi << 32) | lo);
}
#ifdef CGSYNC
#define GSYNC() grid.sync()
#else
#define GSYNC() do { for (int _r = 0; _r < REPN(20); ++_r) xcd_barrier((unsigned*)(WSP + OFF_CTL), (volatile LAS unsigned*)(lds + LDS_BAR_OFF), widk); } while (0)
#endif

__global__ void __launch_bounds__(512, 2) mega_fwd(Params P) {
    extern __shared__ __attribute__((aligned(16))) unsigned char lds_raw[];
    LAS unsigned char* lds = (LAS unsigned char*)lds_raw;
    cg::grid_group grid = cg::this_grid();
    const int G = gridDim.x, c = blockIdx.x;
    const int widk = __builtin_amdgcn_readfirstlane(threadIdx.x >> 6);
    if (threadIdx.x == 0) { ((LAS unsigned*)(lds + LDS_BAR_OFF))[0] = 0u; ((LAS unsigned*)(lds + LDS_BAR_OFF))[1] = 0u; }
    if (blockIdx.x == 0) for (int i = threadIdx.x; i < 3456; i += 512) __hip_atomic_store((unsigned*)(P.ws + OFF_CTL) + i, 0u, __ATOMIC_RELAXED, __HIP_MEMORY_SCOPE_AGENT);
    grid.sync();
    if (threadIdx.x == 0) (void)xb_add((unsigned*)(P.ws + OFF_CTL) + XB_XCNT(xb_xcc_id()), 1u);

#ifdef LDSP
    {
        LAS unsigned long long* PL = (LAS unsigned long long*)(lds + 143360);
        if (threadIdx.x == 0) { const unsigned long long* src = (const unsigned long long*)&P;
#pragma unroll
            for (int i = 0; i < 26; ++i) PL[i] = src[i]; }
        __syncthreads();
    }
#endif
#ifdef LDSP
#define PF(i) ((const float*)ldp(lds, (i)))
#else
#define PF(i) (((const float* const*)&P)[(i)])
#endif
#ifdef LDSP
#define WSP ((unsigned char*)ldp(lds, 25))
#else
#define WSP (P.ws)
#endif
#define XF ((float*)(WSP + OFF_XF))
#define XB ((bf16_t*)(WSP + OFF_XB))
#define PB ((bf16_t*)(WSP + OFF_PB))
#define PLEB ((bf16_t*)(WSP + OFF_PLE))
#define HB ((bf16_t*)(WSP + OFF_H))
#define ACTB ((bf16_t*)(WSP + OFF_ACT))
#define OB ((bf16_t*)(WSP + OFF_O))
#define KTT ((bf16_t*)(WSP + OFF_KTT))
#define SEL ((int*)(WSP + OFF_SEL))
#define XA ((float*)(WSP + OFF_XA))
#define SSQ ((float*)(WSP + OFF_SSQ))
#define DL ((float*)(WSP + OFF_DL))
#define KIN ((bf16_t*)(WSP + OFF_KIN))
#define WB ((bf16_t*)(WSP + OFF_W))
#define QKVR ((bf16_t*)(WSP + OFF_QKVR))
#define BP ((bf16_t*)(WSP + OFF_BP))
#define UT ((float*)(WSP + OFF_UT))
#define KT ((bf16_t*)(WSP + OFF_KT))
#define AP PLEB
#define STB ((float*)(WSP + OFF_ST))
#define PPB ((bf16_t*)(WSP + OFF_PP))


    for (int rep = 0; rep < REPN(12); ++rep) {
        IDX_SETUP
        LAS unsigned* scr = (LAS unsigned*)(lds + wid * 16384);
        if (EN(12)) {
#pragma unroll 1
        for (int j = 0; j < 2; ++j) {
            TJOB(PF(2) + (size_t)j * D * GLA_N, D, GLA_N, WB + W_GIN + (size_t)j * GLA_N * D, 0);
            TJOB(PF(7) + (size_t)j * D * D, D, D, WB + W_GO + (size_t)j * D * D, 0);
        }
#pragma unroll 1
        for (int g = 0; g < 4; ++g) TJOB(PF(8) + (size_t)g * 512 * 512, 512, 512, WB + W_POOL, g * 512);
        TJOB(PF(10), D, DSA_N, WB + W_DIN, 0);
        TJOB(PF(13), D, D, WB + W_DO, 0);
#pragma unroll 1
        for (int i = 0; i < 4; ++i) {
            TJOB(PF(16) + (size_t)i * D * NUP, D, NUP, WB + W_UP + (size_t)i * NUP * D, 0);
            TJOB(PF(19) + (size_t)i * DFF * D, DFF, D, WB + W_DOWN + (size_t)i * D * DFF, 0);
            TJOB(PF(20) + (size_t)i * D * D, D, D, WB + W_GATE + (size_t)i * D * D, 0);
            TJOB(PF(21) + (size_t)i * PLE * D, PLE, D, WB + W_PROJ + (size_t)i * D * PLE, 0);
        }
        }
        if (EN(13)) row_pass(PF(0), nullptr, nullptr, nullptr, XB, nullptr, widk);
        for (size_t i = (size_t)gt; i < (size_t)4 * T * PLE / 4; i += (size_t)NT) { const f32x4 v = ((const f32x4*)PF(1))[i]; u32x2 w; w.x = cvt_pk_bf16(v.x, v.y); w.y = cvt_pk_bf16(v.z, v.w); ((u32x2*)PB)[i] = w; }
    }
    GSYNC();

#pragma unroll 1
    for (int layer = 0; layer < 4; ++layer) {
        const int kind = layer % 3, jl = layer / 3;
        const float* xsrc = (layer == 0) ? PF(0) : XF;
        if (kind != 1) {
            if (kind == 0) for (int rep = 0; rep < REPN(21); ++rep) xa_pass(XB, PF(3) + (size_t)jl * D * 16, XA, widk);
            const int N = (kind == 0) ? GLA_N : DSA_NP;
            pg8::PlainSched S; S.o.init(T / 256, N / 256, G, c); S.A = (const char*)XB; S.B = (const char*)(kind == 0 ? WB + W_GIN + (size_t)jl * GLA_N * D : WB + W_DIN);
            S.tsA = (size_t)256 * D * 2; S.tsB = (size_t)256 * D * 2; S.poolmode = 0;
            pg8::EpiBf16<0> E{HB, N};
            for (int rep = 0; rep < REPN(14); ++rep) pg8::gemm_phase(lds, D, D, D, S, E, widk);
            GSYNC();
        }
        if (kind == 0) {
            for (int rep = 0; rep < REPN(0); ++rep) gla_prep(QKVR, XA, PF(4) + (size_t)jl * 16 * 1024, PF(5) + (size_t)jl * 1024, AP, KT, KTT, DL, lds, widk);
            for (int rep = 0; rep < REPN(1); ++rep) gla_vt(QKVR, BP, lds, widk);
            { IDX_SETUP for (int i = gt; i < T * 4; i += NT) SSQ[i] = 0.f; }
            GSYNC();
            for (int rep = 0; rep < REPN(2); ++rep) { GlaScoreSched S{G, c, AP, KT}; GlaScoreEpi E{AP}; pg8::gemm_phase(lds, 256, 2048, 1024, S, E, widk); }
            for (int rep = 0; rep < REPN(3); ++rep) { GlaUSched S{G, c, BP, KTT}; GlaUEpi E{UT, DL}; pg8::gemm_phase(lds, 256, 512, SEQ, S, E, widk); }
            GSYNC();
            for (int rep = 0; rep < REPN(4); ++rep) gla_scan(UT, DL, BP, widk);
            GSYNC();
            if (EN(5)) { GlaOSched S{G, c, AP, BP}; GlaOEpi E{OB, SSQ}; pg8::gemm_phase(lds, 512, 2048, 512, S, E, widk); }
            GSYNC();
            if (EN(6)) gla_gate(OB, SSQ, QKVR, PF(6) + (size_t)jl * D, widk);
            GSYNC();
        } else if (kind == 1) {
            for (int rep = 0; rep < REPN(7); ++rep) pool_pass(XB, OB, widk);
            GSYNC();
        } else {
            for (int rep = 0; rep < REPN(8); ++rep) dsa_kin(HB, PF(11), PF(12), KIN, widk);
            GSYNC();
            for (int rep = 0; rep < REPN(9); ++rep) dsa_topk(HB, KIN, SEL, lds, widk);
            GSYNC();
            for (int rep = 0; rep < REPN(10); ++rep) dsa_attn(HB, SEL, OB, lds, widk);
            GSYNC();
        }
        {
            pg8::PlainSched S; S.o.init(T / 256, D / 256, G, c); S.A = (const char*)OB;
            S.B = (const char*)(kind == 0 ? WB + W_GO + (size_t)jl * D * D : kind == 1 ? WB + W_POOL : WB + W_DO);
            const int K = (kind == 1) ? 512 : D;
            S.tsA = (size_t)256 * D * 2; S.tsB = (size_t)256 * K * 2; S.poolmode = (kind == 1);
            pg8::EpiResidT<4> E{xsrc, XF, (kind == 1) ? PF(9) : nullptr, nullptr, nullptr, (layer == 0) ? nullptr : STB, PF(22) + (size_t)(layer - 1) * D, PF(23) + (size_t)(layer - 1) * D};
            if (REPN(15) > 1) { pg8::EpiResid E2{xsrc, (float*)HB, (kind == 1) ? PF(9) : nullptr, nullptr, nullptr, (layer == 0) ? nullptr : STB, PF(22) + (size_t)(layer - 1) * D, PF(23) + (size_t)(layer - 1) * D}; pg8::gemm_phase(lds, K, D, K, S, E2, widk); }
            if (EN(15)) pg8::gemm_phase(lds, K, D, K, S, E, widk);
        }
        GSYNC();
        if (EN(13)) row_pass(XF, PF(14) + (size_t)layer * D, PF(15) + (size_t)layer * D, nullptr, XB, STB, widk);
        if (REPN(13) > 1) row_pass(XF, PF(14) + (size_t)layer * D, PF(15) + (size_t)layer * D, (float*)HB, OB, nullptr, widk);
        GSYNC();
#pragma unroll 1
        for (int gi = 0; gi < 2; ++gi) {
            const int N = gi == 0 ? NUP : D;
            pg8::PlainSched S; S.o.init(T / 256, N / 256, G, c); S.A = (const char*)XB;
            S.B = (const char*)(gi == 0 ? WB + W_UP + (size_t)layer * NUP * D : WB + W_GATE + (size_t)layer * D * D);
            S.tsA = (size_t)256 * D * 2; S.tsB = (size_t)256 * D * 2; S.poolmode = 0;
            if (gi == 0) { pg8::EpiBf16<0> E{HB, NUP}; for (int rep = 0; rep < REPN(16); ++rep) pg8::gemm_phase(lds, D, D, D, S, E, widk); }
            else { pg8::EpiBf16<2> E{PLEB, D}; for (int rep = 0; rep < REPN(17); ++rep) pg8::gemm_phase(lds, D, D, D, S, E, widk); }
        }
        {
            pg8::PlainSched S; S.o.init(T / 256, D / 256, G, c); S.A = (const char*)(PB + (size_t)layer * T * PLE); S.B = (const char*)(WB + W_PROJ + (size_t)layer * D * PLE);
            S.tsA = (size_t)256 * PLE * 2; S.tsB = (size_t)256 * PLE * 2; S.poolmode = 0;
            pg8::EpiBf16<0> E{PPB, D};
            for (int rep = 0; rep < REPN(18); ++rep) pg8::gemm_phase(lds, PLE, PLE, PLE, S, E, widk);
        }
        GSYNC();
        for (int rep = 0; rep < REPN(11); ++rep) conv_pass(HB, PF(17) + (size_t)layer * 3 * NUP, PF(18) + (size_t)layer * NUP, ACTB, widk);
        GSYNC();
        {
            pg8::PlainSched S; S.o.init(T / 256, D / 256, G, c); S.A = (const char*)ACTB; S.B = (const char*)(WB + W_DOWN + (size_t)layer * D * DFF);
            S.tsA = (size_t)256 * DFF * 2; S.tsB = (size_t)256 * DFF * 2; S.poolmode = 0;
            pg8::EpiResid E{XF, XF, nullptr, PLEB, PPB, STB, PF(14) + (size_t)layer * D, PF(15) + (size_t)layer * D};
            if (REPN(19) > 1) { pg8::EpiResid E2{XF, (float*)HB, nullptr, PLEB, PPB, STB, PF(14) + (size_t)layer * D, PF(15) + (size_t)layer * D}; pg8::gemm_phase(lds, DFF, DFF, DFF, S, E2, widk); }
            if (EN(19)) pg8::gemm_phase(lds, DFF, DFF, DFF, S, E, widk);
        }
        GSYNC();
        if (!EN(13)) {} else if (layer == 3) row_pass(XF, PF(22) + (size_t)layer * D, PF(23) + (size_t)layer * D, ((float*)PF(24)), nullptr, nullptr, widk);
        else row_pass(XF, PF(22) + (size_t)layer * D, PF(23) + (size_t)layer * D, nullptr, XB, STB, widk);
        if (layer != 3) GSYNC();
    }
}

extern "C" void kernel_launch(void* const* d_in, const int* in_sizes, int n_in, void* d_out, int out_size, void* d_ws, size_t ws_size, hipStream_t stream) {
    static int grid = 0;
    if (grid == 0) {
        if (n_in != 24 || out_size != T * D || ws_size < WS_END) { fprintf(stderr, "kernel_launch: unexpected problem (n_in %d, out %d, ws %zu < %zu)\n", n_in, out_size, ws_size, (size_t)WS_END); grid = -1; return; }
        int dev = 0, cus = 0, per_cu = 0;
        (void)hipGetDevice(&dev); (void)hipDeviceGetAttribute(&cus, hipDeviceAttributeMultiprocessorCount, dev);
        if (hipFuncSetAttribute((const void*)mega_fwd, hipFuncAttributeMaxDynamicSharedMemorySize, LDS_BYTES) != hipSuccess) { fprintf(stderr, "kernel_launch: hipFuncSetAttribute failed\n"); grid = -1; return; }
        if (hipOccupancyMaxActiveBlocksPerMultiprocessor(&per_cu, (const void*)mega_fwd, 512, LDS_BYTES) != hipSuccess || per_cu < 1) { fprintf(stderr, "kernel_launch: occupancy query says %d blocks/CU\n", per_cu); per_cu = 1; }
        (void)hipGetLastError();
        grid = cus;
    }
    if (grid < 0) return;
    Params p{};
    const float** pf = (const float**)&p;
    for (int i = 0; i < 24; ++i) pf[i] = (const float*)d_in[i];
    p.out = (float*)d_out; p.ws = (unsigned char*)d_ws;
    void* args[] = {&p};
    hipError_t e = hipLaunchCooperativeKernel((const void*)mega_fwd, dim3(grid), dim3(512), args, LDS_BYTES, stream);
    if (e != hipSuccess) fprintf(stderr, "kernel_launch: cooperative launch failed: %s (grid %d)\n", hipGetErrorString(e), grid);
}
```

```cpp
#include <hip/hip_runtime.h>
#include <hip/hip_cooperative_groups.h>
#include <cstdio>
namespace cg = cooperative_groups;

#define LAS __attribute__((address_space(3)))
typedef unsigned short bf16_t;
typedef short bf16x8 __attribute__((ext_vector_type(8)));
typedef float f32x4 __attribute__((ext_vector_type(4)));
typedef float f32x2 __attribute__((ext_vector_type(2)));
typedef unsigned u32x4 __attribute__((ext_vector_type(4)));
typedef unsigned u32x2 __attribute__((ext_vector_type(2)));

constexpr int T = 16384, SEQ = 8192, D = 2048, DFF = 5504, NUP = 11008, PLE = 256;
constexpr int GLA_N = 6144, DSA_N = 4176, DSA_NP = 4352;
constexpr float LN_EPS = 1e-5f;
constexpr float ALPHA = 1.681792830507429f;

constexpr size_t OFF_XF = 0;
constexpr size_t OFF_XB = OFF_XF + (size_t)T * D * 4;
constexpr size_t OFF_PB = OFF_XB + (size_t)T * D * 2;
constexpr size_t OFF_PLE = OFF_PB + (size_t)4 * T * PLE * 2;
constexpr size_t OFF_H = OFF_PLE + (size_t)T * D * 2;
constexpr size_t OFF_ACT = OFF_H + (size_t)T * NUP * 2;
constexpr size_t OFF_O = OFF_ACT + (size_t)T * DFF * 2;
constexpr size_t OFF_KTT = OFF_O + (size_t)T * D * 2;
constexpr size_t OFF_SEL = OFF_KTT + (size_t)T * 1024 * 2;
constexpr size_t OFF_XA = OFF_SEL + (size_t)T * 256 * 4;
constexpr size_t OFF_SSQ = OFF_XA + (size_t)T * 16 * 4;
constexpr size_t OFF_DL = OFF_SSQ + (size_t)T * 4 * 4;
constexpr size_t OFF_KIN = OFF_DL + (size_t)8 * 32 * 256 * 4;
constexpr size_t OFF_PP = OFF_KIN + (size_t)T * 64 * 2;
constexpr size_t OFF_CTL = OFF_PP + (size_t)T * D * 2;
constexpr size_t CTL_BYTES = 65536;
constexpr size_t OFF_ST = OFF_CTL + CTL_BYTES;
constexpr size_t OFF_W = OFF_ST + (size_t)T * 8;
constexpr size_t W_GIN = 0;
constexpr size_t W_GO = W_GIN + (size_t)2 * GLA_N * D;
constexpr size_t W_POOL = W_GO + (size_t)2 * D * D;
constexpr size_t W_DIN = W_POOL + (size_t)D * 512;
constexpr size_t W_DO = W_DIN + (size_t)DSA_NP * D;
constexpr size_t W_UP = W_DO + (size_t)D * D;
constexpr size_t W_DOWN = W_UP + (size_t)4 * NUP * D;
constexpr size_t W_GATE = W_DOWN + (size_t)4 * D * DFF;
constexpr size_t W_PROJ = W_GATE + (size_t)4 * D * D;
constexpr size_t W_END = W_PROJ + (size_t)4 * D * PLE;
constexpr size_t WS_END = OFF_W + W_END * 2;
constexpr size_t OFF_QKVR = OFF_H;
constexpr size_t OFF_BP = OFF_H + (size_t)T * GLA_N * 2;
constexpr size_t OFF_UT = OFF_ACT;
constexpr size_t OFF_KT = OFF_ACT + (size_t)8 * 32 * 512 * 256 * 4;
static_assert(OFF_BP + (size_t)8 * 32 * 512 * 512 * 2 <= OFF_ACT, "GLA overlay 1");
static_assert(OFF_KT + (size_t)T * 1024 * 2 <= OFF_O, "GLA overlay 2");

constexpr int LDS_BYTES = 147456;
constexpr int LDS_BAR_OFF = LDS_BYTES - 64;

__device__ __forceinline__ float bf2f(unsigned short b) { return __uint_as_float(((unsigned)b) << 16); }
__device__ __forceinline__ unsigned f2bf(float f) { unsigned u = __float_as_uint(f); return (u + 0x7fffu + ((u >> 16) & 1u)) >> 16; }
__device__ __forceinline__ unsigned cvt_pk_bf16(float lo, float hi) { unsigned r; asm volatile("v_cvt_pk_bf16_f32 %0, %1, %2" : "=v"(r) : "v"(lo), "v"(hi)); return r; }
__device__ __forceinline__ float lo16(unsigned w) { return __uint_as_float(w << 16); }
__device__ __forceinline__ float hi16(unsigned w) { return __uint_as_float(w & 0xffff0000u); }
__device__ __forceinline__ float shx(float v, int m, int lane) { return __int_as_float(__builtin_amdgcn_ds_bpermute((lane ^ m) << 2, __float_as_int(v))); }
__device__ __forceinline__ int shi(int v, int src) { return __builtin_amdgcn_ds_bpermute(src << 2, v); }
__device__ __forceinline__ float wave_sum(float v, int lane) {
#pragma unroll
    for (int o = 1; o < 64; o <<= 1) v += shx(v, o, lane);
    return v;
}
__device__ __forceinline__ f32x2 gelu_pk(f32x2 v) {
    const f32x2 av = __builtin_elementwise_abs(v), d = av * 0.2316418882f + 1.0f;
    f32x2 t; t.x = __builtin_amdgcn_rcpf(d.x); t.y = __builtin_amdgcn_rcpf(d.y);
    f32x2 q = t * 0.5307027145f + (-0.7265760135f); q = q * t + 0.7107068705f; q = q * t + (-0.142248368f); q = q * t + 0.127414796f; q = q * t;
    const f32x2 s = (v * v) * (-0.72134752044f);
    f32x2 e; e.x = __builtin_amdgcn_exp2f(s.x); e.y = __builtin_amdgcn_exp2f(s.y);
    const f32x2 m = v * (q * e), r = v - m;
    f32x2 o; o.x = v.x < 0.f ? m.x : r.x; o.y = v.y < 0.f ? m.y : r.y; return o;
}
__device__ __forceinline__ float sigmoidf_(float x) { return 1.0f / (1.0f + __expf(-x)); }

__device__ __forceinline__ int lane_asm() { int l; asm volatile("v_mbcnt_lo_u32_b32 %0, -1, 0\n\tv_mbcnt_hi_u32_b32 %0, -1, %0" : "=&v"(l)); return l; }
__device__ __forceinline__ int opaque_tid(int widk) { asm volatile("" : "+s"(widk)); int l; asm volatile("v_mbcnt_lo_u32_b32 %0, -1, 0\n\tv_mbcnt_hi_u32_b32 %0, -1, %0" : "=&v"(l)); return (widk << 6) | l; }
__device__ __forceinline__ int opaque_s(int v) { v = __builtin_amdgcn_readfirstlane(v); asm volatile("" : "+s"(v)); return v; }
#define IDX_SETUP const int tid = opaque_tid(widk), lane = tid & 63, wid = __builtin_amdgcn_readfirstlane(tid >> 6); const int G = opaque_s(gridDim.x), c = opaque_s(blockIdx.x); \
    const int gw = c * 8 + wid, NGW = G * 8, gt = c * 512 + tid, NT = G * 512; (void)lane; (void)wid; (void)gw; (void)NGW; (void)gt; (void)NT;
namespace pg8 {
constexpr int BM = 256, BK = 64, HALF = 128, HTB = HALF * BK * 2, NXCD = 8, WGM = 4;
__host__ __device__ __forceinline__ int lds_byte(int r, int c) { const int st = (r >> 4) * 2 + (c >> 5), rr = r & 15, cc = c & 31, ob = rr * 64 + cc * 2; return st * 1024 + (ob ^ (((ob >> 9) & 1) << 5)); }
__host__ __device__ __forceinline__ void stage_rc(int b, int& R, int& C) { const int st = b / 1024, sb = b % 1024, swz = sb ^ (((sb >> 9) & 1) << 5); R = (st >> 1) * 16 + swz / 64; C = (st & 1) * 32 + (swz % 64) / 2; }
__host__ __device__ __forceinline__ int perm32(int rho) { const int n = rho >> 4, i = rho & 15; return 8 * (i >> 2) + 4 * n + (i & 3); }

struct Unit { int pm, pn; const char* A; const char* B; };

struct TileOrder {
    int nM, nN, nwg, G, c;
    __device__ __forceinline__ void init(int nM_, int nN_, int G_, int c_) { nM = nM_; nN = nN_; nwg = nM * nN; G = G_; c = c_; }
    __device__ __forceinline__ bool next(int i, int& pm, int& pn) const {
        const long L = (long)i * G + c; if (L >= nwg) return false;
        int wgid = (int)L; { const int q = nwg / NXCD, r = nwg % NXCD, xcd = wgid % NXCD, off = wgid / NXCD; wgid = (xcd < r ? xcd * (q + 1) : r * (q + 1) + (xcd - r) * q) + off; }
        const int nig = WGM * nN, gid = wgid / nig, fm = gid * WGM, gsz = (nM - fm) < WGM ? (nM - fm) : WGM;
        pm = fm + ((wgid % nig) % gsz); pn = (wgid % nig) / gsz; return true;
    }
};
struct PlainSched {
    TileOrder o; const char* A; const char* B; size_t tsA, tsB; int poolmode;
    __device__ __forceinline__ bool next(int i, Unit& u) const {
        if (!o.next(i, u.pm, u.pn)) return false;
        u.A = A + (size_t)u.pm * tsA + (poolmode ? (size_t)(u.pn >> 1) * 1024 : 0); u.B = B + (size_t)u.pn * tsB; return true;
    }
};

template <int ACT  , bool NT = false  > struct EpiBf16 {
    static constexpr bool PERM = true;
    bf16_t* O; int ldc;
    __device__ __forceinline__ void operator()(const f32x4 (&acc)[2][2][4][2], const Unit& u, int wr, int wc, int fr, int fq) const {
        const int lane = lane_asm(); fr = lane & 15; fq = lane >> 4; (void)lane;
        const int row0 = u.pm * BM + wr * 64 + fr, col0 = u.pn * BM + wc * 32 + 8 * fq;
#pragma unroll
        for (int ai = 0; ai < 2; ++ai)
#pragma unroll
            for (int m = 0; m < 4; ++m) { bf16_t* rowp = O + (size_t)(row0 + ai * HALF + m * 16) * ldc + col0;
#pragma unroll
                for (int bj = 0; bj < 2; ++bj) { f32x4 v0 = acc[ai][bj][m][0], v1 = acc[ai][bj][m][1];
                    if (ACT == 2) {
#pragma unroll
                        for (int j = 0; j < 4; ++j) { v0[j] = sigmoidf_(v0[j]); v1[j] = sigmoidf_(v1[j]); } }
                    u32x4 w; w.x = cvt_pk_bf16(v0[0], v0[1]); w.y = cvt_pk_bf16(v0[2], v0[3]); w.z = cvt_pk_bf16(v1[0], v1[1]); w.w = cvt_pk_bf16(v1[2], v1[3]);
                    if (NT) __builtin_nontemporal_store(w, (u32x4*)(rowp + bj * HALF)); else *(u32x4*)(rowp + bj * HALF) = w; } }
    }
};
struct EpiPleMul {
    static constexpr bool PERM = true;
    bf16_t* O; int ldc;
    __device__ __forceinline__ void operator()(const f32x4 (&acc)[2][2][4][2], const Unit& u, int wr, int wc, int fr, int fq) const {
        const int lane = lane_asm(); fr = lane & 15; fq = lane >> 4; (void)lane;
        const int row0 = u.pm * BM + wr * 64 + fr, col0 = u.pn * BM + wc * 32 + 8 * fq;
#pragma unroll
        for (int ai = 0; ai < 2; ++ai)
#pragma unroll
            for (int m = 0; m < 4; ++m) { bf16_t* rowp = O + (size_t)(row0 + ai * HALF + m * 16) * ldc + col0;
#pragma unroll
                for (int bj = 0; bj < 2; ++bj) { const f32x4 v0 = acc[ai][bj][m][0], v1 = acc[ai][bj][m][1];
                    const u32x4 g = *(const u32x4*)(rowp + bj * HALF);
                    u32x4 w; w.x = cvt_pk_bf16(v0[0] * lo16(g.x), v0[1] * hi16(g.x)); w.y = cvt_pk_bf16(v0[2] * lo16(g.y), v0[3] * hi16(g.y));
                    w.z = cvt_pk_bf16(v1[0] * lo16(g.z), v1[1] * hi16(g.z)); w.w = cvt_pk_bf16(v1[2] * lo16(g.w), v1[3] * hi16(g.w));
                    *(u32x4*)(rowp + bj * HALF) = w; }
                asm volatile("" ::: "memory"); }
    }
};
template <int NB  > struct EpiResidT {
    static constexpr bool PERM = false;
    const float* src; float* dst; const float* cscale; const bf16_t* ple; const bf16_t* ple2;
    const float* st; const float* lg; const float* lb;
    __device__ __forceinline__ void operator()(const f32x4 (&acc)[2][2][4][2], const Unit& u, int wr, int wc, int fr, int fq) const {
        const int lane = lane_asm(); fr = lane & 15; fq = lane >> 4; (void)lane;
        const int row0 = u.pm * BM + wr * 64 + fr, col0 = u.pn * BM + wc * 32 + 4 * fq;
#pragma unroll
        for (int ai = 0; ai < 2; ++ai)
#pragma unroll
            for (int mp = 0; mp < 4 / NB; ++mp) {
                f32x4 sv[NB][2][2]; u32x2 pv[NB][2][2], qv[NB][2][2]; f32x2 sr[NB];
#pragma unroll
                for (int mm = 0; mm < NB; ++mm) { const int m = NB * mp + mm; const size_t rr = (size_t)(row0 + ai * HALF + m * 16), off = rr * D + col0;
                    sr[mm] = (f32x2){0.f, 1.f}; if (st) sr[mm] = *(const f32x2*)(st + 2 * rr);
#pragma unroll
                    for (int bj = 0; bj < 2; ++bj)
#pragma unroll
                        for (int n = 0; n < 2; ++n) { const size_t o2 = off + bj * HALF + n * 16; sv[mm][bj][n] = *(const f32x4*)(src + o2);
                            if (NB == 2 && ple) { pv[mm][bj][n] = *(const u32x2*)(ple + o2); qv[mm][bj][n] = *(const u32x2*)(ple2 + o2); } } }
#pragma unroll
                for (int mm = 0; mm < NB; ++mm) { const int m = NB * mp + mm; const size_t off = (size_t)(row0 + ai * HALF + m * 16) * D + col0;
#pragma unroll
                    for (int bj = 0; bj < 2; ++bj)
#pragma unroll
                        for (int n = 0; n < 2; ++n) { const size_t o2 = off + bj * HALF + n * 16; f32x4 a = acc[ai][bj][m][n];
                            if (cscale) a = a * *(const f32x4*)(cscale + col0 + bj * HALF + n * 16);
                            if (NB == 2 && ple) { const u32x2 pw = pv[mm][bj][n], qw = qv[mm][bj][n];
                                a = a + (f32x4){lo16(pw.x) * lo16(qw.x), hi16(pw.x) * hi16(qw.x), lo16(pw.y) * lo16(qw.y), hi16(pw.y) * hi16(qw.y)}; }
                            f32x4 sx = sv[mm][bj][n];
                            if (st) sx = (sx - sr[mm].x) * sr[mm].y * *(const f32x4*)(lg + col0 + bj * HALF + n * 16) + *(const f32x4*)(lb + col0 + bj * HALF + n * 16);
                            *(f32x4*)(dst + o2) = sx * ALPHA + a; } }
                asm volatile("" ::: "memory");
            }
    }
};

typedef EpiResidT<2> EpiResid;

template <class Epi, class Sched>
__device__ __forceinline__ void gemm_phase(LAS unsigned char* lds, const int K, const int lda, const int ldb, const Sched& S, const Epi& E, int widk) {
    const int tid = opaque_tid(widk), wid = __builtin_amdgcn_readfirstlane(tid >> 6), lane = tid & 63, wr = wid >> 2, wc = wid & 3, fr = lane & 15, fq = lane >> 4;
    const int nt = K / BK;
    unsigned voffA[2], voffB[2];
#pragma unroll
    for (int i = 0; i < 2; ++i) { int R, C; stage_rc(tid * 16 + i * 8192, R, C); const int Rb = Epi::PERM ? ((R & ~31) + perm32(R & 31)) : R;
        voffA[i] = (unsigned)(R * lda + C) * 2u; voffB[i] = (unsigned)(Rb * ldb + C) * 2u; }
    const size_t kstep = (size_t)(BK * 2);
    const size_t hsA = (size_t)HALF * lda * 2, hsB = (size_t)HALF * ldb * 2;
    const unsigned ldsw = (unsigned)wid * 1024u;
    const int aoff = lds_byte(wr * 64 + fr, fq * 8), boff = lds_byte(wc * 32 + fr, fq * 8);
#define PG8_SA(b, h) (((b) * 2 + (h)) * HTB)
#define PG8_SB(b, h) ((4 + (b) * 2 + (h)) * HTB)
#define PG8_STAGE(bufoff, gbase, voff) do { _Pragma("unroll") for (int _i = 0; _i < 2; ++_i) \
        __builtin_amdgcn_global_load_lds((const unsigned*)((const char*)(gbase) + (voff)[_i]), (LAS unsigned*)(lds + (bufoff) + ldsw + _i * 8192), 16, 0, 0); } while (0)
#define PG8_LDA(dst, b, h) do { _Pragma("unroll") for (int m = 0; m < 4; ++m) _Pragma("unroll") for (int k = 0; k < 2; ++k) dst[m][k] = *(const LAS bf16x8*)(lds + PG8_SA(b, h) + aoff + m * 2048 + k * 1024); } while (0)
#define PG8_LDB(dst, b, h) do { _Pragma("unroll") for (int n = 0; n < 2; ++n) _Pragma("unroll") for (int k = 0; k < 2; ++k) dst[n][k] = *(const LAS bf16x8*)(lds + PG8_SB(b, h) + boff + n * 2048 + k * 1024); } while (0)
#define PG8_MMA(ai, bj, At, Bt) do { __builtin_amdgcn_s_setprio(1); _Pragma("unroll") for (int m = 0; m < 4; ++m) _Pragma("unroll") for (int n = 0; n < 2; ++n) _Pragma("unroll") for (int k = 0; k < 2; ++k) \
        acc[ai][bj][m][n] = __builtin_amdgcn_mfma_f32_16x16x32_bf16(Bt[n][k], At[m][k], acc[ai][bj][m][n], 0, 0, 0); __builtin_amdgcn_s_setprio(0); } while (0)
#define PG8_WAIT_V(n) asm volatile("s_waitcnt vmcnt(" #n ")" ::: "memory")
#define PG8_WAIT_L(n) asm volatile("s_waitcnt lgkmcnt(" #n ")" ::: "memory")
#define PG8_BAR __builtin_amdgcn_s_barrier()
#define PG8_SCHED __builtin_amdgcn_sched_barrier(0)
    Unit cur, nxt; int ui = 0;
    if (!S.next(0, cur)) return;
    f32x4 acc[2][2][4][2];
#pragma unroll
    for (int a = 0; a < 2; ++a)
#pragma unroll
        for (int b = 0; b < 2; ++b)
#pragma unroll
            for (int m = 0; m < 4; ++m)
#pragma unroll
                for (int n = 0; n < 2; ++n) acc[a][b][m][n] = (f32x4){0.f, 0.f, 0.f, 0.f};
    bf16x8 At[4][2], B0[2][2], B1[2][2];
    const char* cA = cur.A; const char* cB = cur.B;
    PG8_STAGE(PG8_SB(0, 0), cB, voffB); PG8_STAGE(PG8_SB(0, 1), cB + hsB, voffB); PG8_STAGE(PG8_SA(0, 0), cA, voffA); PG8_STAGE(PG8_SA(0, 1), cA + hsA, voffA);
    if (wr == 1) PG8_BAR;
    PG8_WAIT_V(2); PG8_BAR;
    PG8_STAGE(PG8_SB(1, 0), cB + kstep, voffB); PG8_STAGE(PG8_SA(1, 0), cA + kstep, voffA); PG8_STAGE(PG8_SB(1, 1), cB + hsB + kstep, voffB);
    PG8_WAIT_V(6); PG8_BAR;
    for (;;) {
        const bool has_next = S.next(ui + 1, nxt);
        const char* nA = has_next ? nxt.A : cA; const char* nB = has_next ? nxt.B : cB;
        for (int t = 0; t < nt; t += 2) {
            const bool last = (t == nt - 2);
            const char* a1 = cA + (size_t)(t + 1) * kstep;
            const char* a2 = last ? nA : cA + (size_t)(t + 2) * kstep; const char* b2 = last ? nB : cB + (size_t)(t + 2) * kstep;
            const char* a3 = a2 + kstep; const char* b3 = b2 + kstep;
            PG8_LDB(B0, 0, 0); PG8_LDB(B1, 0, 1); PG8_SCHED; PG8_LDA(At, 0, 0); PG8_STAGE(PG8_SA(1, 1), a1 + hsA, voffA);
            PG8_WAIT_V(8); PG8_WAIT_L(0); PG8_BAR; PG8_MMA(0, 0, At, B0); PG8_MMA(0, 1, At, B1); PG8_BAR; PG8_SCHED;
            PG8_LDA(At, 0, 1); PG8_STAGE(PG8_SB(0, 0), b2, voffB); PG8_STAGE(PG8_SB(0, 1), b2 + hsB, voffB); PG8_STAGE(PG8_SA(0, 0), a2, voffA);
            PG8_WAIT_V(8); PG8_WAIT_L(0); PG8_BAR; PG8_MMA(1, 0, At, B0); PG8_MMA(1, 1, At, B1); PG8_BAR; PG8_SCHED;
            PG8_LDB(B0, 1, 0); PG8_LDB(B1, 1, 1); PG8_SCHED; PG8_LDA(At, 1, 0); PG8_STAGE(PG8_SA(0, 1), a2 + hsA, voffA);
            PG8_WAIT_V(8); PG8_WAIT_L(0); PG8_BAR; PG8_MMA(0, 0, At, B0); PG8_MMA(0, 1, At, B1); PG8_BAR; PG8_SCHED;
            PG8_LDA(At, 1, 1); PG8_STAGE(PG8_SB(1, 0), b3, voffB); PG8_STAGE(PG8_SB(1, 1), b3 + hsB, voffB); PG8_STAGE(PG8_SA(1, 0), a3, voffA);
            PG8_WAIT_V(8); PG8_WAIT_L(0); PG8_BAR; PG8_MMA(1, 0, At, B0); PG8_MMA(1, 1, At, B1); PG8_BAR; PG8_SCHED;
        }
        if (wr == 0) PG8_BAR;
        E(acc, cur, wr, wc, fr, fq);
        if (!has_next) break;
#pragma unroll
        for (int a = 0; a < 2; ++a)
#pragma unroll
            for (int b = 0; b < 2; ++b)
#pragma unroll
                for (int m = 0; m < 4; ++m)
#pragma unroll
                    for (int n = 0; n < 2; ++n) acc[a][b][m][n] = (f32x4){0.f, 0.f, 0.f, 0.f};
        cur = nxt; cA = nA; cB = nB; ++ui;
        if (wr == 1) PG8_BAR;
    }
    PG8_WAIT_V(0);
    PG8_BAR;
#undef PG8_SA
#undef PG8_SB
#undef PG8_STAGE
#undef PG8_LDA
#undef PG8_LDB
#undef PG8_MMA
#undef PG8_WAIT_V
#undef PG8_WAIT_L
#undef PG8_BAR
#undef PG8_SCHED
}
}

struct GlaScoreSched {
    int G, c; const bf16_t* AP; const bf16_t* KT;
    __device__ __forceinline__ bool next(int i, pg8::Unit& u) const {
        const int idx = c + i * G; if (idx >= 256) return false;
        const int bh = idx >> 5, sc = idx & 31, b = bh >> 2, h = bh & 3; const size_t tok0 = (size_t)b * SEQ + sc * 256;
        u.pm = idx; u.pn = 0; u.A = (const char*)(AP + tok0 * 2048 + h * 512); u.B = (const char*)(KT + tok0 * 1024 + h * 256); return true;
    }
};
struct GlaScoreEpi {
    static constexpr bool PERM = true;
    bf16_t* AP;
    __device__ __forceinline__ void operator()(const f32x4 (&acc)[2][2][4][2], const pg8::Unit& u, int wr, int wc, int fr, int fq) const {
        const int lane = lane_asm(); fr = lane & 15; fq = lane >> 4; (void)lane;
        const int idx = u.pm, bh = idx >> 5, sc = idx & 31, b = bh >> 2, h = bh & 3; const size_t tok0 = (size_t)b * SEQ + sc * 256;
#pragma unroll
        for (int ai = 0; ai < 2; ++ai)
#pragma unroll
            for (int m = 0; m < 4; ++m) { const int r = ai * 128 + wr * 64 + m * 16 + fr; bf16_t* rowp = AP + (tok0 + r) * 2048 + h * 512 + 256;
#pragma unroll
                for (int bj = 0; bj < 2; ++bj) { const int c0 = bj * 128 + wc * 32 + 8 * fq; f32x4 v0 = acc[ai][bj][m][0], v1 = acc[ai][bj][m][1];
#pragma unroll
                    for (int j = 0; j < 4; ++j) { if (c0 + j > r) v0[j] = 0.f; if (c0 + 4 + j > r) v1[j] = 0.f; }
                    u32x4 w; w.x = cvt_pk_bf16(v0[0], v0[1]); w.y = cvt_pk_bf16(v0[2], v0[3]); w.z = cvt_pk_bf16(v1[0], v1[1]); w.w = cvt_pk_bf16(v1[2], v1[3]);
                    *(u32x4*)(rowp + c0) = w; } }
    }
};
struct GlaUSched {
    int G, c; const bf16_t* BP; const bf16_t* KTT;
    __device__ __forceinline__ bool next(int i, pg8::Unit& u) const {
        const int idx = c + i * G; if (idx >= 512) return false;
        const int bhsc = idx >> 1, mt = idx & 1, bh = bhsc >> 5, sc = bhsc & 31;
        u.pm = idx; u.pn = 0; u.A = (const char*)(BP + ((size_t)bhsc * 512 + mt * 256) * 512 + 256); u.B = (const char*)(KTT + (size_t)bh * 256 * SEQ + sc * 256); return true;
    }
};
struct GlaUEpi {
    static constexpr bool PERM = false;
    float* UT; const float* DL;
    __device__ __forceinline__ void operator()(const f32x4 (&acc)[2][2][4][2], const pg8::Unit& u, int wr, int wc, int fr, int fq) const {
        const int lane = lane_asm(); fr = lane & 15; fq = lane >> 4; (void)lane;
        const int idx = u.pm, bhsc = idx >> 1, mt = idx & 1; const float* dl = DL + (size_t)bhsc * 256;
#pragma unroll
        for (int ai = 0; ai < 2; ++ai)
#pragma unroll
            for (int m = 0; m < 4; ++m) { const int r = mt * 256 + ai * 128 + wr * 64 + m * 16 + fr; float* rowp = UT + ((size_t)bhsc * 512 + r) * 256;
#pragma unroll
                for (int bj = 0; bj < 2; ++bj)
#pragma unroll
                    for (int n = 0; n < 2; ++n) { const int c0 = bj * 128 + wc * 32 + n * 16 + 4 * fq; *(f32x4*)(rowp + c0) = acc[ai][bj][m][n] * *(const f32x4*)(dl + c0); } }
    }
};
struct GlaOSched {
    int G, c; const bf16_t* AP; const bf16_t* BP;
    __device__ __forceinline__ bool next(int i, pg8::Unit& u) const {
        const int idx = c + i * G; if (idx >= 512) return false;
        const int bhsc = idx >> 1, nt = idx & 1, bh = bhsc >> 5, sc = bhsc & 31, b = bh >> 2, h = bh & 3; const size_t tok0 = (size_t)b * SEQ + sc * 256;
        u.pm = idx; u.pn = 0; u.A = (const char*)(AP + tok0 * 2048 + h * 512); u.B = (const char*)(BP + ((size_t)bhsc * 512 + nt * 256) * 512); return true;
    }
};
struct GlaOEpi {
    static constexpr bool PERM = true;
    bf16_t* O; float* SSQ;
    __device__ __forceinline__ void operator()(const f32x4 (&acc)[2][2][4][2], const pg8::Unit& u, int wr, int wc, int fr, int fq) const {
        const int lane = lane_asm(); fr = lane & 15; fq = lane >> 4; (void)lane;
        const int idx = u.pm, bhsc = idx >> 1, nt = idx & 1, bh = bhsc >> 5, sc = bhsc & 31, b = bh >> 2, h = bh & 3; const size_t tok0 = (size_t)b * SEQ + sc * 256;
#pragma unroll
        for (int ai = 0; ai < 2; ++ai)
#pragma unroll
            for (int m = 0; m < 4; ++m) { const int r = ai * 128 + wr * 64 + m * 16 + fr; bf16_t* rowp = O + (tok0 + r) * 2048 + h * 512 + nt * 256; float ss = 0.f;
#pragma unroll
                for (int bj = 0; bj < 2; ++bj) { const int c0 = bj * 128 + wc * 32 + 8 * fq; const f32x4 v0 = acc[ai][bj][m][0], v1 = acc[ai][bj][m][1];
                    ss += (v0[0] * v0[0] + v0[1] * v0[1]) + (v0[2] * v0[2] + v0[3] * v0[3]) + (v1[0] * v1[0] + v1[1] * v1[1]) + (v1[2] * v1[2] + v1[3] * v1[3]);
                    u32x4 w; w.x = cvt_pk_bf16(v0[0], v0[1]); w.y = cvt_pk_bf16(v0[2], v0[3]); w.z = cvt_pk_bf16(v1[0], v1[1]); w.w = cvt_pk_bf16(v1[2], v1[3]);
                    *(u32x4*)(rowp + c0) = w; }
                ss += shx(ss, 16, lane); ss += shx(ss, 32, lane);
                if (fq == 0) atomicAdd(SSQ + (tok0 + r) * 4 + h, ss); }
    }
};

struct Params {
    const float *x, *p, *gla_w_in, *gla_w_a1, *gla_w_a2, *gla_b_a, *gla_norm_g, *gla_w_o, *pool_w, *pool_scale, *dsa_w_in, *dsa_kidx_g, *dsa_kidx_b, *dsa_w_o,
        *ln_mix_g, *ln_mix_b, *ffn_w_up, *ffn_conv_w, *ffn_conv_b, *ffn_w_down, *ple_gate_w, *ple_proj_w, *ln_ffn_g, *ln_ffn_b;
    float* out; unsigned char* ws;
};

__device__ __forceinline__ void transpose_item(const float* W, int K, int N, bf16_t* WT, int row_off, LAS unsigned* scr, int item, int lane) {
    const int nblk = (N + 63) / 64, kb = item / nblk, nb = item % nblk, k0 = 64 * kb, n0 = 64 * nb;
    const int nn = (lane & 15) * 4; const bool nok = (n0 + nn) < N;
#pragma unroll
    for (int i = 0; i < 8; ++i) { const int kk = 8 * i + 2 * (lane >> 4);
        f32x4 v0 = {0.f, 0.f, 0.f, 0.f}, v1 = v0;
        if (nok) { v0 = *(const f32x4*)(W + (size_t)(k0 + kk) * N + n0 + nn); v1 = *(const f32x4*)(W + (size_t)(k0 + kk + 1) * N + n0 + nn); }
#pragma unroll
        for (int j = 0; j < 4; ++j) scr[((nn + j) * 72 + kk) >> 1] = cvt_pk_bf16(v0[j], v1[j]); }
    asm volatile("s_waitcnt lgkmcnt(0)" ::: "memory");
#pragma unroll
    for (int j = 0; j < 8; ++j) { const int n = (lane >> 3) + 8 * j, ch = lane & 7;
        const u32x4 o = *(const LAS u32x4*)(scr + ((n * 72 + ch * 8) >> 1));
        *(u32x4*)(WT + (size_t)(row_off + n0 + n) * K + k0 + 8 * ch) = o; }
    asm volatile("s_waitcnt lgkmcnt(0)" ::: "memory");
}
#define TJOB(W, K, N, DST, ROWOFF) do { const int _ni = ((K) / 64) * (((N) + 63) / 64); for (int _it = gw; _it < _ni; _it += NGW) transpose_item((W), (K), (N), (DST), (ROWOFF), scr, _it, lane); } while (0)

__device__ __forceinline__ void row_pass(const float* src, const float* __restrict__ g, const float* __restrict__ b, float* dst32, bf16_t* __restrict__ dstb, float* __restrict__ stats, int widk) {
    IDX_SETUP
    f32x4 vn[8];
    if (gw < T) { const f32x4* xr = (const f32x4*)(src + (size_t)gw * D) + lane;
#pragma unroll
        for (int j = 0; j < 8; ++j) vn[j] = xr[64 * j]; }
    for (int r = gw; r < T; r += NGW) {
        f32x4 v[8];
#pragma unroll
        for (int j = 0; j < 8; ++j) v[j] = vn[j];
        if (r + NGW < T) { const f32x4* xr = (const f32x4*)(src + (size_t)(r + NGW) * D) + lane;
#pragma unroll
            for (int j = 0; j < 8; ++j) vn[j] = xr[64 * j]; }
        if (g) {
            float s = 0.f;
#pragma unroll
            for (int j = 0; j < 8; ++j) s += (v[j].x + v[j].y) + (v[j].z + v[j].w);
            const float mean = wave_sum(s, lane) * (1.f / D); float s2 = 0.f;
#pragma unroll
            for (int j = 0; j < 8; ++j) { v[j] = v[j] - mean; s2 += (v[j].x * v[j].x + v[j].y * v[j].y) + (v[j].z * v[j].z + v[j].w * v[j].w); }
            const float rstd = 1.0f / sqrtf(wave_sum(s2, lane) * (1.f / D) + LN_EPS);
            if (stats && lane == 0) *(f32x2*)(stats + 2 * (size_t)r) = (f32x2){mean, rstd};
#pragma unroll
            for (int j = 0; j < 8; ++j) { const f32x4 gg = ((const f32x4*)g)[lane + 64 * j], bb = ((const f32x4*)b)[lane + 64 * j]; v[j] = v[j] * rstd * gg + bb; }
        }
        if (dst32) { f32x4* o = (f32x4*)(dst32 + (size_t)r * D) + lane;
#pragma unroll
            for (int j = 0; j < 8; ++j) o[64 * j] = v[j]; }
        if (dstb) { u32x2* o = (u32x2*)(dstb + (size_t)r * D) + lane;
#pragma unroll
            for (int j = 0; j < 8; ++j) { u32x2 w; w.x = cvt_pk_bf16(v[j].x, v[j].y); w.y = cvt_pk_bf16(v[j].z, v[j].w); o[64 * j] = w; } }
    }
}

__device__ __forceinline__ void xa_pass(const bf16_t* srcb, const float* wa1, float* xa, int widk) {
    IDX_SETUP
    for (int r0 = gw * 4; r0 < T; r0 += NGW * 4) {
        f32x4 acc[4][4];
#pragma unroll
        for (int rr = 0; rr < 4; ++rr)
#pragma unroll
            for (int qd = 0; qd < 4; ++qd) acc[rr][qd] = (f32x4){0.f, 0.f, 0.f, 0.f};
#pragma unroll 2
        for (int i = 0; i < 32; ++i) { const int cc = lane + 64 * i; const f32x4* w = (const f32x4*)(wa1 + (size_t)cc * 16);
            const f32x4 w0 = w[0], w1 = w[1], w2 = w[2], w3 = w[3];
#pragma unroll
            for (int rr = 0; rr < 4; ++rr) { const float xv = bf2f(srcb[(size_t)(r0 + rr) * D + cc]);
                acc[rr][0] += w0 * xv; acc[rr][1] += w1 * xv; acc[rr][2] += w2 * xv; acc[rr][3] += w3 * xv; } }
        const bool b5 = (lane & 32) != 0, b4 = (lane & 16) != 0, b3 = (lane & 8) != 0, b2 = (lane & 4) != 0;
        const int idx = (b5 ? 8 : 0) + (b4 ? 4 : 0) + (b3 ? 2 : 0) + (b2 ? 1 : 0);
#pragma unroll
        for (int rr = 0; rr < 4; ++rr) {
            float k8[8], k4[4], k2[2];
#pragma unroll
            for (int j = 0; j < 8; ++j) { const float lo = acc[rr][j >> 2][j & 3], hi = acc[rr][2 + (j >> 2)][j & 3]; k8[j] = (b5 ? hi : lo) + shx(b5 ? lo : hi, 32, lane); }
#pragma unroll
            for (int j = 0; j < 4; ++j) k4[j] = (b4 ? k8[j + 4] : k8[j]) + shx(b4 ? k8[j] : k8[j + 4], 16, lane);
#pragma unroll
            for (int j = 0; j < 2; ++j) k2[j] = (b3 ? k4[j + 2] : k4[j]) + shx(b3 ? k4[j] : k4[j + 2], 8, lane);
            float k1 = (b2 ? k2[1] : k2[0]) + shx(b2 ? k2[0] : k2[1], 4, lane);
            k1 += shx(k1, 2, lane); k1 += shx(k1, 1, lane);
            if ((lane & 3) == 0) xa[(size_t)(r0 + rr) * 16 + idx] = k1;
        }
    }
}
__device__ __forceinline__ void conv_pass(const bf16_t* __restrict__ H, const float* __restrict__ cw, const float* __restrict__ cb, bf16_t* __restrict__ ACT, int widk) {
    IDX_SETUP
    constexpr int NCG = DFF / 8, NSEG = T / 32;
    for (int idx = gt; idx < NCG * NSEG; idx += NT) {
        const int cgi = idx % NCG, sg = idx / NCG, t0 = sg * 32, c0 = cgi * 8;
        f32x4 wg[3][2], wu[3][2], bg[2], bu[2];
#pragma unroll
        for (int j = 0; j < 3; ++j)
#pragma unroll
            for (int q = 0; q < 2; ++q) { wg[j][q] = *(const f32x4*)(cw + (size_t)j * NUP + c0 + 4 * q); wu[j][q] = *(const f32x4*)(cw + (size_t)j * NUP + DFF + c0 + 4 * q); }
#pragma unroll
        for (int q = 0; q < 2; ++q) { bg[q] = *(const f32x4*)(cb + c0 + 4 * q); bu[q] = *(const f32x4*)(cb + DFF + c0 + 4 * q); }
        f32x4 g2[2], g1[2], u2[2], u1[2];
        if ((t0 & (SEQ - 1)) == 0) {
#pragma unroll
            for (int q = 0; q < 2; ++q) { g2[q] = (f32x4){0.f, 0.f, 0.f, 0.f}; g1[q] = g2[q]; u2[q] = g2[q]; u1[q] = g2[q]; }
        } else {
            const u32x4 a = *(const u32x4*)(H + (size_t)(t0 - 2) * NUP + c0), b = *(const u32x4*)(H + (size_t)(t0 - 1) * NUP + c0);
            const u32x4 c = *(const u32x4*)(H + (size_t)(t0 - 2) * NUP + DFF + c0), d = *(const u32x4*)(H + (size_t)(t0 - 1) * NUP + DFF + c0);
            g2[0] = (f32x4){lo16(a.x), hi16(a.x), lo16(a.y), hi16(a.y)}; g2[1] = (f32x4){lo16(a.z), hi16(a.z), lo16(a.w), hi16(a.w)};
            g1[0] = (f32x4){lo16(b.x), hi16(b.x), lo16(b.y), hi16(b.y)}; g1[1] = (f32x4){lo16(b.z), hi16(b.z), lo16(b.w), hi16(b.w)};
            u2[0] = (f32x4){lo16(c.x), hi16(c.x), lo16(c.y), hi16(c.y)}; u2[1] = (f32x4){lo16(c.z), hi16(c.z), lo16(c.w), hi16(c.w)};
            u1[0] = (f32x4){lo16(d.x), hi16(d.x), lo16(d.y), hi16(d.y)}; u1[1] = (f32x4){lo16(d.z), hi16(d.z), lo16(d.w), hi16(d.w)};
        }
#pragma unroll 4
        for (int t = 0; t < 32; ++t) {
            const u32x4 a = __builtin_nontemporal_load((const u32x4*)(H + (size_t)(t0 + t) * NUP + c0)), c = __builtin_nontemporal_load((const u32x4*)(H + (size_t)(t0 + t) * NUP + DFF + c0));
            f32x4 g0[2], u0[2];
            g0[0] = (f32x4){lo16(a.x), hi16(a.x), lo16(a.y), hi16(a.y)}; g0[1] = (f32x4){lo16(a.z), hi16(a.z), lo16(a.w), hi16(a.w)};
            u0[0] = (f32x4){lo16(c.x), hi16(c.x), lo16(c.y), hi16(c.y)}; u0[1] = (f32x4){lo16(c.z), hi16(c.z), lo16(c.w), hi16(c.w)};
            unsigned ow[4];
#pragma unroll
            for (int q = 0; q < 2; ++q) {
                const f32x4 hg = bg[q] + wg[0][q] * g2[q] + wg[1][q] * g1[q] + wg[2][q] * g0[q];
                const f32x4 hu = bu[q] + wu[0][q] * u2[q] + wu[1][q] * u1[q] + wu[2][q] * u0[q];
                const f32x2 ga = gelu_pk((f32x2){hg[0], hg[1]}), gb = gelu_pk((f32x2){hg[2], hg[3]});
                ow[2 * q] = cvt_pk_bf16(ga.x * hu[0], ga.y * hu[1]); ow[2 * q + 1] = cvt_pk_bf16(gb.x * hu[2], gb.y * hu[3]);
                g2[q] = g1[q]; g1[q] = g0[q]; u2[q] = u1[q]; u1[q] = u0[q];
            }
            *(u32x4*)(ACT + (size_t)(t0 + t) * DFF + c0) = (u32x4){ow[0], ow[1], ow[2], ow[3]};
        }
    }
}

__device__ __forceinline__ void ple_mul(bf16_t* SG, const bf16_t* PP, int widk) {
    IDX_SETUP
    for (int idx = gt; idx < T * (D / 8); idx += NT) {
        const u32x4 a = ((const u32x4*)SG)[idx], b = ((const u32x4*)PP)[idx];
        u32x4 w; w.x = cvt_pk_bf16(lo16(a.x) * lo16(b.x), hi16(a.x) * hi16(b.x)); w.y = cvt_pk_bf16(lo16(a.y) * lo16(b.y), hi16(a.y) * hi16(b.y));
        w.z = cvt_pk_bf16(lo16(a.z) * lo16(b.z), hi16(a.z) * hi16(b.z)); w.w = cvt_pk_bf16(lo16(a.w) * lo16(b.w), hi16(a.w) * hi16(b.w));
        ((u32x4*)SG)[idx] = w;
    }
}
__device__ __forceinline__ void gla_prep(const bf16_t* QKVR, const float* XA, const float* wa2, const float* ba, bf16_t* AP, bf16_t* KT, bf16_t* KTT, float* DL, LAS unsigned char* lds, int widk) {
    IDX_SETUP
    LAS float* tot = (LAS float*)lds;
    for (int it = c; it < 256; it += G) {
        const int h = it & 3, sc = (it >> 2) & 31, b = it >> 7, bh = b * 4 + h, col = h * 256 + 4 * lane;
        f32x4 w2[16];
#pragma unroll
        for (int j = 0; j < 16; ++j) w2[j] = *(const f32x4*)(wa2 + (size_t)j * 1024 + col);
        const f32x4 bav = *(const f32x4*)(ba + col);
        const size_t tokw = (size_t)b * SEQ + sc * 256 + wid * 32;
#define GLA_LA2(t, out) do { const f32x4* xa4 = (const f32x4*)(XA + (t) * 16); const f32x4 a0 = xa4[0], a1 = xa4[1], a2 = xa4[2], a3 = xa4[3]; \
            f32x4 z = bav + w2[0] * a0[0] + w2[1] * a0[1] + w2[2] * a0[2] + w2[3] * a0[3]; z += w2[4] * a1[0] + w2[5] * a1[1] + w2[6] * a1[2] + w2[7] * a1[3]; \
            z += w2[8] * a2[0] + w2[9] * a2[1] + w2[10] * a2[2] + w2[11] * a2[3]; z += w2[12] * a3[0] + w2[13] * a3[1] + w2[14] * a3[2] + w2[15] * a3[3]; \
            _Pragma("unroll") for (int _e = 0; _e < 4; ++_e) (out)[_e] = -0.0625f * __builtin_amdgcn_logf(1.0f + __builtin_amdgcn_exp2f(-z[_e] * 1.44269504f)); } while (0)
        f32x4 sum = {0.f, 0.f, 0.f, 0.f};
#pragma unroll 4
        for (int tt = 0; tt < 32; ++tt) { f32x4 la; GLA_LA2(tokw + tt, la); sum += la; }
        *(LAS f32x4*)(tot + wid * 256 + 4 * lane) = sum;
        __syncthreads();
        f32x4 bs = {0.f, 0.f, 0.f, 0.f}, ball = bs;
#pragma unroll
        for (int w = 0; w < 8; ++w) { const f32x4 tv = *(const LAS f32x4*)(tot + w * 256 + 4 * lane); if (w < wid) bs += tv; ball += tv; }
        for (int tt = 0; tt < 32; tt += 8) {
            unsigned pk[4][4];
#pragma unroll
            for (int e = 0; e < 8; e += 2) {
                f32x4 kt2[2];
#pragma unroll
                for (int e2 = 0; e2 < 2; ++e2) {
                    const size_t t = tokw + tt + e + e2;
                    f32x4 la; GLA_LA2(t, la); bs += la;
                    const u32x2 qw = *(const u32x2*)(QKVR + t * GLA_N + col), kw = *(const u32x2*)(QKVR + t * GLA_N + 1024 + col);
                    const f32x4 qv = {lo16(qw.x), hi16(qw.x), lo16(qw.y), hi16(qw.y)}, kv = {lo16(kw.x), hi16(kw.x), lo16(kw.y), hi16(kw.y)};
                    f32x4 qt, kt;
#pragma unroll
                    for (int j = 0; j < 4; ++j) { qt[j] = qv[j] * 0.0625f * __builtin_amdgcn_exp2f(bs[j]); kt[j] = kv[j] * __builtin_amdgcn_exp2f(fminf(-bs[j], 120.f)); }
                    u32x2 qo, ko; qo.x = cvt_pk_bf16(qt[0], qt[1]); qo.y = cvt_pk_bf16(qt[2], qt[3]); ko.x = cvt_pk_bf16(kt[0], kt[1]); ko.y = cvt_pk_bf16(kt[2], kt[3]);
                    *(u32x2*)(AP + t * 2048 + h * 512 + 4 * lane) = qo;
                    *(u32x2*)(KT + t * 1024 + col) = ko;
                    kt2[e2] = kt;
                }
#pragma unroll
                for (int j = 0; j < 4; ++j) pk[j][e >> 1] = cvt_pk_bf16(kt2[0][j], kt2[1][j]);
            }
#pragma unroll
            for (int j = 0; j < 4; ++j)
                *(u32x4*)(KTT + ((size_t)(bh * 256 + 4 * lane + j) * SEQ + sc * 256 + wid * 32 + tt)) = (u32x4){pk[j][0], pk[j][1], pk[j][2], pk[j][3]};
        }
        if (wid == 0) { f32x4 dl;
#pragma unroll
            for (int j = 0; j < 4; ++j) dl[j] = __builtin_amdgcn_exp2f(ball[j]);
            *(f32x4*)(DL + (size_t)(bh * 32 + sc) * 256 + 4 * lane) = dl; }
#undef GLA_LA2
        __syncthreads();
    }
}
__device__ __forceinline__ void gla_vt(const bf16_t* __restrict__ QKVR, bf16_t* __restrict__ BP, LAS unsigned char* lds, int widk) {
    IDX_SETUP
    LAS bf16_t* scr = (LAS bf16_t*)(lds + wid * 9216);
    for (int it = gw; it < 256 * 32; it += NGW) {
        const int tt = it >> 5, vt = it & 31;
        const size_t tokb = (size_t)tt * 64; const int vcol = vt * 64, h = vcol >> 9, vv0 = vcol & 511;
        const int b = (int)(tokb >> 13), tl = (int)(tokb & (SEQ - 1)), sc = tl >> 8, tloc0 = tl & 255, bhsc = (b * 4 + h) * 32 + sc;
#pragma unroll
        for (int i = 0; i < 8; ++i) { const int row = (lane >> 3) + 8 * i, ch = lane & 7;
            const u32x4 w = *(const u32x4*)(QKVR + (tokb + row) * GLA_N + 2048 + vcol + ch * 8);
            *(LAS u32x4*)(scr + row * 72 + ch * 8) = w; }
        asm volatile("s_waitcnt lgkmcnt(0)" ::: "memory");
#pragma unroll
        for (int cch = 0; cch < 8; ++cch) {
            unsigned short e[8];
#pragma unroll
            for (int j = 0; j < 8; ++j) e[j] = scr[(cch * 8 + j) * 72 + lane];
            u32x4 w; w.x = e[0] | ((unsigned)e[1] << 16); w.y = e[2] | ((unsigned)e[3] << 16); w.z = e[4] | ((unsigned)e[5] << 16); w.w = e[6] | ((unsigned)e[7] << 16);
            *(u32x4*)(BP + ((size_t)bhsc * 512 + vv0 + lane) * 512 + 256 + tloc0 + cch * 8) = w;
        }
        asm volatile("s_waitcnt lgkmcnt(0)" ::: "memory");
    }
}
__device__ __forceinline__ void gla_scan(const float* __restrict__ UT, const float* __restrict__ DL, bf16_t* __restrict__ BP, int widk) {
    IDX_SETUP
    for (int idx = gt; idx < 8 * 512 * 64; idx += NT) {
        const int k4 = idx & 63, v = (idx >> 6) & 511, bh = idx >> 15;
        f32x4 S = {0.f, 0.f, 0.f, 0.f};
#pragma unroll 4
        for (int sc = 0; sc < 32; ++sc) {
            const size_t bhsc = (size_t)bh * 32 + sc;
            u32x2 w; w.x = cvt_pk_bf16(S[0], S[1]); w.y = cvt_pk_bf16(S[2], S[3]);
            *(u32x2*)(BP + (bhsc * 512 + v) * 512 + k4 * 4) = w;
            const f32x4 dl = *(const f32x4*)(DL + bhsc * 256 + k4 * 4), uu = *(const f32x4*)(UT + (bhsc * 512 + v) * 256 + k4 * 4);
            S = dl * S + uu;
        }
    }
}
__device__ __forceinline__ void gla_gate(bf16_t* O, const float* SSQ, const bf16_t* QKVR, const float* ng, int widk) {
    IDX_SETUP
    for (int idx = gt; idx < T * (D / 8); idx += NT) {
        const int t = idx >> 8, c0 = (idx & 255) * 8, h = c0 >> 9;
        const float rs = 1.0f / sqrtf(SSQ[(size_t)t * 4 + h] * (1.f / 512.f) + LN_EPS);
        const u32x4 ov = *(const u32x4*)(O + (size_t)t * D + c0), rv = *(const u32x4*)(QKVR + (size_t)t * GLA_N + 4096 + c0);
        const f32x4 g0 = *(const f32x4*)(ng + c0), g1 = *(const f32x4*)(ng + c0 + 4);
        float o[8] = {lo16(ov.x), hi16(ov.x), lo16(ov.y), hi16(ov.y), lo16(ov.z), hi16(ov.z), lo16(ov.w), hi16(ov.w)};
        float r[8] = {lo16(rv.x), hi16(rv.x), lo16(rv.y), hi16(rv.y), lo16(rv.z), hi16(rv.z), lo16(rv.w), hi16(rv.w)};
        float gg[8] = {g0[0], g0[1], g0[2], g0[3], g1[0], g1[1], g1[2], g1[3]};
        float y[8];
#pragma unroll
        for (int j = 0; j < 8; ++j) { const float on = bf2f((unsigned short)f2bf(o[j] * rs * gg[j])); y[j] = on * (r[j] * sigmoidf_(r[j])); }
        *(u32x4*)(O + (size_t)t * D + c0) = (u32x4){cvt_pk_bf16(y[0], y[1]), cvt_pk_bf16(y[2], y[3]), cvt_pk_bf16(y[4], y[5]), cvt_pk_bf16(y[6], y[7])};
    }
}

__device__ __forceinline__ f32x4 ldbf4(const bf16_t* p) { const u32x2 w = *(const u32x2*)p; return (f32x4){lo16(w.x), hi16(w.x), lo16(w.y), hi16(w.y)}; }
__device__ __forceinline__ void pool_pass(const bf16_t* __restrict__ X, bf16_t* __restrict__ PO, int widk) {
    IDX_SETUP
    for (int idx = gt; idx < 512 * 512; idx += NT) {
        const int cg4 = idx & 511, sg = idx >> 9, c0 = cg4 * 4, w = 2 << (c0 >> 9);
        const int t0 = sg * 32, tb = t0 & (SEQ - 1);
        f32x4 sum = {0.f, 0.f, 0.f, 0.f};
        for (int j = 1; j < w; ++j) if (tb - j >= 0) sum += ldbf4(X + (size_t)(t0 - j) * D + c0);
#pragma unroll 4
        for (int t = 0; t < 32; ++t) {
            const f32x4 xv = ldbf4(X + (size_t)(t0 + t) * D + c0);
            sum += xv;
            const int tp = tb + t; const float inv = 1.0f / (float)((tp + 1) < w ? (tp + 1) : w);
            const f32x4 y = sum * inv - xv;
            u32x2 o; o.x = cvt_pk_bf16(y[0], y[1]); o.y = cvt_pk_bf16(y[2], y[3]);
            *(u32x2*)(PO + (size_t)(t0 + t) * D + c0) = o;
            if (tp - w + 1 >= 0) sum -= ldbf4(X + (size_t)(t0 + t - w + 1) * D + c0);
        }
    }
}

__device__ __forceinline__ void dsa_kin(const bf16_t* DP, const float* g, const float* b, bf16_t* KIN, int widk) {
    IDX_SETUP
    const float gg = g[lane], bb = b[lane];
    for (int r = gw; r < T; r += NGW) {
        const float v = bf2f(DP[(size_t)r * DSA_NP + 4096 + lane]);
        const float mean = wave_sum(v, lane) * (1.f / 64.f), d = v - mean, var = wave_sum(d * d, lane) * (1.f / 64.f);
        KIN[(size_t)r * 64 + lane] = (bf16_t)f2bf(d * (1.0f / sqrtf(var + LN_EPS)) * gg + bb);
    }
}
__device__ __forceinline__ unsigned f2key(float f) { const unsigned u = __float_as_uint(f); return (u & 0x80000000u) ? ~u : (u | 0x80000000u); }
__device__ __forceinline__ void topk_find_digit(const LAS unsigned* hist, int kk, int lane, int& dg, int& nk) {
    const u32x4 h4 = *(const LAS u32x4*)(hist + 4 * lane);
    const int cc = (int)(h4.x + h4.y + h4.z + h4.w);
    int suf = cc;
#pragma unroll
    for (int o = 1; o < 64; o <<= 1) { const int tv = shi(suf, (lane + o) & 63); if (lane + o < 64) suf += tv; }
    const unsigned long long bal = __ballot(suf >= kk);
    const int Lh = bal ? 63 - __builtin_clzll(bal) : 0;
    int above = suf - cc, d, k2;
    if (above + (int)h4.w >= kk) { d = 3; k2 = kk - above; }
    else { above += (int)h4.w;
        if (above + (int)h4.z >= kk) { d = 2; k2 = kk - above; }
        else { above += (int)h4.z;
            if (above + (int)h4.y >= kk) { d = 1; k2 = kk - above; }
            else { above += (int)h4.y; d = 0; k2 = kk - above; } } }
    dg = __builtin_amdgcn_readlane(4 * lane + d, Lh); nk = __builtin_amdgcn_readlane(k2, Lh);
}
__device__ __forceinline__ void dsa_topk(const bf16_t* DP, const bf16_t* KIN, int* SEL, LAS unsigned char* lds, int widk) {
    IDX_SETUP
    LAS float* scs = (LAS float*)lds;
    LAS unsigned* hist = (LAS unsigned*)(lds + 131072);
    LAS unsigned* misc = (LAS unsigned*)(lds + 131072 + 4096);
    LAS float* mmf = (LAS float*)(lds + 131072 + 4096 + 128);
    LAS unsigned* cand = (LAS unsigned*)(lds + 131072 + 4096 + 384);
    const int fr = lane & 15, fq = lane >> 4;
    for (int rr = c; rr < T / 4; rr += G) {
        const int b = rr >> 11; int blk = rr & 2047; { const int cblk = blk & 255, kb = blk >> 8; blk = (kb < 4) ? (cblk + 256 * kb) : (2047 - (cblk + 256 * (kb - 4))); }
        const int tq0 = blk * 4, n = tq0 + 4;
        const size_t tokq = (size_t)b * SEQ + tq0;
        bf16x8 Af[4][2]; float wv[4][4];
#pragma unroll
        for (int q = 0; q < 4; ++q) {
#pragma unroll
            for (int ks = 0; ks < 2; ++ks) Af[q][ks] = *(const bf16x8*)(DP + (tokq + q) * DSA_NP + 3072 + fr * 64 + ks * 32 + fq * 8);
            const u32x2 ww = *(const u32x2*)(DP + (tokq + q) * DSA_NP + 4160 + 4 * fq);
            wv[q][0] = lo16(ww.x) * 0.03125f; wv[q][1] = hi16(ww.x) * 0.03125f; wv[q][2] = lo16(ww.y) * 0.03125f; wv[q][3] = hi16(ww.y) * 0.03125f;
        }
        const int ntile = (n + 15) >> 4;
        {
            bf16x8 Bf[4][2], Bn[4][2];
#define TOPK_LOAD(dst, jbase) do { _Pragma("unroll") for (int u = 0; u < 4; ++u) { int j = (jbase) + 8 * u; j = j < 512 ? j : 511; \
                const bf16_t* kp = KIN + ((size_t)b * SEQ + j * 16 + fr) * 64 + fq * 8; dst[u][0] = *(const bf16x8*)kp; dst[u][1] = *(const bf16x8*)(kp + 32); } } while (0)
            TOPK_LOAD(Bf, wid);
            float rmn = __builtin_inff(), rmx = -__builtin_inff();
            for (int j4 = wid; j4 < ntile; j4 += 32) {
                TOPK_LOAD(Bn, j4 + 32);
#pragma unroll
                for (int u = 0; u < 4; ++u) {
                    const int j = j4 + 8 * u;
                    if (j < ntile) {
                        float myval = 0.f;
#pragma unroll
                        for (int q = 0; q < 4; ++q) {
                            f32x4 a = {0.f, 0.f, 0.f, 0.f};
                            a = __builtin_amdgcn_mfma_f32_16x16x32_bf16(Af[q][0], Bf[u][0], a, 0, 0, 0);
                            a = __builtin_amdgcn_mfma_f32_16x16x32_bf16(Af[q][1], Bf[u][1], a, 0, 0, 0);
                            float val = wv[q][0] * fmaxf(a[0], 0.f) + wv[q][1] * fmaxf(a[1], 0.f) + wv[q][2] * fmaxf(a[2], 0.f) + wv[q][3] * fmaxf(a[3], 0.f);
                            val += shx(val, 16, lane); val += shx(val, 32, lane);
                            if (fq == q) myval = val;
                        }
                        const int s = j * 16 + fr;
                        if (s > tq0 + fq) myval = -__builtin_inff(); else { rmn = fminf(rmn, myval); rmx = fmaxf(rmx, myval); }
                        scs[fq * 8192 + s] = myval;
                    }
                }
#pragma unroll
                for (int u = 0; u < 4; ++u) { Bf[u][0] = Bn[u][0]; Bf[u][1] = Bn[u][1]; }
            }
#undef TOPK_LOAD
#pragma unroll
            for (int o = 1; o < 16; o <<= 1) { rmn = fminf(rmn, shx(rmn, o, lane)); rmx = fmaxf(rmx, shx(rmx, o, lane)); }
            if (fr == 0) { mmf[wid * 8 + fq * 2] = rmn; mmf[wid * 8 + fq * 2 + 1] = rmx; }
            for (int i = tid; i < 1024; i += 512) hist[i] = 0u;
            if (tid < 32) misc[tid] = 0u;
        }
        __syncthreads();
        const int q = wid >> 1, sub = tid & 127, nq = tq0 + q + 1;
        int* selrow = SEL + (tokq + q) * 256;
        LAS float* row = scs + q * 8192;
        if (n <= 256) {
            for (int i = sub; i < 256; i += 128) selrow[i] = (i < nq) ? i : -1;
        } else {
            float mn = mmf[q * 2], mx = mmf[q * 2 + 1];
#pragma unroll
            for (int w = 1; w < 8; ++w) { mn = fminf(mn, mmf[w * 8 + q * 2]); mx = fmaxf(mx, mmf[w * 8 + q * 2 + 1]); }
            const float scale = (mx > mn) ? 255.0f / (mx - mn) : 0.f;
#define DSA_BIN(v) ({ int _b = (int)(((v) - mn) * scale); _b = _b < 0 ? 0 : _b; _b > 255 ? 255 : _b; })
            for (int sb = 0; sb < nq; sb += 512) { const int s4 = sb + 4 * sub;
                if (s4 < nq) { const f32x4 v4 = *(const LAS f32x4*)(row + s4);
#pragma unroll
                    for (int e = 0; e < 4; ++e) if (s4 + e < nq) __hip_atomic_fetch_add(hist + q * 256 + DSA_BIN(v4[e]), 1u, __ATOMIC_RELAXED, __HIP_MEMORY_SCOPE_WORKGROUP); } }
            __syncthreads();
            int bA, kkA; topk_find_digit(hist + q * 256, 256, lane, bA, kkA);
            LAS unsigned* lst = cand + q * 512;
            for (int sb = 0; sb < nq; sb += 512) { const int s4 = sb + 4 * sub; const bool in4 = s4 < nq;
                f32x4 v4 = {0.f, 0.f, 0.f, 0.f}; if (in4) v4 = *(const LAS f32x4*)(row + s4);
#pragma unroll
                for (int e = 0; e < 4; ++e) { const int s = s4 + e; const bool in = s < nq; const float v = v4[e]; const int bin = DSA_BIN(v);
                    const bool gsel = in && bin > bA;
                    const unsigned long long gm = __ballot(gsel);
                    if (gm) { const int leader = __builtin_ctzll(gm); unsigned base = 0u;
                        if (lane == leader) base = __hip_atomic_fetch_add(misc + q * 4 + 2, (unsigned)__builtin_popcountll(gm), __ATOMIC_RELAXED, __HIP_MEMORY_SCOPE_WORKGROUP);
                        base = (unsigned)__builtin_amdgcn_readlane((int)base, leader);
                        const unsigned pos = base + (unsigned)__builtin_popcountll(gm & ((1ull << lane) - 1ull));
                        if (gsel && pos < 256u) selrow[pos] = s; }
                    if (in && bin == bA) { const unsigned cp = __hip_atomic_fetch_add(misc + q * 4 + 3, 1u, __ATOMIC_RELAXED, __HIP_MEMORY_SCOPE_WORKGROUP); if (cp < 256u) { lst[2 * cp] = f2key(v); lst[2 * cp + 1] = (unsigned)s; } } }
            }
            __syncthreads();
            const int nc = (int)misc[q * 4 + 3];
            if (nc <= 256) {
                for (int i = sub; i < nc; i += 128) { const unsigned ki = lst[2 * i], si = lst[2 * i + 1]; int rank = 0;
                    for (int j = 0; j < nc; ++j) { const unsigned kj = lst[2 * j], sj = lst[2 * j + 1]; rank += (kj > ki || (kj == ki && sj < si)) ? 1 : 0; }
                    if (rank < kkA) selrow[256 - kkA + rank] = (int)si; }
            } else if ((wid & 1) == 0) {
                unsigned prefix = 0u, maskb = 0u; int kk = kkA;
#pragma unroll 1
                for (int pass = 0; pass < 4; ++pass) { const int shift = 24 - 8 * pass;
                    for (int i = lane; i < 256; i += 64) hist[q * 256 + i] = 0u;
                    asm volatile("s_waitcnt lgkmcnt(0)" ::: "memory");
                    for (int s = lane; s < nq; s += 64) { const float v = row[s]; if (DSA_BIN(v) == bA) { const unsigned key = f2key(v); if ((key & maskb) == prefix) __hip_atomic_fetch_add(hist + q * 256 + ((key >> shift) & 255u), 1u, __ATOMIC_RELAXED, __HIP_MEMORY_SCOPE_WORKGROUP); } }
                    asm volatile("s_waitcnt lgkmcnt(0)" ::: "memory");
                    int dg, nk; topk_find_digit(hist + q * 256, kk, lane, dg, nk); kk = nk;
                    prefix |= (unsigned)dg << shift; maskb |= 255u << shift; }
                int baseG = 256 - kkA, baseE = 256 - kk; const int endE = 256;
                for (int sb = 0; sb < nq; sb += 64) { const int s = sb + lane; const bool in = s < nq; const float v = in ? row[s] : 0.f; const bool inb = in && DSA_BIN(v) == bA; const unsigned key = f2key(v);
                    const bool g = inb && key > prefix, e = inb && key == prefix;
                    const unsigned long long gm = __ballot(g), em = __ballot(e), lt = (1ull << lane) - 1ull;
                    if (g) { const int pos = baseG + __builtin_popcountll(gm & lt); if (pos < 256) selrow[pos] = s; }
                    if (e) { const int pos = baseE + __builtin_popcountll(em & lt); if (pos < endE) selrow[pos] = s; }
                    baseG += __builtin_popcountll(gm); baseE += __builtin_popcountll(em); }
            }
#undef DSA_BIN
        }
        __syncthreads();
    }
}
__device__ __forceinline__ void dsa_attn(const bf16_t* DP, const int* SEL, bf16_t* O, LAS unsigned char* lds, int widk) {
    IDX_SETUP
    LAS unsigned char* pl = lds + wid * 10240;
    LAS unsigned char* vt = lds + wid * 10240 + 2048;
    const int fr = lane & 15, fq = lane >> 4;
    unsigned tra[8][2];
#pragma unroll
    for (int cb = 0; cb < 8; ++cb)
#pragma unroll
        for (int t = 0; t < 2; ++t) { const unsigned q_ = (unsigned)(fr >> 2), p_ = (unsigned)(fr & 3), row = 8u * (unsigned)fq + 4u * (unsigned)t + q_, ch = 2u * (unsigned)cb + (p_ >> 1);
            tra[cb][t] = (unsigned)(size_t)vt + 256u * row + 16u * (ch ^ (((row & 3u) << 2) | ((row >> 2) & 3u))) + 8u * (p_ & 1u); }
    for (int m = 0;; ++m) {
#ifdef ATTN_BLOCKED_XCD
        const int kk_ = wid + 8 * m; if (kk_ >= 256 || G != 256) { if (G == 256) break; }
        const int pair = c >> 5, t = (c & 31) + 32 * kk_, b = pair >> 2, g = pair & 3;
#else
        const int jdx = c + G * (wid + 8 * m); if (jdx >= T * 4) break;
        const int pair = jdx & 7, t = jdx >> 3, b = pair >> 2, g = pair & 3;
#endif
        const size_t tok = (size_t)b * SEQ + t; const int nvalid = (t + 1) < 256 ? (t + 1) : 256;
        int s0 = SEL[tok * 256 + lane], s1 = SEL[tok * 256 + 64 + lane], s2 = SEL[tok * 256 + 128 + lane], s3 = SEL[tok * 256 + 192 + lane];
        s0 = s0 < 0 ? 0 : s0; s1 = s1 < 0 ? 0 : s1; s2 = s2 < 0 ? 0 : s2; s3 = s3 < 0 ? 0 : s3;
        bf16x8 qf[4];
#pragma unroll
        for (int ks = 0; ks < 4; ++ks) { qf[ks] = (bf16x8){0, 0, 0, 0, 0, 0, 0, 0}; if (fr < 4) qf[ks] = *(const bf16x8*)(DP + tok * DSA_NP + (g * 4 + fr) * 128 + ks * 32 + fq * 8); }
        const bf16_t* kbase = DP + (size_t)b * SEQ * DSA_NP + 2048 + g * 128 + fq * 8;
        f32x4 acc[16];
#pragma unroll
        for (int j = 0; j < 16; ++j) {
            const int sreg = (j < 4) ? s0 : (j < 8) ? s1 : (j < 12) ? s2 : s3;
            const int idx = shi(sreg, (16 * j + fr) & 63);
            const bf16_t* kr = kbase + (size_t)idx * DSA_NP;
            const bf16x8 a0 = *(const bf16x8*)kr, a1 = *(const bf16x8*)(kr + 32), a2 = *(const bf16x8*)(kr + 64), a3 = *(const bf16x8*)(kr + 96);
            f32x4 a = {0.f, 0.f, 0.f, 0.f};
            a = __builtin_amdgcn_mfma_f32_16x16x32_bf16(a0, qf[0], a, 0, 0, 0);
            a = __builtin_amdgcn_mfma_f32_16x16x32_bf16(a1, qf[1], a, 0, 0, 0);
            a = __builtin_amdgcn_mfma_f32_16x16x32_bf16(a2, qf[2], a, 0, 0, 0);
            a = __builtin_amdgcn_mfma_f32_16x16x32_bf16(a3, qf[3], a, 0, 0, 0);
            acc[j] = a;
            if ((j & 7) == 7) asm volatile("" ::: "memory");
        }
        const bf16_t* vbase = DP + (size_t)b * SEQ * DSA_NP + 2560 + g * 128 + fr * 8;
        u32x4 vcur[8], vnxt[8], vnn[8];
#define ATTN_VLOAD(dst, ks) do { const int sreg_ = ((ks) < 2) ? s0 : ((ks) < 4) ? s1 : ((ks) < 6) ? s2 : s3; _Pragma("unroll") for (int i = 0; i < 8; ++i) { \
            const int idx_ = shi(sreg_, 32 * ((ks) & 1) + fq + 4 * i); dst[i] = *(const u32x4*)(vbase + (size_t)idx_ * DSA_NP); } } while (0)
        ATTN_VLOAD(vcur, 0); ATTN_VLOAD(vnxt, 1);
        float mx = -__builtin_inff();
#pragma unroll
        for (int j = 0; j < 16; ++j)
#pragma unroll
            for (int r = 0; r < 4; ++r) { const int slot = 16 * j + 4 * fq + r; const float sv = (slot < nvalid) ? acc[j][r] * 0.08838834764831845f : -__builtin_inff(); acc[j][r] = sv; mx = fmaxf(mx, sv); }
        mx = fmaxf(mx, shx(mx, 16, lane)); mx = fmaxf(mx, shx(mx, 32, lane));
        float sum = 0.f;
#pragma unroll
        for (int j = 0; j < 16; ++j)
#pragma unroll
            for (int r = 0; r < 4; ++r) { const float pv = __expf(acc[j][r] - mx); acc[j][r] = pv; sum += pv; }
        sum += shx(sum, 16, lane); sum += shx(sum, 32, lane);
        const float inv = 1.0f / sum;
        if (fr < 4) {
#pragma unroll
            for (int j = 0; j < 16; ++j) { u32x2 w; w.x = cvt_pk_bf16(acc[j][0] * inv, acc[j][1] * inv); w.y = cvt_pk_bf16(acc[j][2] * inv, acc[j][3] * inv);
                *(LAS u32x2*)(pl + (fr * 256 + 16 * j + 4 * fq) * 2) = w; }
        }
        f32x4 oc[8];
#pragma unroll
        for (int cb = 0; cb < 8; ++cb) oc[cb] = (f32x4){0.f, 0.f, 0.f, 0.f};
#pragma unroll
        for (int ks = 0; ks < 8; ++ks) {
            if (ks < 6) ATTN_VLOAD(vnn, ks + 2);
#pragma unroll
            for (int i = 0; i < 8; ++i) { const unsigned row = (unsigned)(fq + 4 * i), ch = (unsigned)fr;
                *(LAS u32x4*)(vt + 256u * row + 16u * (ch ^ (((row & 3u) << 2) | ((row >> 2) & 3u)))) = vcur[i]; }
            bf16x8 pa = (bf16x8){0, 0, 0, 0, 0, 0, 0, 0};
            asm volatile("s_waitcnt lgkmcnt(0)" ::: "memory");
            if (fr < 4) pa = *(const LAS bf16x8*)(pl + (fr * 256 + 32 * ks + 8 * fq) * 2);
            u32x2 t0[8], t1[8];
#pragma unroll
            for (int cb = 0; cb < 8; ++cb) {
                asm volatile("ds_read_b64_tr_b16 %0, %1" : "=v"(t0[cb]) : "v"(tra[cb][0]) : "memory");
                asm volatile("ds_read_b64_tr_b16 %0, %1" : "=v"(t1[cb]) : "v"(tra[cb][1]) : "memory");
            }
            asm volatile("s_waitcnt lgkmcnt(0)" : "+v"(t0[0]), "+v"(t0[1]), "+v"(t0[2]), "+v"(t0[3]), "+v"(t0[4]), "+v"(t0[5]), "+v"(t0[6]), "+v"(t0[7]),
                                                  "+v"(t1[0]), "+v"(t1[1]), "+v"(t1[2]), "+v"(t1[3]), "+v"(t1[4]), "+v"(t1[5]), "+v"(t1[6]), "+v"(t1[7]), "+v"(pa) :: "memory");
#pragma unroll
            for (int cb = 0; cb < 8; ++cb) { const u32x4 bw = {t0[cb].x, t0[cb].y, t1[cb].x, t1[cb].y};
                oc[cb] = __builtin_amdgcn_mfma_f32_16x16x32_bf16(pa, __builtin_bit_cast(bf16x8, bw), oc[cb], 0, 0, 0); }
#pragma unroll
            for (int i = 0; i < 8; ++i) { vcur[i] = vnxt[i]; vnxt[i] = vnn[i]; }
        }
#undef ATTN_VLOAD
        if (fq == 0) {
            bf16_t* op = O + tok * D + (g * 4) * 128 + fr;
#pragma unroll
            for (int cb = 0; cb < 8; ++cb)
#pragma unroll
                for (int r = 0; r < 4; ++r) op[r * 128 + 16 * cb] = (bf16_t)f2bf(oc[cb][r]);
        }
        asm volatile("s_waitcnt lgkmcnt(0)" ::: "memory");
    }
}


#define XB_TMO      128
#define XB_XCNT(j)  (256  + 64 * (j))
#define XB_XSUB(j)  (1280 + 64 * (j))
#define XB_XGEN(j)  (2304 + 64 * (j))
#define XB_TOP      3328
#define XB_TOPGEN   3392
#define XB_SPIN_CAP (1u << 22)
__device__ __forceinline__ unsigned xb_ld(unsigned* p)              { return __hip_atomic_load(p, __ATOMIC_RELAXED, __HIP_MEMORY_SCOPE_AGENT); }
__device__ __forceinline__ unsigned xb_add(unsigned* p, unsigned v) { return __hip_atomic_fetch_add(p, v, __ATOMIC_RELAXED, __HIP_MEMORY_SCOPE_AGENT); }
__device__ __forceinline__ unsigned xb_xcc_id() { return (unsigned)__builtin_amdgcn_s_getreg((3 << 11) | 20) & 0xFu; }
#define XB_SPIN(cond, bar) do { unsigned _sp = 0; while (cond) { __builtin_amdgcn_s_sleep(1); \
    if ((++_sp & 255u) == 0u) { if (xb_ld(&(bar)[XB_TMO])) break; if (_sp > XB_SPIN_CAP) { atomicAdd(&(bar)[XB_TMO], 1u); break; } } } } while (0)
__device__ __forceinline__ void xcd_barrier_complete(unsigned* bar, unsigned x, unsigned& nloc, unsigned& nx) {
    const unsigned G = gridDim.x;
    unsigned sum, cnt, mine, sp = 0u;
    for (;;) {
        sum = 0u; cnt = 0u; mine = 0u;
#pragma unroll
        for (unsigned j = 0; j < 16; ++j) { const unsigned cc = xb_ld(&bar[XB_XCNT(j)]); sum += cc; cnt += (cc > 0u) ? 1u : 0u; mine = (j == x) ? cc : mine; }
        if (sum == G) break;
        __builtin_amdgcn_s_sleep(1);
        if ((++sp & 255u) == 0u) { if (xb_ld(&bar[XB_TMO])) break; if (sp > XB_SPIN_CAP) { atomicAdd(&bar[XB_TMO], 1u); break; } }
    }
    nloc = mine > 0u ? mine : 1u; nx = cnt > 0u ? cnt : 1u;
}
__device__ __forceinline__ void xcd_barrier(unsigned* bar, volatile LAS unsigned* st, int widk) {
    asm volatile("s_waitcnt vmcnt(0)" ::: "memory");
    __syncthreads();
    if (opaque_tid(widk) == 0) {
        __builtin_amdgcn_s_waitcnt(0);
        const unsigned x = xb_xcc_id();
        unsigned nloc = st[0], nx = st[1];
        if (nloc == 0u) { xcd_barrier_complete(bar, x, nloc, nx); st[0] = nloc; st[1] = nx; }
        const unsigned old = xb_add(&bar[XB_XSUB(x)], 1u);
        const unsigned gen = old / nloc;
        if (old + 1u == (gen + 1u) * nloc) {
            __builtin_amdgcn_fence(__ATOMIC_RELEASE, "agent");
            asm volatile("s_waitcnt vmcnt(0)" ::: "memory");
            const unsigned og = xb_add(&bar[XB_TOP], 1u);
            const unsigned tg = og / nx;
            if (og + 1u == (tg + 1u) * nx) xb_add(&bar[XB_TOPGEN], 1u);
            else XB_SPIN(xb_ld(&bar[XB_TOPGEN]) == tg, bar);
            __builtin_amdgcn_fence(__ATOMIC_ACQUIRE, "agent");
            xb_add(&bar[XB_XGEN(x)], 1u);
            asm volatile("s_waitcnt vmcnt(0)" ::: "memory");
        } else {
            XB_SPIN(xb_ld(&bar[XB_XGEN(x)]) == gen, bar);
            __builtin_amdgcn_fence(__ATOMIC_ACQUIRE, "agent");
            asm volatile("s_waitcnt vmcnt(0)" ::: "memory");
        }
    }
    __syncthreads();
}
#ifndef EN_MASK
#define EN_MASK 0xFFFFFF
#endif
#define EN(b) ((EN_MASK >> (b)) & 1)
#ifndef REP_MASK
#define REP_MASK 0
#endif
#define REPN(b) (1 + ((REP_MASK >> (b)) & 1))
__device__ __forceinline__ const void* ldp(LAS unsigned char* lds, int i) {
    const LAS unsigned* q = (const LAS unsigned*)(lds + 143360) + 2 * i;
    const unsigned lo = __builtin_amdgcn_readfirstlane(q[0]), hi = __builtin_amdgcn_readfirstlane(q[1]);
    return (const void*)(((unsigned long long)hi << 32) | lo);
}
#ifdef CGSYNC
#define GSYNC() grid.sync()
#else
#define GSYNC() do { for (int _r = 0; _r < REPN(20); ++_r) xcd_barrier((unsigned*)(WSP + OFF_CTL), (volatile LAS unsigned*)(lds + LDS_BAR_OFF), widk); } while (0)
#endif

__global__ void __launch_bounds__(512, 2) mega_fwd(Params P) {
    extern __shared__ __attribute__((aligned(16))) unsigned char lds_raw[];
    LAS unsigned char* lds = (LAS unsigned char*)lds_raw;
    cg::grid_group grid = cg::this_grid();
    const int G = gridDim.x, c = blockIdx.x;
    const int widk = __builtin_amdgcn_readfirstlane(threadIdx.x >> 6);
    if (threadIdx.x == 0) { ((LAS unsigned*)(lds + LDS_BAR_OFF))[0] = 0u; ((LAS unsigned*)(lds + LDS_BAR_OFF))[1] = 0u; }
    if (blockIdx.x == 0) for (int i = threadIdx.x; i < 3456; i += 512) __hip_atomic_store((unsigned*)(P.ws + OFF_CTL) + i, 0u, __ATOMIC_RELAXED, __HIP_MEMORY_SCOPE_AGENT);
    grid.sync();
    if (threadIdx.x == 0) (void)xb_add((unsigned*)(P.ws + OFF_CTL) + XB_XCNT(xb_xcc_id()), 1u);

#ifdef LDSP
    {
        LAS unsigned long long* PL = (LAS unsigned long long*)(lds + 143360);
        if (threadIdx.x == 0) { const unsigned long long* src = (const unsigned long long*)&P;
#pragma unroll
            for (int i = 0; i < 26; ++i) PL[i] = src[i]; }
        __syncthreads();
    }
#endif
#ifdef LDSP
#define PF(i) ((const float*)ldp(lds, (i)))
#else
#define PF(i) (((const float* const*)&P)[(i)])
#endif
#ifdef LDSP
#define WSP ((unsigned char*)ldp(lds, 25))
#else
#define WSP (P.ws)
#endif
#define XF ((float*)(WSP + OFF_XF))
#define XB ((bf16_t*)(WSP + OFF_XB))
#define PB ((bf16_t*)(WSP + OFF_PB))
#define PLEB ((bf16_t*)(WSP + OFF_PLE))
#define HB ((bf16_t*)(WSP + OFF_H))
#define ACTB ((bf16_t*)(WSP + OFF_ACT))
#define OB ((bf16_t*)(WSP + OFF_O))
#define KTT ((bf16_t*)(WSP + OFF_KTT))
#define SEL ((int*)(WSP + OFF_SEL))
#define XA ((float*)(WSP + OFF_XA))
#define SSQ ((float*)(WSP + OFF_SSQ))
#define DL ((float*)(WSP + OFF_DL))
#define KIN ((bf16_t*)(WSP + OFF_KIN))
#define WB ((bf16_t*)(WSP + OFF_W))
#define QKVR ((bf16_t*)(WSP + OFF_QKVR))
#define BP ((bf16_t*)(WSP + OFF_BP))
#define UT ((float*)(WSP + OFF_UT))
#define KT ((bf16_t*)(WSP + OFF_KT))
#define AP PLEB
#define STB ((float*)(WSP + OFF_ST))
#define PPB ((bf16_t*)(WSP + OFF_PP))


    for (int rep = 0; rep < REPN(12); ++rep) {
        IDX_SETUP
        LAS unsigned* scr = (LAS unsigned*)(lds + wid * 16384);
        if (EN(12)) {
#pragma unroll 1
        for (int j = 0; j < 2; ++j) {
            TJOB(PF(2) + (size_t)j * D * GLA_N, D, GLA_N, WB + W_GIN + (size_t)j * GLA_N * D, 0);
            TJOB(PF(7) + (size_t)j * D * D, D, D, WB + W_GO + (size_t)j * D * D, 0);
        }
#pragma unroll 1
        for (int g = 0; g < 4; ++g) TJOB(PF(8) + (size_t)g * 512 * 512, 512, 512, WB + W_POOL, g * 512);
        TJOB(PF(10), D, DSA_N, WB + W_DIN, 0);
        TJOB(PF(13), D, D, WB + W_DO, 0);
#pragma unroll 1
        for (int i = 0; i < 4; ++i) {
            TJOB(PF(16) + (size_t)i * D * NUP, D, NUP, WB + W_UP + (size_t)i * NUP * D, 0);
            TJOB(PF(19) + (size_t)i * DFF * D, DFF, D, WB + W_DOWN + (size_t)i * D * DFF, 0);
            TJOB(PF(20) + (size_t)i * D * D, D, D, WB + W_GATE + (size_t)i * D * D, 0);
            TJOB(PF(21) + (size_t)i * PLE * D, PLE, D, WB + W_PROJ + (size_t)i * D * PLE, 0);
        }
        }
        if (EN(13)) row_pass(PF(0), nullptr, nullptr, nullptr, XB, nullptr, widk);
        for (size_t i = (size_t)gt; i < (size_t)4 * T * PLE / 4; i += (size_t)NT) { const f32x4 v = ((const f32x4*)PF(1))[i]; u32x2 w; w.x = cvt_pk_bf16(v.x, v.y); w.y = cvt_pk_bf16(v.z, v.w); ((u32x2*)PB)[i] = w; }
    }
    GSYNC();

#pragma unroll 1
    for (int layer = 0; layer < 4; ++layer) {
        const int kind = layer % 3, jl = layer / 3;
        const float* xsrc = (layer == 0) ? PF(0) : XF;
        if (kind != 1) {
            if (kind == 0) for (int rep = 0; rep < REPN(21); ++rep) xa_pass(XB, PF(3) + (size_t)jl * D * 16, XA, widk);
            const int N = (kind == 0) ? GLA_N : DSA_NP;
            pg8::PlainSched S; S.o.init(T / 256, N / 256, G, c); S.A = (const char*)XB; S.B = (const char*)(kind == 0 ? WB + W_GIN + (size_t)jl * GLA_N * D : WB + W_DIN);
            S.tsA = (size_t)256 * D * 2; S.tsB = (size_t)256 * D * 2; S.poolmode = 0;
            pg8::EpiBf16<0> E{HB, N};
            for (int rep = 0; rep < REPN(14); ++rep) pg8::gemm_phase(lds, D, D, D, S, E, widk);
            GSYNC();
        }
        if (kind == 0) {
            for (int rep = 0; rep < REPN(0); ++rep) gla_prep(QKVR, XA, PF(4) + (size_t)jl * 16 * 1024, PF(5) + (size_t)jl * 1024, AP, KT, KTT, DL, lds, widk);
            for (int rep = 0; rep < REPN(1); ++rep) gla_vt(QKVR, BP, lds, widk);
            { IDX_SETUP for (int i = gt; i < T * 4; i += NT) SSQ[i] = 0.f; }
            GSYNC();
            for (int rep = 0; rep < REPN(2); ++rep) { GlaScoreSched S{G, c, AP, KT}; GlaScoreEpi E{AP}; pg8::gemm_phase(lds, 256, 2048, 1024, S, E, widk); }
            for (int rep = 0; rep < REPN(3); ++rep) { GlaUSched S{G, c, BP, KTT}; GlaUEpi E{UT, DL}; pg8::gemm_phase(lds, 256, 512, SEQ, S, E, widk); }
            GSYNC();
            for (int rep = 0; rep < REPN(4); ++rep) gla_scan(UT, DL, BP, widk);
            GSYNC();
            if (EN(5)) { GlaOSched S{G, c, AP, BP}; GlaOEpi E{OB, SSQ}; pg8::gemm_phase(lds, 512, 2048, 512, S, E, widk); }
            GSYNC();
            if (EN(6)) gla_gate(OB, SSQ, QKVR, PF(6) + (size_t)jl * D, widk);
            GSYNC();
        } else if (kind == 1) {
            for (int rep = 0; rep < REPN(7); ++rep) pool_pass(XB, OB, widk);
            GSYNC();
        } else {
            for (int rep = 0; rep < REPN(8); ++rep) dsa_kin(HB, PF(11), PF(12), KIN, widk);
            GSYNC();
            for (int rep = 0; rep < REPN(9); ++rep) dsa_topk(HB, KIN, SEL, lds, widk);
            GSYNC();
            for (int rep = 0; rep < REPN(10); ++rep) dsa_attn(HB, SEL, OB, lds, widk);
            GSYNC();
        }
        {
            pg8::PlainSched S; S.o.init(T / 256, D / 256, G, c); S.A = (const char*)OB;
            S.B = (const char*)(kind == 0 ? WB + W_GO + (size_t)jl * D * D : kind == 1 ? WB + W_POOL : WB + W_DO);
            const int K = (kind == 1) ? 512 : D;
            S.tsA = (size_t)256 * D * 2; S.tsB = (size_t)256 * K * 2; S.poolmode = (kind == 1);
            pg8::EpiResidT<4> E{xsrc, XF, (kind == 1) ? PF(9) : nullptr, nullptr, nullptr, (layer == 0) ? nullptr : STB, PF(22) + (size_t)(layer - 1) * D, PF(23) + (size_t)(layer - 1) * D};
            if (REPN(15) > 1) { pg8::EpiResid E2{xsrc, (float*)HB, (kind == 1) ? PF(9) : nullptr, nullptr, nullptr, (layer == 0) ? nullptr : STB, PF(22) + (size_t)(layer - 1) * D, PF(23) + (size_t)(layer - 1) * D}; pg8::gemm_phase(lds, K, D, K, S, E2, widk); }
            if (EN(15)) pg8::gemm_phase(lds, K, D, K, S, E, widk);
        }
        GSYNC();
        if (EN(13)) row_pass(XF, PF(14) + (size_t)layer * D, PF(15) + (size_t)layer * D, nullptr, XB, STB, widk);
        if (REPN(13) > 1) row_pass(XF, PF(14) + (size_t)layer * D, PF(15) + (size_t)layer * D, (float*)HB, OB, nullptr, widk);
        GSYNC();
#pragma unroll 1
        for (int gi = 0; gi < 2; ++gi) {
            const int N = gi == 0 ? NUP : D;
            pg8::PlainSched S; S.o.init(T / 256, N / 256, G, c); S.A = (const char*)XB;
            S.B = (const char*)(gi == 0 ? WB + W_UP + (size_t)layer * NUP * D : WB + W_GATE + (size_t)layer * D * D);
            S.tsA = (size_t)256 * D * 2; S.tsB = (size_t)256 * D * 2; S.poolmode = 0;
            if (gi == 0) { pg8::EpiBf16<0, true> E{HB, NUP}; for (int rep = 0; rep < REPN(16); ++rep) pg8::gemm_phase(lds, D, D, D, S, E, widk); }
            else { pg8::EpiBf16<2> E{PLEB, D}; for (int rep = 0; rep < REPN(17); ++rep) pg8::gemm_phase(lds, D, D, D, S, E, widk); }
        }
        {
            pg8::PlainSched S; S.o.init(T / 256, D / 256, G, c); S.A = (const char*)(PB + (size_t)layer * T * PLE); S.B = (const char*)(WB + W_PROJ + (size_t)layer * D * PLE);
            S.tsA = (size_t)256 * PLE * 2; S.tsB = (size_t)256 * PLE * 2; S.poolmode = 0;
            pg8::EpiBf16<0> E{PPB, D};
            for (int rep = 0; rep < REPN(18); ++rep) pg8::gemm_phase(lds, PLE, PLE, PLE, S, E, widk);
        }
        GSYNC();
        for (int rep = 0; rep < REPN(11); ++rep) conv_pass(HB, PF(17) + (size_t)layer * 3 * NUP, PF(18) + (size_t)layer * NUP, ACTB, widk);
        GSYNC();
        {
            pg8::PlainSched S; S.o.init(T / 256, D / 256, G, c); S.A = (const char*)ACTB; S.B = (const char*)(WB + W_DOWN + (size_t)layer * D * DFF);
            S.tsA = (size_t)256 * DFF * 2; S.tsB = (size_t)256 * DFF * 2; S.poolmode = 0;
            pg8::EpiResid E{XF, XF, nullptr, PLEB, PPB, STB, PF(14) + (size_t)layer * D, PF(15) + (size_t)layer * D};
            if (REPN(19) > 1) { pg8::EpiResid E2{XF, (float*)HB, nullptr, PLEB, PPB, STB, PF(14) + (size_t)layer * D, PF(15) + (size_t)layer * D}; pg8::gemm_phase(lds, DFF, DFF, DFF, S, E2, widk); }
            if (EN(19)) pg8::gemm_phase(lds, DFF, DFF, DFF, S, E, widk);
        }
        GSYNC();
        if (!EN(13)) {} else if (layer == 3) row_pass(XF, PF(22) + (size_t)layer * D, PF(23) + (size_t)layer * D, ((float*)PF(24)), nullptr, nullptr, widk);
        else row_pass(XF, PF(22) + (size_t)layer * D, PF(23) + (size_t)layer * D, nullptr, XB, STB, widk);
        if (layer != 3) GSYNC();
    }
}

extern "C" void kernel_launch(void* const* d_in, const int* in_sizes, int n_in, void* d_out, int out_size, void* d_ws, size_t ws_size, hipStream_t stream) {
    static int grid = 0;
    if (grid == 0) {
        if (n_in != 24 || out_size != T * D || ws_size < WS_END) { fprintf(stderr, "kernel_launch: unexpected problem (n_in %d, out %d, ws %zu < %zu)\n", n_in, out_size, ws_size, (size_t)WS_END); grid = -1; return; }
        int dev = 0, cus = 0, per_cu = 0;
        (void)hipGetDevice(&dev); (void)hipDeviceGetAttribute(&cus, hipDeviceAttributeMultiprocessorCount, dev);
        if (hipFuncSetAttribute((const void*)mega_fwd, hipFuncAttributeMaxDynamicSharedMemorySize, LDS_BYTES) != hipSuccess) { fprintf(stderr, "kernel_launch: hipFuncSetAttribute failed\n"); grid = -1; return; }
        if (hipOccupancyMaxActiveBlocksPerMultiprocessor(&per_cu, (const void*)mega_fwd, 512, LDS_BYTES) != hipSuccess || per_cu < 1) { fprintf(stderr, "kernel_launch: occupancy query says %d blocks/CU\n", per_cu); per_cu = 1; }
        (void)hipGetLastError();
        grid = cus;
    }
    if (grid < 0) return;
    Params p{};
    const float** pf = (const float**)&p;
    for (int i = 0; i < 24; ++i) pf[i] = (const float*)d_in[i];
    p.out = (float*)d_out; p.ws = (unsigned char*)d_ws;
    void* args[] = {&p};
    hipError_t e = hipLaunchCooperativeKernel((const void*)mega_fwd, dim3(grid), dim3(512), args, LDS_BYTES, stream);
    if (e != hipSuccess) fprintf(stderr, "kernel_launch: cooperative launch failed: %s (grid %d)\n", hipGetErrorString(e), grid);
}
```

```cpp
#include <hip/hip_runtime.h>
#include <hip/hip_cooperative_groups.h>
#include <cstdio>
namespace cg = cooperative_groups;

#define LAS __attribute__((address_space(3)))
typedef unsigned short bf16_t;
typedef short bf16x8 __attribute__((ext_vector_type(8)));
typedef float f32x4 __attribute__((ext_vector_type(4)));
typedef float f32x2 __attribute__((ext_vector_type(2)));
typedef unsigned u32x4 __attribute__((ext_vector_type(4)));
typedef unsigned u32x2 __attribute__((ext_vector_type(2)));

constexpr int T = 16384, SEQ = 8192, D = 2048, DFF = 5504, NUP = 11008, PLE = 256;
constexpr int GLA_N = 6144, DSA_N = 4176, DSA_NP = 4352;
constexpr float LN_EPS = 1e-5f;
constexpr float ALPHA = 1.681792830507429f;

constexpr size_t OFF_XF = 0;
constexpr size_t OFF_XB = OFF_XF + (size_t)T * D * 4;
constexpr size_t OFF_PB = OFF_XB + (size_t)T * D * 2;
constexpr size_t OFF_PLE = OFF_PB + (size_t)4 * T * PLE * 2;
constexpr size_t OFF_H = OFF_PLE + (size_t)T * D * 2;
constexpr size_t OFF_ACT = OFF_H + (size_t)T * NUP * 2;
constexpr size_t OFF_O = OFF_ACT + (size_t)T * DFF * 2;
constexpr size_t OFF_KTT = OFF_O + (size_t)T * D * 2;
constexpr size_t OFF_SEL = OFF_KTT + (size_t)T * 1024 * 2;
constexpr size_t OFF_XA = OFF_SEL + (size_t)T * 256 * 4;
constexpr size_t OFF_SSQ = OFF_XA + (size_t)T * 16 * 4;
constexpr size_t OFF_DL = OFF_SSQ + (size_t)T * 4 * 4;
constexpr size_t OFF_KIN = OFF_DL + (size_t)8 * 32 * 256 * 4;
constexpr size_t OFF_PP = OFF_KIN + (size_t)T * 64 * 2;
constexpr size_t OFF_CTL = OFF_PP + (size_t)T * D * 2;
constexpr size_t CTL_BYTES = 65536;
constexpr size_t OFF_ST = OFF_CTL + CTL_BYTES;
constexpr size_t OFF_W = OFF_ST + (size_t)T * 8;
constexpr size_t W_GIN = 0;
constexpr size_t W_GO = W_GIN + (size_t)2 * GLA_N * D;
constexpr size_t W_POOL = W_GO + (size_t)2 * D * D;
constexpr size_t W_DIN = W_POOL + (size_t)D * 512;
constexpr size_t W_DO = W_DIN + (size_t)DSA_NP * D;
constexpr size_t W_UP = W_DO + (size_t)D * D;
constexpr size_t W_DOWN = W_UP + (size_t)4 * NUP * D;
constexpr size_t W_GATE = W_DOWN + (size_t)4 * D * DFF;
constexpr size_t W_PROJ = W_GATE + (size_t)4 * D * D;
constexpr size_t W_END = W_PROJ + (size_t)4 * D * PLE;
constexpr size_t WS_END = OFF_W + W_END * 2;
constexpr size_t OFF_QKVR = OFF_H;
constexpr size_t OFF_BP = OFF_H + (size_t)T * GLA_N * 2;
constexpr size_t OFF_UT = OFF_ACT;
constexpr size_t OFF_KT = OFF_ACT + (size_t)8 * 32 * 512 * 256 * 4;
static_assert(OFF_BP + (size_t)8 * 32 * 512 * 512 * 2 <= OFF_ACT, "GLA overlay 1");
static_assert(OFF_KT + (size_t)T * 1024 * 2 <= OFF_O, "GLA overlay 2");

constexpr int LDS_BYTES = 147456;
constexpr int LDS_BAR_OFF = LDS_BYTES - 64;

__device__ __forceinline__ float bf2f(unsigned short b) { return __uint_as_float(((unsigned)b) << 16); }
__device__ __forceinline__ unsigned f2bf(float f) { unsigned u = __float_as_uint(f); return (u + 0x7fffu + ((u >> 16) & 1u)) >> 16; }
__device__ __forceinline__ unsigned cvt_pk_bf16(float lo, float hi) { unsigned r; asm volatile("v_cvt_pk_bf16_f32 %0, %1, %2" : "=v"(r) : "v"(lo), "v"(hi)); return r; }
__device__ __forceinline__ float lo16(unsigned w) { return __uint_as_float(w << 16); }
__device__ __forceinline__ float hi16(unsigned w) { return __uint_as_float(w & 0xffff0000u); }
__device__ __forceinline__ float shx(float v, int m, int lane) { return __int_as_float(__builtin_amdgcn_ds_bpermute((lane ^ m) << 2, __float_as_int(v))); }
__device__ __forceinline__ int shi(int v, int src) { return __builtin_amdgcn_ds_bpermute(src << 2, v); }
__device__ __forceinline__ float wave_sum(float v, int lane) {
#pragma unroll
    for (int o = 1; o < 64; o <<= 1) v += shx(v, o, lane);
    return v;
}
__device__ __forceinline__ f32x2 gelu_pk(f32x2 v) {
    const f32x2 av = __builtin_elementwise_abs(v), d = av * 0.2316418882f + 1.0f;
    f32x2 t; t.x = __builtin_amdgcn_rcpf(d.x); t.y = __builtin_amdgcn_rcpf(d.y);
    f32x2 q = t * 0.5307027145f + (-0.7265760135f); q = q * t + 0.7107068705f; q = q * t + (-0.142248368f); q = q * t + 0.127414796f; q = q * t;
    const f32x2 s = (v * v) * (-0.72134752044f);
    f32x2 e; e.x = __builtin_amdgcn_exp2f(s.x); e.y = __builtin_amdgcn_exp2f(s.y);
    const f32x2 m = v * (q * e), r = v - m;
    f32x2 o; o.x = v.x < 0.f ? m.x : r.x; o.y = v.y < 0.f ? m.y : r.y; return o;
}
__device__ __forceinline__ float sigmoidf_(float x) { return 1.0f / (1.0f + __expf(-x)); }

__device__ __forceinline__ int lane_asm() { int l; asm volatile("v_mbcnt_lo_u32_b32 %0, -1, 0\n\tv_mbcnt_hi_u32_b32 %0, -1, %0" : "=&v"(l)); return l; }
__device__ __forceinline__ int opaque_tid(int widk) { asm volatile("" : "+s"(widk)); int l; asm volatile("v_mbcnt_lo_u32_b32 %0, -1, 0\n\tv_mbcnt_hi_u32_b32 %0, -1, %0" : "=&v"(l)); return (widk << 6) | l; }
__device__ __forceinline__ int opaque_s(int v) { v = __builtin_amdgcn_readfirstlane(v); asm volatile("" : "+s"(v)); return v; }
#define IDX_SETUP const int tid = opaque_tid(widk), lane = tid & 63, wid = __builtin_amdgcn_readfirstlane(tid >> 6); const int G = opaque_s(gridDim.x), c = opaque_s(blockIdx.x); \
    const int gw = c * 8 + wid, NGW = G * 8, gt = c * 512 + tid, NT = G * 512; (void)lane; (void)wid; (void)gw; (void)NGW; (void)gt; (void)NT;
namespace pg8 {
constexpr int BM = 256, BK = 64, HALF = 128, HTB = HALF * BK * 2, NXCD = 8, WGM = 4;
__host__ __device__ __forceinline__ int lds_byte(int r, int c) { const int st = (r >> 4) * 2 + (c >> 5), rr = r & 15, cc = c & 31, ob = rr * 64 + cc * 2; return st * 1024 + (ob ^ (((ob >> 9) & 1) << 5)); }
__host__ __device__ __forceinline__ void stage_rc(int b, int& R, int& C) { const int st = b / 1024, sb = b % 1024, swz = sb ^ (((sb >> 9) & 1) << 5); R = (st >> 1) * 16 + swz / 64; C = (st & 1) * 32 + (swz % 64) / 2; }
__host__ __device__ __forceinline__ int perm32(int rho) { const int n = rho >> 4, i = rho & 15; return 8 * (i >> 2) + 4 * n + (i & 3); }

struct Unit { int pm, pn; const char* A; const char* B; };

struct TileOrder {
    int nM, nN, nwg, G, c;
    __device__ __forceinline__ void init(int nM_, int nN_, int G_, int c_) { nM = nM_; nN = nN_; nwg = nM * nN; G = G_; c = c_; }
    __device__ __forceinline__ bool next(int i, int& pm, int& pn) const {
        const long L = (long)i * G + c; if (L >= nwg) return false;
        int wgid = (int)L; { const int q = nwg / NXCD, r = nwg % NXCD, xcd = wgid % NXCD, off = wgid / NXCD; wgid = (xcd < r ? xcd * (q + 1) : r * (q + 1) + (xcd - r) * q) + off; }
        const int nig = WGM * nN, gid = wgid / nig, fm = gid * WGM, gsz = (nM - fm) < WGM ? (nM - fm) : WGM;
        pm = fm + ((wgid % nig) % gsz); pn = (wgid % nig) / gsz; return true;
    }
};
struct PlainSched {
    TileOrder o; const char* A; const char* B; size_t tsA, tsB; int poolmode;
    __device__ __forceinline__ bool next(int i, Unit& u) const {
        if (!o.next(i, u.pm, u.pn)) return false;
        u.A = A + (size_t)u.pm * tsA + (poolmode ? (size_t)(u.pn >> 1) * 1024 : 0); u.B = B + (size_t)u.pn * tsB; return true;
    }
};

template <int ACT  , bool NT = false  > struct EpiBf16 {
    static constexpr bool PERM = true;
    bf16_t* O; int ldc;
    __device__ __forceinline__ void operator()(const f32x4 (&acc)[2][2][4][2], const Unit& u, int wr, int wc, int fr, int fq) const {
        const int lane = lane_asm(); fr = lane & 15; fq = lane >> 4; (void)lane;
        const int row0 = u.pm * BM + wr * 64 + fr, col0 = u.pn * BM + wc * 32 + 8 * fq;
#pragma unroll
        for (int ai = 0; ai < 2; ++ai)
#pragma unroll
            for (int m = 0; m < 4; ++m) { bf16_t* rowp = O + (size_t)(row0 + ai * HALF + m * 16) * ldc + col0;
#pragma unroll
                for (int bj = 0; bj < 2; ++bj) { f32x4 v0 = acc[ai][bj][m][0], v1 = acc[ai][bj][m][1];
                    if (ACT == 2) {
#pragma unroll
                        for (int j = 0; j < 4; ++j) { v0[j] = sigmoidf_(v0[j]); v1[j] = sigmoidf_(v1[j]); } }
                    u32x4 w; w.x = cvt_pk_bf16(v0[0], v0[1]); w.y = cvt_pk_bf16(v0[2], v0[3]); w.z = cvt_pk_bf16(v1[0], v1[1]); w.w = cvt_pk_bf16(v1[2], v1[3]);
                    if (NT) __builtin_nontemporal_store(w, (u32x4*)(rowp + bj * HALF)); else *(u32x4*)(rowp + bj * HALF) = w; } }
    }
};
struct EpiPleMul {
    static constexpr bool PERM = true;
    bf16_t* O; int ldc;
    __device__ __forceinline__ void operator()(const f32x4 (&acc)[2][2][4][2], const Unit& u, int wr, int wc, int fr, int fq) const {
        const int lane = lane_asm(); fr = lane & 15; fq = lane >> 4; (void)lane;
        const int row0 = u.pm * BM + wr * 64 + fr, col0 = u.pn * BM + wc * 32 + 8 * fq;
#pragma unroll
        for (int ai = 0; ai < 2; ++ai)
#pragma unroll
            for (int m = 0; m < 4; ++m) { bf16_t* rowp = O + (size_t)(row0 + ai * HALF + m * 16) * ldc + col0;
#pragma unroll
                for (int bj = 0; bj < 2; ++bj) { const f32x4 v0 = acc[ai][bj][m][0], v1 = acc[ai][bj][m][1];
                    const u32x4 g = *(const u32x4*)(rowp + bj * HALF);
                    u32x4 w; w.x = cvt_pk_bf16(v0[0] * lo16(g.x), v0[1] * hi16(g.x)); w.y = cvt_pk_bf16(v0[2] * lo16(g.y), v0[3] * hi16(g.y));
                    w.z = cvt_pk_bf16(v1[0] * lo16(g.z), v1[1] * hi16(g.z)); w.w = cvt_pk_bf16(v1[2] * lo16(g.w), v1[3] * hi16(g.w));
                    *(u32x4*)(rowp + bj * HALF) = w; }
                asm volatile("" ::: "memory"); }
    }
};
template <int NB  > struct EpiResidT {
    static constexpr bool PERM = false;
    const float* src; float* dst; const float* cscale; const bf16_t* ple; const bf16_t* ple2;
    const float* st; const float* lg; const float* lb;
    __device__ __forceinline__ void operator()(const f32x4 (&acc)[2][2][4][2], const Unit& u, int wr, int wc, int fr, int fq) const {
        const int lane = lane_asm(); fr = lane & 15; fq = lane >> 4; (void)lane;
        const int row0 = u.pm * BM + wr * 64 + fr, col0 = u.pn * BM + wc * 32 + 4 * fq;
#pragma unroll
        for (int ai = 0; ai < 2; ++ai)
#pragma unroll
            for (int mp = 0; mp < 4 / NB; ++mp) {
                f32x4 sv[NB][2][2]; u32x2 pv[NB][2][2], qv[NB][2][2]; f32x2 sr[NB];
#pragma unroll
                for (int mm = 0; mm < NB; ++mm) { const int m = NB * mp + mm; const size_t rr = (size_t)(row0 + ai * HALF + m * 16), off = rr * D + col0;
                    sr[mm] = (f32x2){0.f, 1.f}; if (st) sr[mm] = *(const f32x2*)(st + 2 * rr);
#pragma unroll
                    for (int bj = 0; bj < 2; ++bj)
#pragma unroll
                        for (int n = 0; n < 2; ++n) { const size_t o2 = off + bj * HALF + n * 16; sv[mm][bj][n] = *(const f32x4*)(src + o2);
                            if (NB == 2 && ple) { pv[mm][bj][n] = *(const u32x2*)(ple + o2); qv[mm][bj][n] = *(const u32x2*)(ple2 + o2); } } }
#pragma unroll
                for (int mm = 0; mm < NB; ++mm) { const int m = NB * mp + mm; const size_t off = (size_t)(row0 + ai * HALF + m * 16) * D + col0;
#pragma unroll
                    for (int bj = 0; bj < 2; ++bj)
#pragma unroll
                        for (int n = 0; n < 2; ++n) { const size_t o2 = off + bj * HALF + n * 16; f32x4 a = acc[ai][bj][m][n];
                            if (cscale) a = a * *(const f32x4*)(cscale + col0 + bj * HALF + n * 16);
                            if (NB == 2 && ple) { const u32x2 pw = pv[mm][bj][n], qw = qv[mm][bj][n];
                                a = a + (f32x4){lo16(pw.x) * lo16(qw.x), hi16(pw.x) * hi16(qw.x), lo16(pw.y) * lo16(qw.y), hi16(pw.y) * hi16(qw.y)}; }
                            f32x4 sx = sv[mm][bj][n];
                            if (st) sx = (sx - sr[mm].x) * sr[mm].y * *(const f32x4*)(lg + col0 + bj * HALF + n * 16) + *(const f32x4*)(lb + col0 + bj * HALF + n * 16);
                            *(f32x4*)(dst + o2) = sx * ALPHA + a; } }
                asm volatile("" ::: "memory");
            }
    }
};

typedef EpiResidT<2> EpiResid;

template <class Epi, class Sched>
__device__ __forceinline__ void gemm_phase(LAS unsigned char* lds, const int K, const int lda, const int ldb, const Sched& S, const Epi& E, int widk) {
    const int tid = opaque_tid(widk), wid = __builtin_amdgcn_readfirstlane(tid >> 6), lane = tid & 63, wr = wid >> 2, wc = wid & 3, fr = lane & 15, fq = lane >> 4;
    const int nt = K / BK;
    unsigned voffA[2], voffB[2];
#pragma unroll
    for (int i = 0; i < 2; ++i) { int R, C; stage_rc(tid * 16 + i * 8192, R, C); const int Rb = Epi::PERM ? ((R & ~31) + perm32(R & 31)) : R;
        voffA[i] = (unsigned)(R * lda + C) * 2u; voffB[i] = (unsigned)(Rb * ldb + C) * 2u; }
    const size_t kstep = (size_t)(BK * 2);
    const size_t hsA = (size_t)HALF * lda * 2, hsB = (size_t)HALF * ldb * 2;
    const unsigned ldsw = (unsigned)wid * 1024u;
    const int aoff = lds_byte(wr * 64 + fr, fq * 8), boff = lds_byte(wc * 32 + fr, fq * 8);
#define PG8_SA(b, h) (((b) * 2 + (h)) * HTB)
#define PG8_SB(b, h) ((4 + (b) * 2 + (h)) * HTB)
#define PG8_STAGE(bufoff, gbase, voff) do { _Pragma("unroll") for (int _i = 0; _i < 2; ++_i) \
        __builtin_amdgcn_global_load_lds((const unsigned*)((const char*)(gbase) + (voff)[_i]), (LAS unsigned*)(lds + (bufoff) + ldsw + _i * 8192), 16, 0, 0); } while (0)
#define PG8_LDA(dst, b, h) do { _Pragma("unroll") for (int m = 0; m < 4; ++m) _Pragma("unroll") for (int k = 0; k < 2; ++k) dst[m][k] = *(const LAS bf16x8*)(lds + PG8_SA(b, h) + aoff + m * 2048 + k * 1024); } while (0)
#define PG8_LDB(dst, b, h) do { _Pragma("unroll") for (int n = 0; n < 2; ++n) _Pragma("unroll") for (int k = 0; k < 2; ++k) dst[n][k] = *(const LAS bf16x8*)(lds + PG8_SB(b, h) + boff + n * 2048 + k * 1024); } while (0)
#define PG8_MMA(ai, bj, At, Bt) do { __builtin_amdgcn_s_setprio(1); _Pragma("unroll") for (int m = 0; m < 4; ++m) _Pragma("unroll") for (int n = 0; n < 2; ++n) _Pragma("unroll") for (int k = 0; k < 2; ++k) \
        acc[ai][bj][m][n] = __builtin_amdgcn_mfma_f32_16x16x32_bf16(Bt[n][k], At[m][k], acc[ai][bj][m][n], 0, 0, 0); __builtin_amdgcn_s_setprio(0); } while (0)
#define PG8_WAIT_V(n) asm volatile("s_waitcnt vmcnt(" #n ")" ::: "memory")
#define PG8_WAIT_L(n) asm volatile("s_waitcnt lgkmcnt(" #n ")" ::: "memory")
#define PG8_BAR __builtin_amdgcn_s_barrier()
#define PG8_SCHED __builtin_amdgcn_sched_barrier(0)
    Unit cur, nxt; int ui = 0;
    if (!S.next(0, cur)) return;
    f32x4 acc[2][2][4][2];
#pragma unroll
    for (int a = 0; a < 2; ++a)
#pragma unroll
        for (int b = 0; b < 2; ++b)
#pragma unroll
            for (int m = 0; m < 4; ++m)
#pragma unroll
                for (int n = 0; n < 2; ++n) acc[a][b][m][n] = (f32x4){0.f, 0.f, 0.f, 0.f};
    bf16x8 At[4][2], B0[2][2], B1[2][2];
    const char* cA = cur.A; const char* cB = cur.B;
    PG8_STAGE(PG8_SB(0, 0), cB, voffB); PG8_STAGE(PG8_SB(0, 1), cB + hsB, voffB); PG8_STAGE(PG8_SA(0, 0), cA, voffA); PG8_STAGE(PG8_SA(0, 1), cA + hsA, voffA);
    if (wr == 1) PG8_BAR;
    PG8_WAIT_V(2); PG8_BAR;
    PG8_STAGE(PG8_SB(1, 0), cB + kstep, voffB); PG8_STAGE(PG8_SA(1, 0), cA + kstep, voffA); PG8_STAGE(PG8_SB(1, 1), cB + hsB + kstep, voffB);
    PG8_WAIT_V(6); PG8_BAR;
    for (;;) {
        const bool has_next = S.next(ui + 1, nxt);
        const char* nA = has_next ? nxt.A : cA; const char* nB = has_next ? nxt.B : cB;
        for (int t = 0; t < nt; t += 2) {
            const bool last = (t == nt - 2);
            const char* a1 = cA + (size_t)(t + 1) * kstep;
            const char* a2 = last ? nA : cA + (size_t)(t + 2) * kstep; const char* b2 = last ? nB : cB + (size_t)(t + 2) * kstep;
            const char* a3 = a2 + kstep; const char* b3 = b2 + kstep;
            PG8_LDB(B0, 0, 0); PG8_LDB(B1, 0, 1); PG8_SCHED; PG8_LDA(At, 0, 0); PG8_STAGE(PG8_SA(1, 1), a1 + hsA, voffA);
            PG8_WAIT_V(8); PG8_WAIT_L(0); PG8_BAR; PG8_MMA(0, 0, At, B0); PG8_MMA(0, 1, At, B1); PG8_BAR; PG8_SCHED;
            PG8_LDA(At, 0, 1); PG8_STAGE(PG8_SB(0, 0), b2, voffB); PG8_STAGE(PG8_SB(0, 1), b2 + hsB, voffB); PG8_STAGE(PG8_SA(0, 0), a2, voffA);
            PG8_WAIT_V(8); PG8_WAIT_L(0); PG8_BAR; PG8_MMA(1, 0, At, B0); PG8_MMA(1, 1, At, B1); PG8_BAR; PG8_SCHED;
            PG8_LDB(B0, 1, 0); PG8_LDB(B1, 1, 1); PG8_SCHED; PG8_LDA(At, 1, 0); PG8_STAGE(PG8_SA(0, 1), a2 + hsA, voffA);
            PG8_WAIT_V(8); PG8_WAIT_L(0); PG8_BAR; PG8_MMA(0, 0, At, B0); PG8_MMA(0, 1, At, B1); PG8_BAR; PG8_SCHED;
            PG8_LDA(At, 1, 1); PG8_STAGE(PG8_SB(1, 0), b3, voffB); PG8_STAGE(PG8_SB(1, 1), b3 + hsB, voffB); PG8_STAGE(PG8_SA(1, 0), a3, voffA);
            PG8_WAIT_V(8); PG8_WAIT_L(0); PG8_BAR; PG8_MMA(1, 0, At, B0); PG8_MMA(1, 1, At, B1); PG8_BAR; PG8_SCHED;
        }
        if (wr == 0) PG8_BAR;
        E(acc, cur, wr, wc, fr, fq);
        if (!has_next) break;
#pragma unroll
        for (int a = 0; a < 2; ++a)
#pragma unroll
            for (int b = 0; b < 2; ++b)
#pragma unroll
                for (int m = 0; m < 4; ++m)
#pragma unroll
                    for (int n = 0; n < 2; ++n) acc[a][b][m][n] = (f32x4){0.f, 0.f, 0.f, 0.f};
        cur = nxt; cA = nA; cB = nB; ++ui;
        if (wr == 1) PG8_BAR;
    }
    PG8_WAIT_V(0);
    PG8_BAR;
#undef PG8_SA
#undef PG8_SB
#undef PG8_STAGE
#undef PG8_LDA
#undef PG8_LDB
#undef PG8_MMA
#undef PG8_WAIT_V
#undef PG8_WAIT_L
#undef PG8_BAR
#undef PG8_SCHED
}
}

struct GlaScoreSched {
    int G, c; const bf16_t* AP; const bf16_t* KT;
    __device__ __forceinline__ bool next(int i, pg8::Unit& u) const {
        const int idx = c + i * G; if (idx >= 256) return false;
        const int bh = idx >> 5, sc = idx & 31, b = bh >> 2, h = bh & 3; const size_t tok0 = (size_t)b * SEQ + sc * 256;
        u.pm = idx; u.pn = 0; u.A = (const char*)(AP + tok0 * 2048 + h * 512); u.B = (const char*)(KT + tok0 * 1024 + h * 256); return true;
    }
};
struct GlaScoreEpi {
    static constexpr bool PERM = true;
    bf16_t* AP;
    __device__ __forceinline__ void operator()(const f32x4 (&acc)[2][2][4][2], const pg8::Unit& u, int wr, int wc, int fr, int fq) const {
        const int lane = lane_asm(); fr = lane & 15; fq = lane >> 4; (void)lane;
        const int idx = u.pm, bh = idx >> 5, sc = idx & 31, b = bh >> 2, h = bh & 3; const size_t tok0 = (size_t)b * SEQ + sc * 256;
#pragma unroll
        for (int ai = 0; ai < 2; ++ai)
#pragma unroll
            for (int m = 0; m < 4; ++m) { const int r = ai * 128 + wr * 64 + m * 16 + fr; bf16_t* rowp = AP + (tok0 + r) * 2048 + h * 512 + 256;
#pragma unroll
                for (int bj = 0; bj < 2; ++bj) { const int c0 = bj * 128 + wc * 32 + 8 * fq; f32x4 v0 = acc[ai][bj][m][0], v1 = acc[ai][bj][m][1];
#pragma unroll
                    for (int j = 0; j < 4; ++j) { if (c0 + j > r) v0[j] = 0.f; if (c0 + 4 + j > r) v1[j] = 0.f; }
                    u32x4 w; w.x = cvt_pk_bf16(v0[0], v0[1]); w.y = cvt_pk_bf16(v0[2], v0[3]); w.z = cvt_pk_bf16(v1[0], v1[1]); w.w = cvt_pk_bf16(v1[2], v1[3]);
                    *(u32x4*)(rowp + c0) = w; } }
    }
};
struct GlaUSched {
    int G, c; const bf16_t* BP; const bf16_t* KTT;
    __device__ __forceinline__ bool next(int i, pg8::Unit& u) const {
        const int idx = c + i * G; if (idx >= 512) return false;
        const int bhsc = idx >> 1, mt = idx & 1, bh = bhsc >> 5, sc = bhsc & 31;
        u.pm = idx; u.pn = 0; u.A = (const char*)(BP + ((size_t)bhsc * 512 + mt * 256) * 512 + 256); u.B = (const char*)(KTT + (size_t)bh * 256 * SEQ + sc * 256); return true;
    }
};
struct GlaUEpi {
    static constexpr bool PERM = false;
    float* UT; const float* DL;
    __device__ __forceinline__ void operator()(const f32x4 (&acc)[2][2][4][2], const pg8::Unit& u, int wr, int wc, int fr, int fq) const {
        const int lane = lane_asm(); fr = lane & 15; fq = lane >> 4; (void)lane;
        const int idx = u.pm, bhsc = idx >> 1, mt = idx & 1; const float* dl = DL + (size_t)bhsc * 256;
#pragma unroll
        for (int ai = 0; ai < 2; ++ai)
#pragma unroll
            for (int m = 0; m < 4; ++m) { const int r = mt * 256 + ai * 128 + wr * 64 + m * 16 + fr; float* rowp = UT + ((size_t)bhsc * 512 + r) * 256;
#pragma unroll
                for (int bj = 0; bj < 2; ++bj)
#pragma unroll
                    for (int n = 0; n < 2; ++n) { const int c0 = bj * 128 + wc * 32 + n * 16 + 4 * fq; *(f32x4*)(rowp + c0) = acc[ai][bj][m][n] * *(const f32x4*)(dl + c0); } }
    }
};
struct GlaOSched {
    int G, c; const bf16_t* AP; const bf16_t* BP;
    __device__ __forceinline__ bool next(int i, pg8::Unit& u) const {
        const int idx = c + i * G; if (idx >= 512) return false;
        const int bhsc = idx >> 1, nt = idx & 1, bh = bhsc >> 5, sc = bhsc & 31, b = bh >> 2, h = bh & 3; const size_t tok0 = (size_t)b * SEQ + sc * 256;
        u.pm = idx; u.pn = 0; u.A = (const char*)(AP + tok0 * 2048 + h * 512); u.B = (const char*)(BP + ((size_t)bhsc * 512 + nt * 256) * 512); return true;
    }
};
struct GlaOEpi {
    static constexpr bool PERM = true;
    bf16_t* O; float* SSQ;
    __device__ __forceinline__ void operator()(const f32x4 (&acc)[2][2][4][2], const pg8::Unit& u, int wr, int wc, int fr, int fq) const {
        const int lane = lane_asm(); fr = lane & 15; fq = lane >> 4; (void)lane;
        const int idx = u.pm, bhsc = idx >> 1, nt = idx & 1, bh = bhsc >> 5, sc = bhsc & 31, b = bh >> 2, h = bh & 3; const size_t tok0 = (size_t)b * SEQ + sc * 256;
#pragma unroll
        for (int ai = 0; ai < 2; ++ai)
#pragma unroll
            for (int m = 0; m < 4; ++m) { const int r = ai * 128 + wr * 64 + m * 16 + fr; bf16_t* rowp = O + (tok0 + r) * 2048 + h * 512 + nt * 256; float ss = 0.f;
#pragma unroll
                for (int bj = 0; bj < 2; ++bj) { const int c0 = bj * 128 + wc * 32 + 8 * fq; const f32x4 v0 = acc[ai][bj][m][0], v1 = acc[ai][bj][m][1];
                    ss += (v0[0] * v0[0] + v0[1] * v0[1]) + (v0[2] * v0[2] + v0[3] * v0[3]) + (v1[0] * v1[0] + v1[1] * v1[1]) + (v1[2] * v1[2] + v1[3] * v1[3]);
                    u32x4 w; w.x = cvt_pk_bf16(v0[0], v0[1]); w.y = cvt_pk_bf16(v0[2], v0[3]); w.z = cvt_pk_bf16(v1[0], v1[1]); w.w = cvt_pk_bf16(v1[2], v1[3]);
                    *(u32x4*)(rowp + c0) = w; }
                ss += shx(ss, 16, lane); ss += shx(ss, 32, lane);
                if (fq == 0) atomicAdd(SSQ + (tok0 + r) * 4 + h, ss); }
    }
};

struct Params {
    const float *x, *p, *gla_w_in, *gla_w_a1, *gla_w_a2, *gla_b_a, *gla_norm_g, *gla_w_o, *pool_w, *pool_scale, *dsa_w_in, *dsa_kidx_g, *dsa_kidx_b, *dsa_w_o,
        *ln_mix_g, *ln_mix_b, *ffn_w_up, *ffn_conv_w, *ffn_conv_b, *ffn_w_down, *ple_gate_w, *ple_proj_w, *ln_ffn_g, *ln_ffn_b;
    float* out; unsigned char* ws;
};

__device__ __forceinline__ void transpose_item(const float* W, int K, int N, bf16_t* WT, int row_off, LAS unsigned* scr, int item, int lane) {
    const int nblk = (N + 63) / 64, kb = item / nblk, nb = item % nblk, k0 = 64 * kb, n0 = 64 * nb;
    const int nn = (lane & 15) * 4; const bool nok = (n0 + nn) < N;
#pragma unroll
    for (int i = 0; i < 8; ++i) { const int kk = 8 * i + 2 * (lane >> 4);
        f32x4 v0 = {0.f, 0.f, 0.f, 0.f}, v1 = v0;
        if (nok) { v0 = __builtin_nontemporal_load((const f32x4*)(W + (size_t)(k0 + kk) * N + n0 + nn)); v1 = __builtin_nontemporal_load((const f32x4*)(W + (size_t)(k0 + kk + 1) * N + n0 + nn)); }
#pragma unroll
        for (int j = 0; j < 4; ++j) scr[((nn + j) * 72 + kk) >> 1] = cvt_pk_bf16(v0[j], v1[j]); }
    asm volatile("s_waitcnt lgkmcnt(0)" ::: "memory");
#pragma unroll
    for (int j = 0; j < 8; ++j) { const int n = (lane >> 3) + 8 * j, ch = lane & 7;
        const u32x4 o = *(const LAS u32x4*)(scr + ((n * 72 + ch * 8) >> 1));
        __builtin_nontemporal_store(o, (u32x4*)(WT + (size_t)(row_off + n0 + n) * K + k0 + 8 * ch)); }
    asm volatile("s_waitcnt lgkmcnt(0)" ::: "memory");
}
#define TJOB(W, K, N, DST, ROWOFF) do { const int _ni = ((K) / 64) * (((N) + 63) / 64); for (int _it = gw; _it < _ni; _it += NGW) transpose_item((W), (K), (N), (DST), (ROWOFF), scr, _it, lane); } while (0)

__device__ __forceinline__ void row_pass(const float* src, const float* __restrict__ g, const float* __restrict__ b, float* dst32, bf16_t* __restrict__ dstb, float* __restrict__ stats, int widk) {
    IDX_SETUP
    f32x4 vn[8];
    if (gw < T) { const f32x4* xr = (const f32x4*)(src + (size_t)gw * D) + lane;
#pragma unroll
        for (int j = 0; j < 8; ++j) vn[j] = xr[64 * j]; }
    for (int r = gw; r < T; r += NGW) {
        f32x4 v[8];
#pragma unroll
        for (int j = 0; j < 8; ++j) v[j] = vn[j];
        if (r + NGW < T) { const f32x4* xr = (const f32x4*)(src + (size_t)(r + NGW) * D) + lane;
#pragma unroll
            for (int j = 0; j < 8; ++j) vn[j] = xr[64 * j]; }
        if (g) {
            float s = 0.f;
#pragma unroll
            for (int j = 0; j < 8; ++j) s += (v[j].x + v[j].y) + (v[j].z + v[j].w);
            const float mean = wave_sum(s, lane) * (1.f / D); float s2 = 0.f;
#pragma unroll
            for (int j = 0; j < 8; ++j) { v[j] = v[j] - mean; s2 += (v[j].x * v[j].x + v[j].y * v[j].y) + (v[j].z * v[j].z + v[j].w * v[j].w); }
            const float rstd = 1.0f / sqrtf(wave_sum(s2, lane) * (1.f / D) + LN_EPS);
            if (stats && lane == 0) *(f32x2*)(stats + 2 * (size_t)r) = (f32x2){mean, rstd};
#pragma unroll
            for (int j = 0; j < 8; ++j) { const f32x4 gg = ((const f32x4*)g)[lane + 64 * j], bb = ((const f32x4*)b)[lane + 64 * j]; v[j] = v[j] * rstd * gg + bb; }
        }
        if (dst32) { f32x4* o = (f32x4*)(dst32 + (size_t)r * D) + lane;
#pragma unroll
            for (int j = 0; j < 8; ++j) o[64 * j] = v[j]; }
        if (dstb) { u32x2* o = (u32x2*)(dstb + (size_t)r * D) + lane;
#pragma unroll
            for (int j = 0; j < 8; ++j) { u32x2 w; w.x = cvt_pk_bf16(v[j].x, v[j].y); w.y = cvt_pk_bf16(v[j].z, v[j].w); o[64 * j] = w; } }
    }
}

__device__ __forceinline__ void xa_pass(const bf16_t* srcb, const float* wa1, float* xa, int widk) {
    IDX_SETUP
    for (int r0 = gw * 4; r0 < T; r0 += NGW * 4) {
        f32x4 acc[4][4];
#pragma unroll
        for (int rr = 0; rr < 4; ++rr)
#pragma unroll
            for (int qd = 0; qd < 4; ++qd) acc[rr][qd] = (f32x4){0.f, 0.f, 0.f, 0.f};
#pragma unroll 2
        for (int i = 0; i < 32; ++i) { const int cc = lane + 64 * i; const f32x4* w = (const f32x4*)(wa1 + (size_t)cc * 16);
            const f32x4 w0 = w[0], w1 = w[1], w2 = w[2], w3 = w[3];
#pragma unroll
            for (int rr = 0; rr < 4; ++rr) { const float xv = bf2f(srcb[(size_t)(r0 + rr) * D + cc]);
                acc[rr][0] += w0 * xv; acc[rr][1] += w1 * xv; acc[rr][2] += w2 * xv; acc[rr][3] += w3 * xv; } }
        const bool b5 = (lane & 32) != 0, b4 = (lane & 16) != 0, b3 = (lane & 8) != 0, b2 = (lane & 4) != 0;
        const int idx = (b5 ? 8 : 0) + (b4 ? 4 : 0) + (b3 ? 2 : 0) + (b2 ? 1 : 0);
#pragma unroll
        for (int rr = 0; rr < 4; ++rr) {
            float k8[8], k4[4], k2[2];
#pragma unroll
            for (int j = 0; j < 8; ++j) { const float lo = acc[rr][j >> 2][j & 3], hi = acc[rr][2 + (j >> 2)][j & 3]; k8[j] = (b5 ? hi : lo) + shx(b5 ? lo : hi, 32, lane); }
#pragma unroll
            for (int j = 0; j < 4; ++j) k4[j] = (b4 ? k8[j + 4] : k8[j]) + shx(b4 ? k8[j] : k8[j + 4], 16, lane);
#pragma unroll
            for (int j = 0; j < 2; ++j) k2[j] = (b3 ? k4[j + 2] : k4[j]) + shx(b3 ? k4[j] : k4[j + 2], 8, lane);
            float k1 = (b2 ? k2[1] : k2[0]) + shx(b2 ? k2[0] : k2[1], 4, lane);
            k1 += shx(k1, 2, lane); k1 += shx(k1, 1, lane);
            if ((lane & 3) == 0) xa[(size_t)(r0 + rr) * 16 + idx] = k1;
        }
    }
}
__device__ __forceinline__ void conv_pass(const bf16_t* __restrict__ H, const float* __restrict__ cw, const float* __restrict__ cb, bf16_t* __restrict__ ACT, int widk) {
    IDX_SETUP
    constexpr int NCG = DFF / 8, NSEG = T / 32;
    for (int idx = gt; idx < NCG * NSEG; idx += NT) {
        const int cgi = idx % NCG, sg = idx / NCG, t0 = sg * 32, c0 = cgi * 8;
        f32x4 wg[3][2], wu[3][2], bg[2], bu[2];
#pragma unroll
        for (int j = 0; j < 3; ++j)
#pragma unroll
            for (int q = 0; q < 2; ++q) { wg[j][q] = *(const f32x4*)(cw + (size_t)j * NUP + c0 + 4 * q); wu[j][q] = *(const f32x4*)(cw + (size_t)j * NUP + DFF + c0 + 4 * q); }
#pragma unroll
        for (int q = 0; q < 2; ++q) { bg[q] = *(const f32x4*)(cb + c0 + 4 * q); bu[q] = *(const f32x4*)(cb + DFF + c0 + 4 * q); }
        f32x4 g2[2], g1[2], u2[2], u1[2];
        if ((t0 & (SEQ - 1)) == 0) {
#pragma unroll
            for (int q = 0; q < 2; ++q) { g2[q] = (f32x4){0.f, 0.f, 0.f, 0.f}; g1[q] = g2[q]; u2[q] = g2[q]; u1[q] = g2[q]; }
        } else {
            const u32x4 a = *(const u32x4*)(H + (size_t)(t0 - 2) * NUP + c0), b = *(const u32x4*)(H + (size_t)(t0 - 1) * NUP + c0);
            const u32x4 c = *(const u32x4*)(H + (size_t)(t0 - 2) * NUP + DFF + c0), d = *(const u32x4*)(H + (size_t)(t0 - 1) * NUP + DFF + c0);
            g2[0] = (f32x4){lo16(a.x), hi16(a.x), lo16(a.y), hi16(a.y)}; g2[1] = (f32x4){lo16(a.z), hi16(a.z), lo16(a.w), hi16(a.w)};
            g1[0] = (f32x4){lo16(b.x), hi16(b.x), lo16(b.y), hi16(b.y)}; g1[1] = (f32x4){lo16(b.z), hi16(b.z), lo16(b.w), hi16(b.w)};
            u2[0] = (f32x4){lo16(c.x), hi16(c.x), lo16(c.y), hi16(c.y)}; u2[1] = (f32x4){lo16(c.z), hi16(c.z), lo16(c.w), hi16(c.w)};
            u1[0] = (f32x4){lo16(d.x), hi16(d.x), lo16(d.y), hi16(d.y)}; u1[1] = (f32x4){lo16(d.z), hi16(d.z), lo16(d.w), hi16(d.w)};
        }
#pragma unroll 4
        for (int t = 0; t < 32; ++t) {
            const u32x4 a = __builtin_nontemporal_load((const u32x4*)(H + (size_t)(t0 + t) * NUP + c0)), c = __builtin_nontemporal_load((const u32x4*)(H + (size_t)(t0 + t) * NUP + DFF + c0));
            f32x4 g0[2], u0[2];
            g0[0] = (f32x4){lo16(a.x), hi16(a.x), lo16(a.y), hi16(a.y)}; g0[1] = (f32x4){lo16(a.z), hi16(a.z), lo16(a.w), hi16(a.w)};
            u0[0] = (f32x4){lo16(c.x), hi16(c.x), lo16(c.y), hi16(c.y)}; u0[1] = (f32x4){lo16(c.z), hi16(c.z), lo16(c.w), hi16(c.w)};
            unsigned ow[4];
#pragma unroll
            for (int q = 0; q < 2; ++q) {
                const f32x4 hg = bg[q] + wg[0][q] * g2[q] + wg[1][q] * g1[q] + wg[2][q] * g0[q];
                const f32x4 hu = bu[q] + wu[0][q] * u2[q] + wu[1][q] * u1[q] + wu[2][q] * u0[q];
                const f32x2 ga = gelu_pk((f32x2){hg[0], hg[1]}), gb = gelu_pk((f32x2){hg[2], hg[3]});
                ow[2 * q] = cvt_pk_bf16(ga.x * hu[0], ga.y * hu[1]); ow[2 * q + 1] = cvt_pk_bf16(gb.x * hu[2], gb.y * hu[3]);
                g2[q] = g1[q]; g1[q] = g0[q]; u2[q] = u1[q]; u1[q] = u0[q];
            }
            *(u32x4*)(ACT + (size_t)(t0 + t) * DFF + c0) = (u32x4){ow[0], ow[1], ow[2], ow[3]};
        }
    }
}

__device__ __forceinline__ void ple_mul(bf16_t* SG, const bf16_t* PP, int widk) {
    IDX_SETUP
    for (int idx = gt; idx < T * (D / 8); idx += NT) {
        const u32x4 a = ((const u32x4*)SG)[idx], b = ((const u32x4*)PP)[idx];
        u32x4 w; w.x = cvt_pk_bf16(lo16(a.x) * lo16(b.x), hi16(a.x) * hi16(b.x)); w.y = cvt_pk_bf16(lo16(a.y) * lo16(b.y), hi16(a.y) * hi16(b.y));
        w.z = cvt_pk_bf16(lo16(a.z) * lo16(b.z), hi16(a.z) * hi16(b.z)); w.w = cvt_pk_bf16(lo16(a.w) * lo16(b.w), hi16(a.w) * hi16(b.w));
        ((u32x4*)SG)[idx] = w;
    }
}
__device__ __forceinline__ void gla_prep(const bf16_t* QKVR, const float* XA, const float* wa2, const float* ba, bf16_t* AP, bf16_t* KT, bf16_t* KTT, float* DL, LAS unsigned char* lds, int widk) {
    IDX_SETUP
    LAS float* tot = (LAS float*)lds;
    for (int it = c; it < 256; it += G) {
        const int h = it & 3, sc = (it >> 2) & 31, b = it >> 7, bh = b * 4 + h, col = h * 256 + 4 * lane;
        f32x4 w2[16];
#pragma unroll
        for (int j = 0; j < 16; ++j) w2[j] = *(const f32x4*)(wa2 + (size_t)j * 1024 + col);
        const f32x4 bav = *(const f32x4*)(ba + col);
        const size_t tokw = (size_t)b * SEQ + sc * 256 + wid * 32;
#define GLA_LA2(t, out) do { const f32x4* xa4 = (const f32x4*)(XA + (t) * 16); const f32x4 a0 = xa4[0], a1 = xa4[1], a2 = xa4[2], a3 = xa4[3]; \
            f32x4 z = bav + w2[0] * a0[0] + w2[1] * a0[1] + w2[2] * a0[2] + w2[3] * a0[3]; z += w2[4] * a1[0] + w2[5] * a1[1] + w2[6] * a1[2] + w2[7] * a1[3]; \
            z += w2[8] * a2[0] + w2[9] * a2[1] + w2[10] * a2[2] + w2[11] * a2[3]; z += w2[12] * a3[0] + w2[13] * a3[1] + w2[14] * a3[2] + w2[15] * a3[3]; \
            _Pragma("unroll") for (int _e = 0; _e < 4; ++_e) (out)[_e] = -0.0625f * __builtin_amdgcn_logf(1.0f + __builtin_amdgcn_exp2f(-z[_e] * 1.44269504f)); } while (0)
        f32x4 sum = {0.f, 0.f, 0.f, 0.f};
#pragma unroll 4
        for (int tt = 0; tt < 32; ++tt) { f32x4 la; GLA_LA2(tokw + tt, la); sum += la; }
        *(LAS f32x4*)(tot + wid * 256 + 4 * lane) = sum;
        __syncthreads();
        f32x4 bs = {0.f, 0.f, 0.f, 0.f}, ball = bs;
#pragma unroll
        for (int w = 0; w < 8; ++w) { const f32x4 tv = *(const LAS f32x4*)(tot + w * 256 + 4 * lane); if (w < wid) bs += tv; ball += tv; }
        for (int tt = 0; tt < 32; tt += 8) {
            unsigned pk[4][4];
#pragma unroll
            for (int e = 0; e < 8; e += 2) {
                f32x4 kt2[2];
#pragma unroll
                for (int e2 = 0; e2 < 2; ++e2) {
                    const size_t t = tokw + tt + e + e2;
                    f32x4 la; GLA_LA2(t, la); bs += la;
                    const u32x2 qw = *(const u32x2*)(QKVR + t * GLA_N + col), kw = *(const u32x2*)(QKVR + t * GLA_N + 1024 + col);
                    const f32x4 qv = {lo16(qw.x), hi16(qw.x), lo16(qw.y), hi16(qw.y)}, kv = {lo16(kw.x), hi16(kw.x), lo16(kw.y), hi16(kw.y)};
                    f32x4 qt, kt;
#pragma unroll
                    for (int j = 0; j < 4; ++j) { qt[j] = qv[j] * 0.0625f * __builtin_amdgcn_exp2f(bs[j]); kt[j] = kv[j] * __builtin_amdgcn_exp2f(fminf(-bs[j], 120.f)); }
                    u32x2 qo, ko; qo.x = cvt_pk_bf16(qt[0], qt[1]); qo.y = cvt_pk_bf16(qt[2], qt[3]); ko.x = cvt_pk_bf16(kt[0], kt[1]); ko.y = cvt_pk_bf16(kt[2], kt[3]);
                    *(u32x2*)(AP + t * 2048 + h * 512 + 4 * lane) = qo;
                    *(u32x2*)(KT + t * 1024 + col) = ko;
                    kt2[e2] = kt;
                }
#pragma unroll
                for (int j = 0; j < 4; ++j) pk[j][e >> 1] = cvt_pk_bf16(kt2[0][j], kt2[1][j]);
            }
#pragma unroll
            for (int j = 0; j < 4; ++j)
                *(u32x4*)(KTT + ((size_t)(bh * 256 + 4 * lane + j) * SEQ + sc * 256 + wid * 32 + tt)) = (u32x4){pk[j][0], pk[j][1], pk[j][2], pk[j][3]};
        }
        if (wid == 0) { f32x4 dl;
#pragma unroll
            for (int j = 0; j < 4; ++j) dl[j] = __builtin_amdgcn_exp2f(ball[j]);
            *(f32x4*)(DL + (size_t)(bh * 32 + sc) * 256 + 4 * lane) = dl; }
#undef GLA_LA2
        __syncthreads();
    }
}
__device__ __forceinline__ void gla_vt(const bf16_t* __restrict__ QKVR, bf16_t* __restrict__ BP, LAS unsigned char* lds, int widk) {
    IDX_SETUP
    LAS bf16_t* scr = (LAS bf16_t*)(lds + wid * 9216);
    for (int it = gw; it < 256 * 32; it += NGW) {
        const int tt = it >> 5, vt = it & 31;
        const size_t tokb = (size_t)tt * 64; const int vcol = vt * 64, h = vcol >> 9, vv0 = vcol & 511;
        const int b = (int)(tokb >> 13), tl = (int)(tokb & (SEQ - 1)), sc = tl >> 8, tloc0 = tl & 255, bhsc = (b * 4 + h) * 32 + sc;
#pragma unroll
        for (int i = 0; i < 8; ++i) { const int row = (lane >> 3) + 8 * i, ch = lane & 7;
            const u32x4 w = *(const u32x4*)(QKVR + (tokb + row) * GLA_N + 2048 + vcol + ch * 8);
            *(LAS u32x4*)(scr + row * 72 + ch * 8) = w; }
        asm volatile("s_waitcnt lgkmcnt(0)" ::: "memory");
#pragma unroll
        for (int cch = 0; cch < 8; ++cch) {
            unsigned short e[8];
#pragma unroll
            for (int j = 0; j < 8; ++j) e[j] = scr[(cch * 8 + j) * 72 + lane];
            u32x4 w; w.x = e[0] | ((unsigned)e[1] << 16); w.y = e[2] | ((unsigned)e[3] << 16); w.z = e[4] | ((unsigned)e[5] << 16); w.w = e[6] | ((unsigned)e[7] << 16);
            *(u32x4*)(BP + ((size_t)bhsc * 512 + vv0 + lane) * 512 + 256 + tloc0 + cch * 8) = w;
        }
        asm volatile("s_waitcnt lgkmcnt(0)" ::: "memory");
    }
}
__device__ __forceinline__ void gla_scan(const float* __restrict__ UT, const float* __restrict__ DL, bf16_t* __restrict__ BP, int widk) {
    IDX_SETUP
    for (int idx = gt; idx < 8 * 512 * 64; idx += NT) {
        const int k4 = idx & 63, v = (idx >> 6) & 511, bh = idx >> 15;
        f32x4 S = {0.f, 0.f, 0.f, 0.f};
#pragma unroll 4
        for (int sc = 0; sc < 32; ++sc) {
            const size_t bhsc = (size_t)bh * 32 + sc;
            u32x2 w; w.x = cvt_pk_bf16(S[0], S[1]); w.y = cvt_pk_bf16(S[2], S[3]);
            *(u32x2*)(BP + (bhsc * 512 + v) * 512 + k4 * 4) = w;
            const f32x4 dl = *(const f32x4*)(DL + bhsc * 256 + k4 * 4), uu = *(const f32x4*)(UT + (bhsc * 512 + v) * 256 + k4 * 4);
            S = dl * S + uu;
        }
    }
}
__device__ __forceinline__ void gla_gate(bf16_t* O, const float* SSQ, const bf16_t* QKVR, const float* ng, int widk) {
    IDX_SETUP
    for (int idx = gt; idx < T * (D / 8); idx += NT) {
        const int t = idx >> 8, c0 = (idx & 255) * 8, h = c0 >> 9;
        const float rs = 1.0f / sqrtf(SSQ[(size_t)t * 4 + h] * (1.f / 512.f) + LN_EPS);
        const u32x4 ov = *(const u32x4*)(O + (size_t)t * D + c0), rv = *(const u32x4*)(QKVR + (size_t)t * GLA_N + 4096 + c0);
        const f32x4 g0 = *(const f32x4*)(ng + c0), g1 = *(const f32x4*)(ng + c0 + 4);
        float o[8] = {lo16(ov.x), hi16(ov.x), lo16(ov.y), hi16(ov.y), lo16(ov.z), hi16(ov.z), lo16(ov.w), hi16(ov.w)};
        float r[8] = {lo16(rv.x), hi16(rv.x), lo16(rv.y), hi16(rv.y), lo16(rv.z), hi16(rv.z), lo16(rv.w), hi16(rv.w)};
        float gg[8] = {g0[0], g0[1], g0[2], g0[3], g1[0], g1[1], g1[2], g1[3]};
        float y[8];
#pragma unroll
        for (int j = 0; j < 8; ++j) { const float on = bf2f((unsigned short)f2bf(o[j] * rs * gg[j])); y[j] = on * (r[j] * sigmoidf_(r[j])); }
        *(u32x4*)(O + (size_t)t * D + c0) = (u32x4){cvt_pk_bf16(y[0], y[1]), cvt_pk_bf16(y[2], y[3]), cvt_pk_bf16(y[4], y[5]), cvt_pk_bf16(y[6], y[7])};
    }
}

__device__ __forceinline__ f32x4 ldbf4(const bf16_t* p) { const u32x2 w = *(const u32x2*)p; return (f32x4){lo16(w.x), hi16(w.x), lo16(w.y), hi16(w.y)}; }
__device__ __forceinline__ void pool_pass(const bf16_t* __restrict__ X, bf16_t* __restrict__ PO, int widk) {
    IDX_SETUP
    for (int idx = gt; idx < 512 * 512; idx += NT) {
        const int cg4 = idx & 511, sg = idx >> 9, c0 = cg4 * 4, w = 2 << (c0 >> 9);
        const int t0 = sg * 32, tb = t0 & (SEQ - 1);
        f32x4 sum = {0.f, 0.f, 0.f, 0.f};
        for (int j = 1; j < w; ++j) if (tb - j >= 0) sum += ldbf4(X + (size_t)(t0 - j) * D + c0);
#pragma unroll 4
        for (int t = 0; t < 32; ++t) {
            const f32x4 xv = ldbf4(X + (size_t)(t0 + t) * D + c0);
            sum += xv;
            const int tp = tb + t; const float inv = 1.0f / (float)((tp + 1) < w ? (tp + 1) : w);
            const f32x4 y = sum * inv - xv;
            u32x2 o; o.x = cvt_pk_bf16(y[0], y[1]); o.y = cvt_pk_bf16(y[2], y[3]);
            *(u32x2*)(PO + (size_t)(t0 + t) * D + c0) = o;
            if (tp - w + 1 >= 0) sum -= ldbf4(X + (size_t)(t0 + t - w + 1) * D + c0);
        }
    }
}

__device__ __forceinline__ void dsa_kin(const bf16_t* DP, const float* g, const float* b, bf16_t* KIN, int widk) {
    IDX_SETUP
    const float gg = g[lane], bb = b[lane];
    for (int r = gw; r < T; r += NGW) {
        const float v = bf2f(DP[(size_t)r * DSA_NP + 4096 + lane]);
        const float mean = wave_sum(v, lane) * (1.f / 64.f), d = v - mean, var = wave_sum(d * d, lane) * (1.f / 64.f);
        KIN[(size_t)r * 64 + lane] = (bf16_t)f2bf(d * (1.0f / sqrtf(var + LN_EPS)) * gg + bb);
    }
}
__device__ __forceinline__ unsigned f2key(float f) { const unsigned u = __float_as_uint(f); return (u & 0x80000000u) ? ~u : (u | 0x80000000u); }
__device__ __forceinline__ void topk_find_digit(const LAS unsigned* hist, int kk, int lane, int& dg, int& nk) {
    const u32x4 h4 = *(const LAS u32x4*)(hist + 4 * lane);
    const int cc = (int)(h4.x + h4.y + h4.z + h4.w);
    int suf = cc;
#pragma unroll
    for (int o = 1; o < 64; o <<= 1) { const int tv = shi(suf, (lane + o) & 63); if (lane + o < 64) suf += tv; }
    const unsigned long long bal = __ballot(suf >= kk);
    const int Lh = bal ? 63 - __builtin_clzll(bal) : 0;
    int above = suf - cc, d, k2;
    if (above + (int)h4.w >= kk) { d = 3; k2 = kk - above; }
    else { above += (int)h4.w;
        if (above + (int)h4.z >= kk) { d = 2; k2 = kk - above; }
        else { above += (int)h4.z;
            if (above + (int)h4.y >= kk) { d = 1; k2 = kk - above; }
            else { above += (int)h4.y; d = 0; k2 = kk - above; } } }
    dg = __builtin_amdgcn_readlane(4 * lane + d, Lh); nk = __builtin_amdgcn_readlane(k2, Lh);
}
__device__ __forceinline__ void dsa_topk(const bf16_t* DP, const bf16_t* KIN, int* SEL, LAS unsigned char* lds, int widk) {
    IDX_SETUP
    LAS float* scs = (LAS float*)lds;
    LAS unsigned* hist = (LAS unsigned*)(lds + 131072);
    LAS unsigned* misc = (LAS unsigned*)(lds + 131072 + 4096);
    LAS float* mmf = (LAS float*)(lds + 131072 + 4096 + 128);
    LAS unsigned* cand = (LAS unsigned*)(lds + 131072 + 4096 + 384);
    const int fr = lane & 15, fq = lane >> 4;
    for (int rr = c; rr < T / 4; rr += G) {
        const int b = rr >> 11; int blk = rr & 2047; { const int cblk = blk & 255, kb = blk >> 8; blk = (kb < 4) ? (cblk + 256 * kb) : (2047 - (cblk + 256 * (kb - 4))); }
        const int tq0 = blk * 4, n = tq0 + 4;
        const size_t tokq = (size_t)b * SEQ + tq0;
        bf16x8 Af[4][2]; float wv[4][4];
#pragma unroll
        for (int q = 0; q < 4; ++q) {
#pragma unroll
            for (int ks = 0; ks < 2; ++ks) Af[q][ks] = *(const bf16x8*)(DP + (tokq + q) * DSA_NP + 3072 + fr * 64 + ks * 32 + fq * 8);
            const u32x2 ww = *(const u32x2*)(DP + (tokq + q) * DSA_NP + 4160 + 4 * fq);
            wv[q][0] = lo16(ww.x) * 0.03125f; wv[q][1] = hi16(ww.x) * 0.03125f; wv[q][2] = lo16(ww.y) * 0.03125f; wv[q][3] = hi16(ww.y) * 0.03125f;
        }
        const int ntile = (n + 15) >> 4;
        {
            bf16x8 Bf[4][2], Bn[4][2];
#define TOPK_LOAD(dst, jbase) do { _Pragma("unroll") for (int u = 0; u < 4; ++u) { int j = (jbase) + 8 * u; j = j < 512 ? j : 511; \
                const bf16_t* kp = KIN + ((size_t)b * SEQ + j * 16 + fr) * 64 + fq * 8; dst[u][0] = *(const bf16x8*)kp; dst[u][1] = *(const bf16x8*)(kp + 32); } } while (0)
            TOPK_LOAD(Bf, wid);
            float rmn = __builtin_inff(), rmx = -__builtin_inff();
            for (int j4 = wid; j4 < ntile; j4 += 32) {
                TOPK_LOAD(Bn, j4 + 32);
#pragma unroll
                for (int u = 0; u < 4; ++u) {
                    const int j = j4 + 8 * u;
                    if (j < ntile) {
                        float myval = 0.f;
#pragma unroll
                        for (int q = 0; q < 4; ++q) {
                            f32x4 a = {0.f, 0.f, 0.f, 0.f};
                            a = __builtin_amdgcn_mfma_f32_16x16x32_bf16(Af[q][0], Bf[u][0], a, 0, 0, 0);
                            a = __builtin_amdgcn_mfma_f32_16x16x32_bf16(Af[q][1], Bf[u][1], a, 0, 0, 0);
                            float val = wv[q][0] * fmaxf(a[0], 0.f) + wv[q][1] * fmaxf(a[1], 0.f) + wv[q][2] * fmaxf(a[2], 0.f) + wv[q][3] * fmaxf(a[3], 0.f);
                            val += shx(val, 16, lane); val += shx(val, 32, lane);
                            if (fq == q) myval = val;
                        }
                        const int s = j * 16 + fr;
                        if (s > tq0 + fq) myval = -__builtin_inff(); else { rmn = fminf(rmn, myval); rmx = fmaxf(rmx, myval); }
                        scs[fq * 8192 + s] = myval;
                    }
                }
#pragma unroll
                for (int u = 0; u < 4; ++u) { Bf[u][0] = Bn[u][0]; Bf[u][1] = Bn[u][1]; }
            }
#undef TOPK_LOAD
#pragma unroll
            for (int o = 1; o < 16; o <<= 1) { rmn = fminf(rmn, shx(rmn, o, lane)); rmx = fmaxf(rmx, shx(rmx, o, lane)); }
            if (fr == 0) { mmf[wid * 8 + fq * 2] = rmn; mmf[wid * 8 + fq * 2 + 1] = rmx; }
            for (int i = tid; i < 1024; i += 512) hist[i] = 0u;
            if (tid < 32) misc[tid] = 0u;
        }
        __syncthreads();
        const int q = wid >> 1, sub = tid & 127, nq = tq0 + q + 1;
        int* selrow = SEL + (tokq + q) * 256;
        LAS float* row = scs + q * 8192;
        if (n <= 256) {
            for (int i = sub; i < 256; i += 128) selrow[i] = (i < nq) ? i : -1;
        } else {
            float mn = mmf[q * 2], mx = mmf[q * 2 + 1];
#pragma unroll
            for (int w = 1; w < 8; ++w) { mn = fminf(mn, mmf[w * 8 + q * 2]); mx = fmaxf(mx, mmf[w * 8 + q * 2 + 1]); }
            const float scale = (mx > mn) ? 255.0f / (mx - mn) : 0.f;
#define DSA_BIN(v) ({ int _b = (int)(((v) - mn) * scale); _b = _b < 0 ? 0 : _b; _b > 255 ? 255 : _b; })
            for (int sb = 0; sb < nq; sb += 512) { const int s4 = sb + 4 * sub;
                if (s4 < nq) { const f32x4 v4 = *(const LAS f32x4*)(row + s4);
#pragma unroll
                    for (int e = 0; e < 4; ++e) if (s4 + e < nq) __hip_atomic_fetch_add(hist + q * 256 + DSA_BIN(v4[e]), 1u, __ATOMIC_RELAXED, __HIP_MEMORY_SCOPE_WORKGROUP); } }
            __syncthreads();
            int bA, kkA; topk_find_digit(hist + q * 256, 256, lane, bA, kkA);
            LAS unsigned* lst = cand + q * 512;
            for (int sb = 0; sb < nq; sb += 512) { const int s4 = sb + 4 * sub; const bool in4 = s4 < nq;
                f32x4 v4 = {0.f, 0.f, 0.f, 0.f}; if (in4) v4 = *(const LAS f32x4*)(row + s4);
#pragma unroll
                for (int e = 0; e < 4; ++e) { const int s = s4 + e; const bool in = s < nq; const float v = v4[e]; const int bin = DSA_BIN(v);
                    const bool gsel = in && bin > bA;
                    const unsigned long long gm = __ballot(gsel);
                    if (gm) { const int leader = __builtin_ctzll(gm); unsigned base = 0u;
                        if (lane == leader) base = __hip_atomic_fetch_add(misc + q * 4 + 2, (unsigned)__builtin_popcountll(gm), __ATOMIC_RELAXED, __HIP_MEMORY_SCOPE_WORKGROUP);
                        base = (unsigned)__builtin_amdgcn_readlane((int)base, leader);
                        const unsigned pos = base + (unsigned)__builtin_popcountll(gm & ((1ull << lane) - 1ull));
                        if (gsel && pos < 256u) selrow[pos] = s; }
                    if (in && bin == bA) { const unsigned cp = __hip_atomic_fetch_add(misc + q * 4 + 3, 1u, __ATOMIC_RELAXED, __HIP_MEMORY_SCOPE_WORKGROUP); if (cp < 256u) { lst[2 * cp] = f2key(v); lst[2 * cp + 1] = (unsigned)s; } } }
            }
            __syncthreads();
            const int nc = (int)misc[q * 4 + 3];
            if (nc <= 256) {
                for (int i = sub; i < nc; i += 128) { const unsigned ki = lst[2 * i], si = lst[2 * i + 1]; int rank = 0;
                    for (int j = 0; j < nc; ++j) { const unsigned kj = lst[2 * j], sj = lst[2 * j + 1]; rank += (kj > ki || (kj == ki && sj < si)) ? 1 : 0; }
                    if (rank < kkA) selrow[256 - kkA + rank] = (int)si; }
            } else if ((wid & 1) == 0) {
                unsigned prefix = 0u, maskb = 0u; int kk = kkA;
#pragma unroll 1
                for (int pass = 0; pass < 4; ++pass) { const int shift = 24 - 8 * pass;
                    for (int i = lane; i < 256; i += 64) hist[q * 256 + i] = 0u;
                    asm volatile("s_waitcnt lgkmcnt(0)" ::: "memory");
                    for (int s = lane; s < nq; s += 64) { const float v = row[s]; if (DSA_BIN(v) == bA) { const unsigned key = f2key(v); if ((key & maskb) == prefix) __hip_atomic_fetch_add(hist + q * 256 + ((key >> shift) & 255u), 1u, __ATOMIC_RELAXED, __HIP_MEMORY_SCOPE_WORKGROUP); } }
                    asm volatile("s_waitcnt lgkmcnt(0)" ::: "memory");
                    int dg, nk; topk_find_digit(hist + q * 256, kk, lane, dg, nk); kk = nk;
                    prefix |= (unsigned)dg << shift; maskb |= 255u << shift; }
                int baseG = 256 - kkA, baseE = 256 - kk; const int endE = 256;
                for (int sb = 0; sb < nq; sb += 64) { const int s = sb + lane; const bool in = s < nq; const float v = in ? row[s] : 0.f; const bool inb = in && DSA_BIN(v) == bA; const unsigned key = f2key(v);
                    const bool g = inb && key > prefix, e = inb && key == prefix;
                    const unsigned long long gm = __ballot(g), em = __ballot(e), lt = (1ull << lane) - 1ull;
                    if (g) { const int pos = baseG + __builtin_popcountll(gm & lt); if (pos < 256) selrow[pos] = s; }
                    if (e) { const int pos = baseE + __builtin_popcountll(em & lt); if (pos < endE) selrow[pos] = s; }
                    baseG += __builtin_popcountll(gm); baseE += __builtin_popcountll(em); }
            }
#undef DSA_BIN
        }
        __syncthreads();
    }
}
__device__ __forceinline__ void dsa_attn(const bf16_t* DP, const int* SEL, bf16_t* O, LAS unsigned char* lds, int widk) {
    IDX_SETUP
    LAS unsigned char* pl = lds + wid * 10240;
    LAS unsigned char* vt = lds + wid * 10240 + 2048;
    const int fr = lane & 15, fq = lane >> 4;
    unsigned tra[8][2];
#pragma unroll
    for (int cb = 0; cb < 8; ++cb)
#pragma unroll
        for (int t = 0; t < 2; ++t) { const unsigned q_ = (unsigned)(fr >> 2), p_ = (unsigned)(fr & 3), row = 8u * (unsigned)fq + 4u * (unsigned)t + q_, ch = 2u * (unsigned)cb + (p_ >> 1);
            tra[cb][t] = (unsigned)(size_t)vt + 256u * row + 16u * (ch ^ (((row & 3u) << 2) | ((row >> 2) & 3u))) + 8u * (p_ & 1u); }
    for (int m = 0;; ++m) {
#ifdef ATTN_BLOCKED_XCD
        const int kk_ = wid + 8 * m; if (kk_ >= 256 || G != 256) { if (G == 256) break; }
        const int pair = c >> 5, t = (c & 31) + 32 * kk_, b = pair >> 2, g = pair & 3;
#else
        const int jdx = c + G * (wid + 8 * m); if (jdx >= T * 4) break;
        const int pair = jdx & 7, t = jdx >> 3, b = pair >> 2, g = pair & 3;
#endif
        const size_t tok = (size_t)b * SEQ + t; const int nvalid = (t + 1) < 256 ? (t + 1) : 256;
        int s0 = SEL[tok * 256 + lane], s1 = SEL[tok * 256 + 64 + lane], s2 = SEL[tok * 256 + 128 + lane], s3 = SEL[tok * 256 + 192 + lane];
        s0 = s0 < 0 ? 0 : s0; s1 = s1 < 0 ? 0 : s1; s2 = s2 < 0 ? 0 : s2; s3 = s3 < 0 ? 0 : s3;
        bf16x8 qf[4];
#pragma unroll
        for (int ks = 0; ks < 4; ++ks) { qf[ks] = (bf16x8){0, 0, 0, 0, 0, 0, 0, 0}; if (fr < 4) qf[ks] = *(const bf16x8*)(DP + tok * DSA_NP + (g * 4 + fr) * 128 + ks * 32 + fq * 8); }
        const bf16_t* kbase = DP + (size_t)b * SEQ * DSA_NP + 2048 + g * 128 + fq * 8;
        f32x4 acc[16];
#pragma unroll
        for (int j = 0; j < 16; ++j) {
            const int sreg = (j < 4) ? s0 : (j < 8) ? s1 : (j < 12) ? s2 : s3;
            const int idx = shi(sreg, (16 * j + fr) & 63);
            const bf16_t* kr = kbase + (size_t)idx * DSA_NP;
            const bf16x8 a0 = *(const bf16x8*)kr, a1 = *(const bf16x8*)(kr + 32), a2 = *(const bf16x8*)(kr + 64), a3 = *(const bf16x8*)(kr + 96);
            f32x4 a = {0.f, 0.f, 0.f, 0.f};
            a = __builtin_amdgcn_mfma_f32_16x16x32_bf16(a0, qf[0], a, 0, 0, 0);
            a = __builtin_amdgcn_mfma_f32_16x16x32_bf16(a1, qf[1], a, 0, 0, 0);
            a = __builtin_amdgcn_mfma_f32_16x16x32_bf16(a2, qf[2], a, 0, 0, 0);
            a = __builtin_amdgcn_mfma_f32_16x16x32_bf16(a3, qf[3], a, 0, 0, 0);
            acc[j] = a;
            if ((j & 7) == 7) asm volatile("" ::: "memory");
        }
        const bf16_t* vbase = DP + (size_t)b * SEQ * DSA_NP + 2560 + g * 128 + fr * 8;
        u32x4 vcur[8], vnxt[8], vnn[8];
#define ATTN_VLOAD(dst, ks) do { const int sreg_ = ((ks) < 2) ? s0 : ((ks) < 4) ? s1 : ((ks) < 6) ? s2 : s3; _Pragma("unroll") for (int i = 0; i < 8; ++i) { \
            const int idx_ = shi(sreg_, 32 * ((ks) & 1) + fq + 4 * i); dst[i] = *(const u32x4*)(vbase + (size_t)idx_ * DSA_NP); } } while (0)
        ATTN_VLOAD(vcur, 0); ATTN_VLOAD(vnxt, 1);
        float mx = -__builtin_inff();
#pragma unroll
        for (int j = 0; j < 16; ++j)
#pragma unroll
            for (int r = 0; r < 4; ++r) { const int slot = 16 * j + 4 * fq + r; const float sv = (slot < nvalid) ? acc[j][r] * 0.08838834764831845f : -__builtin_inff(); acc[j][r] = sv; mx = fmaxf(mx, sv); }
        mx = fmaxf(mx, shx(mx, 16, lane)); mx = fmaxf(mx, shx(mx, 32, lane));
        float sum = 0.f;
#pragma unroll
        for (int j = 0; j < 16; ++j)
#pragma unroll
            for (int r = 0; r < 4; ++r) { const float pv = __expf(acc[j][r] - mx); acc[j][r] = pv; sum += pv; }
        sum += shx(sum, 16, lane); sum += shx(sum, 32, lane);
        const float inv = 1.0f / sum;
        if (fr < 4) {
#pragma unroll
            for (int j = 0; j < 16; ++j) { u32x2 w; w.x = cvt_pk_bf16(acc[j][0] * inv, acc[j][1] * inv); w.y = cvt_pk_bf16(acc[j][2] * inv, acc[j][3] * inv);
                *(LAS u32x2*)(pl + (fr * 256 + 16 * j + 4 * fq) * 2) = w; }
        }
        f32x4 oc[8];
#pragma unroll
        for (int cb = 0; cb < 8; ++cb) oc[cb] = (f32x4){0.f, 0.f, 0.f, 0.f};
#pragma unroll
        for (int ks = 0; ks < 8; ++ks) {
            if (ks < 6) ATTN_VLOAD(vnn, ks + 2);
#pragma unroll
            for (int i = 0; i < 8; ++i) { const unsigned row = (unsigned)(fq + 4 * i), ch = (unsigned)fr;
                *(LAS u32x4*)(vt + 256u * row + 16u * (ch ^ (((row & 3u) << 2) | ((row >> 2) & 3u)))) = vcur[i]; }
            bf16x8 pa = (bf16x8){0, 0, 0, 0, 0, 0, 0, 0};
            asm volatile("s_waitcnt lgkmcnt(0)" ::: "memory");
            if (fr < 4) pa = *(const LAS bf16x8*)(pl + (fr * 256 + 32 * ks + 8 * fq) * 2);
            u32x2 t0[8], t1[8];
#pragma unroll
            for (int cb = 0; cb < 8; ++cb) {
                asm volatile("ds_read_b64_tr_b16 %0, %1" : "=v"(t0[cb]) : "v"(tra[cb][0]) : "memory");
                asm volatile("ds_read_b64_tr_b16 %0, %1" : "=v"(t1[cb]) : "v"(tra[cb][1]) : "memory");
            }
            asm volatile("s_waitcnt lgkmcnt(0)" : "+v"(t0[0]), "+v"(t0[1]), "+v"(t0[2]), "+v"(t0[3]), "+v"(t0[4]), "+v"(t0[5]), "+v"(t0[6]), "+v"(t0[7]),
                                                  "+v"(t1[0]), "+v"(t1[1]), "+v"(t1[2]), "+v"(t1[3]), "+v"(t1[4]), "+v"(t1[5]), "+v"(t1[6]), "+v"(t1[7]), "+v"(pa) :: "memory");
#pragma unroll
            for (int cb = 0; cb < 8; ++cb) { const u32x4 bw = {t0[cb].x, t0[cb].y, t1[cb].x, t1[cb].y};
                oc[cb] = __builtin_amdgcn_mfma_f32_16x16x32_bf16(pa, __builtin_bit_cast(bf16x8, bw), oc[cb], 0, 0, 0); }
#pragma unroll
            for (int i = 0; i < 8; ++i) { vcur[i] = vnxt[i]; vnxt[i] = vnn[i]; }
        }
#undef ATTN_VLOAD
        if (fq == 0) {
            bf16_t* op = O + tok * D + (g * 4) * 128 + fr;
#pragma unroll
            for (int cb = 0; cb < 8; ++cb)
#pragma unroll
                for (int r = 0; r < 4; ++r) op[r * 128 + 16 * cb] = (bf16_t)f2bf(oc[cb][r]);
        }
        asm volatile("s_waitcnt lgkmcnt(0)" ::: "memory");
    }
}


#define XB_TMO      128
#define XB_XCNT(j)  (256  + 64 * (j))
#define XB_XSUB(j)  (1280 + 64 * (j))
#define XB_XGEN(j)  (2304 + 64 * (j))
#define XB_TOP      3328
#define XB_TOPGEN   3392
#define XB_SPIN_CAP (1u << 22)
__device__ __forceinline__ unsigned xb_ld(unsigned* p)              { return __hip_atomic_load(p, __ATOMIC_RELAXED, __HIP_MEMORY_SCOPE_AGENT); }
__device__ __forceinline__ unsigned xb_add(unsigned* p, unsigned v) { return __hip_atomic_fetch_add(p, v, __ATOMIC_RELAXED, __HIP_MEMORY_SCOPE_AGENT); }
__device__ __forceinline__ unsigned xb_xcc_id() { return (unsigned)__builtin_amdgcn_s_getreg((3 << 11) | 20) & 0xFu; }
#define XB_SPIN(cond, bar) do { unsigned _sp = 0; while (cond) { __builtin_amdgcn_s_sleep(1); \
    if ((++_sp & 255u) == 0u) { if (xb_ld(&(bar)[XB_TMO])) break; if (_sp > XB_SPIN_CAP) { atomicAdd(&(bar)[XB_TMO], 1u); break; } } } } while (0)
__device__ __forceinline__ void xcd_barrier_complete(unsigned* bar, unsigned x, unsigned& nloc, unsigned& nx) {
    const unsigned G = gridDim.x;
    unsigned sum, cnt, mine, sp = 0u;
    for (;;) {
        sum = 0u; cnt = 0u; mine = 0u;
#pragma unroll
        for (unsigned j = 0; j < 16; ++j) { const unsigned cc = xb_ld(&bar[XB_XCNT(j)]); sum += cc; cnt += (cc > 0u) ? 1u : 0u; mine = (j == x) ? cc : mine; }
        if (sum == G) break;
        __builtin_amdgcn_s_sleep(1);
        if ((++sp & 255u) == 0u) { if (xb_ld(&bar[XB_TMO])) break; if (sp > XB_SPIN_CAP) { atomicAdd(&bar[XB_TMO], 1u); break; } }
    }
    nloc = mine > 0u ? mine : 1u; nx = cnt > 0u ? cnt : 1u;
}
__device__ __forceinline__ void xcd_barrier(unsigned* bar, volatile LAS unsigned* st, int widk) {
    asm volatile("s_waitcnt vmcnt(0)" ::: "memory");
    __syncthreads();
    if (opaque_tid(widk) == 0) {
        __builtin_amdgcn_s_waitcnt(0);
        const unsigned x = xb_xcc_id();
        unsigned nloc = st[0], nx = st[1];
        if (nloc == 0u) { xcd_barrier_complete(bar, x, nloc, nx); st[0] = nloc; st[1] = nx; }
        const unsigned old = xb_add(&bar[XB_XSUB(x)], 1u);
        const unsigned gen = old / nloc;
        if (old + 1u == (gen + 1u) * nloc) {
            __builtin_amdgcn_fence(__ATOMIC_RELEASE, "agent");
            asm volatile("s_waitcnt vmcnt(0)" ::: "memory");
            const unsigned og = xb_add(&bar[XB_TOP], 1u);
            const unsigned tg = og / nx;
            if (og + 1u == (tg + 1u) * nx) xb_add(&bar[XB_TOPGEN], 1u);
            else XB_SPIN(xb_ld(&bar[XB_TOPGEN]) == tg, bar);
            __builtin_amdgcn_fence(__ATOMIC_ACQUIRE, "agent");
            xb_add(&bar[XB_XGEN(x)], 1u);
            asm volatile("s_waitcnt vmcnt(0)" ::: "memory");
        } else {
            XB_SPIN(xb_ld(&bar[XB_XGEN(x)]) == gen, bar);
            __builtin_amdgcn_fence(__ATOMIC_ACQUIRE, "agent");
            asm volatile("s_waitcnt vmcnt(0)" ::: "memory");
        }
    }
    __syncthreads();
}
#ifndef EN_MASK
#define EN_MASK 0xFFFFFF
#endif
#define EN(b) ((EN_MASK >> (b)) & 1)
#ifndef REP_MASK
#define REP_MASK 0
#endif
#define REPN(b) (1 + ((REP_MASK >> (b)) & 1))
__device__ __forceinline__ const void* ldp(LAS unsigned char* lds, int i) {
    const LAS unsigned* q = (const LAS unsigned*)(lds + 143360) + 2 * i;
    const unsigned lo = __builtin_amdgcn_readfirstlane(q[0]), hi = __builtin_amdgcn_readfirstlane(q[1]);
    return (const void*)(((unsigned long long)hi << 32) | lo);
}
#ifdef CGSYNC
#define GSYNC() grid.sync()
#else
#define GSYNC() do { for (int _r = 0; _r < REPN(20); ++_r) xcd_barrier((unsigned*)(WSP + OFF_CTL), (volatile LAS unsigned*)(lds + LDS_BAR_OFF), widk); } while (0)
#endif

__global__ void __launch_bounds__(512, 2) mega_fwd(Params P) {
    extern __shared__ __attribute__((aligned(16))) unsigned char lds_raw[];
    LAS unsigned char* lds = (LAS unsigned char*)lds_raw;
    cg::grid_group grid = cg::this_grid();
    const int G = gridDim.x, c = blockIdx.x;
    const int widk = __builtin_amdgcn_readfirstlane(threadIdx.x >> 6);
    if (threadIdx.x == 0) { ((LAS unsigned*)(lds + LDS_BAR_OFF))[0] = 0u; ((LAS unsigned*)(lds + LDS_BAR_OFF))[1] = 0u; }
    if (blockIdx.x == 0) for (int i = threadIdx.x; i < 3456; i += 512) __hip_atomic_store((unsigned*)(P.ws + OFF_CTL) + i, 0u, __ATOMIC_RELAXED, __HIP_MEMORY_SCOPE_AGENT);
    grid.sync();
    if (threadIdx.x == 0) (void)xb_add((unsigned*)(P.ws + OFF_CTL) + XB_XCNT(xb_xcc_id()), 1u);

#ifdef LDSP
    {
        LAS unsigned long long* PL = (LAS unsigned long long*)(lds + 143360);
        if (threadIdx.x == 0) { const unsigned long long* src = (const unsigned long long*)&P;
#pragma unroll
            for (int i = 0; i < 26; ++i) PL[i] = src[i]; }
        __syncthreads();
    }
#endif
#ifdef LDSP
#define PF(i) ((const float*)ldp(lds, (i)))
#else
#define PF(i) (((const float* const*)&P)[(i)])
#endif
#ifdef LDSP
#define WSP ((unsigned char*)ldp(lds, 25))
#else
#define WSP (P.ws)
#endif
#define XF ((float*)(WSP + OFF_XF))
#define XB ((bf16_t*)(WSP + OFF_XB))
#define PB ((bf16_t*)(WSP + OFF_PB))
#define PLEB ((bf16_t*)(WSP + OFF_PLE))
#define HB ((bf16_t*)(WSP + OFF_H))
#define ACTB ((bf16_t*)(WSP + OFF_ACT))
#define OB ((bf16_t*)(WSP + OFF_O))
#define KTT ((bf16_t*)(WSP + OFF_KTT))
#define SEL ((int*)(WSP + OFF_SEL))
#define XA ((float*)(WSP + OFF_XA))
#define SSQ ((float*)(WSP + OFF_SSQ))
#define DL ((float*)(WSP + OFF_DL))
#define KIN ((bf16_t*)(WSP + OFF_KIN))
#define WB ((bf16_t*)(WSP + OFF_W))
#define QKVR ((bf16_t*)(WSP + OFF_QKVR))
#define BP ((bf16_t*)(WSP + OFF_BP))
#define UT ((float*)(WSP + OFF_UT))
#define KT ((bf16_t*)(WSP + OFF_KT))
#define AP PLEB
#define STB ((float*)(WSP + OFF_ST))
#define PPB ((bf16_t*)(WSP + OFF_PP))


    for (int rep = 0; rep < REPN(12); ++rep) {
        IDX_SETUP
        LAS unsigned* scr = (LAS unsigned*)(lds + wid * 16384);
        if (EN(12)) {
#pragma unroll 1
        for (int j = 0; j < 2; ++j) {
            TJOB(PF(2) + (size_t)j * D * GLA_N, D, GLA_N, WB + W_GIN + (size_t)j * GLA_N * D, 0);
            TJOB(PF(7) + (size_t)j * D * D, D, D, WB + W_GO + (size_t)j * D * D, 0);
        }
#pragma unroll 1
        for (int g = 0; g < 4; ++g) TJOB(PF(8) + (size_t)g * 512 * 512, 512, 512, WB + W_POOL, g * 512);
        TJOB(PF(10), D, DSA_N, WB + W_DIN, 0);
        TJOB(PF(13), D, D, WB + W_DO, 0);
#pragma unroll 1
        for (int i = 0; i < 4; ++i) {
            TJOB(PF(16) + (size_t)i * D * NUP, D, NUP, WB + W_UP + (size_t)i * NUP * D, 0);
            TJOB(PF(19) + (size_t)i * DFF * D, DFF, D, WB + W_DOWN + (size_t)i * D * DFF, 0);
            TJOB(PF(20) + (size_t)i * D * D, D, D, WB + W_GATE + (size_t)i * D * D, 0);
            TJOB(PF(21) + (size_t)i * PLE * D, PLE, D, WB + W_PROJ + (size_t)i * D * PLE, 0);
        }
        }
        if (EN(13)) row_pass(PF(0), nullptr, nullptr, nullptr, XB, nullptr, widk);
        for (size_t i = (size_t)gt; i < (size_t)4 * T * PLE / 4; i += (size_t)NT) { const f32x4 v = __builtin_nontemporal_load(((const f32x4*)PF(1)) + i); u32x2 w; w.x = cvt_pk_bf16(v.x, v.y); w.y = cvt_pk_bf16(v.z, v.w); ((u32x2*)PB)[i] = w; }
    }
    GSYNC();

#pragma unroll 1
    for (int layer = 0; layer < 4; ++layer) {
        const int kind = layer % 3, jl = layer / 3;
        const float* xsrc = (layer == 0) ? PF(0) : XF;
        if (kind != 1) {
            if (kind == 0) for (int rep = 0; rep < REPN(21); ++rep) xa_pass(XB, PF(3) + (size_t)jl * D * 16, XA, widk);
            const int N = (kind == 0) ? GLA_N : DSA_NP;
            pg8::PlainSched S; S.o.init(T / 256, N / 256, G, c); S.A = (const char*)XB; S.B = (const char*)(kind == 0 ? WB + W_GIN + (size_t)jl * GLA_N * D : WB + W_DIN);
            S.tsA = (size_t)256 * D * 2; S.tsB = (size_t)256 * D * 2; S.poolmode = 0;
            pg8::EpiBf16<0> E{HB, N};
            for (int rep = 0; rep < REPN(14); ++rep) pg8::gemm_phase(lds, D, D, D, S, E, widk);
            GSYNC();
        }
        if (kind == 0) {
            for (int rep = 0; rep < REPN(0); ++rep) gla_prep(QKVR, XA, PF(4) + (size_t)jl * 16 * 1024, PF(5) + (size_t)jl * 1024, AP, KT, KTT, DL, lds, widk);
            for (int rep = 0; rep < REPN(1); ++rep) gla_vt(QKVR, BP, lds, widk);
            { IDX_SETUP for (int i = gt; i < T * 4; i += NT) SSQ[i] = 0.f; }
            GSYNC();
            for (int rep = 0; rep < REPN(2); ++rep) { GlaScoreSched S{G, c, AP, KT}; GlaScoreEpi E{AP}; pg8::gemm_phase(lds, 256, 2048, 1024, S, E, widk); }
            for (int rep = 0; rep < REPN(3); ++rep) { GlaUSched S{G, c, BP, KTT}; GlaUEpi E{UT, DL}; pg8::gemm_phase(lds, 256, 512, SEQ, S, E, widk); }
            GSYNC();
            for (int rep = 0; rep < REPN(4); ++rep) gla_scan(UT, DL, BP, widk);
            GSYNC();
            if (EN(5)) { GlaOSched S{G, c, AP, BP}; GlaOEpi E{OB, SSQ}; pg8::gemm_phase(lds, 512, 2048, 512, S, E, widk); }
            GSYNC();
            if (EN(6)) gla_gate(OB, SSQ, QKVR, PF(6) + (size_t)jl * D, widk);
            GSYNC();
        } else if (kind == 1) {
            for (int rep = 0; rep < REPN(7); ++rep) pool_pass(XB, OB, widk);
            GSYNC();
        } else {
            for (int rep = 0; rep < REPN(8); ++rep) dsa_kin(HB, PF(11), PF(12), KIN, widk);
            GSYNC();
            for (int rep = 0; rep < REPN(9); ++rep) dsa_topk(HB, KIN, SEL, lds, widk);
            GSYNC();
            for (int rep = 0; rep < REPN(10); ++rep) dsa_attn(HB, SEL, OB, lds, widk);
            GSYNC();
        }
        {
            pg8::PlainSched S; S.o.init(T / 256, D / 256, G, c); S.A = (const char*)OB;
            S.B = (const char*)(kind == 0 ? WB + W_GO + (size_t)jl * D * D : kind == 1 ? WB + W_POOL : WB + W_DO);
            const int K = (kind == 1) ? 512 : D;
            S.tsA = (size_t)256 * D * 2; S.tsB = (size_t)256 * K * 2; S.poolmode = (kind == 1);
            pg8::EpiResidT<4> E{xsrc, XF, (kind == 1) ? PF(9) : nullptr, nullptr, nullptr, (layer == 0) ? nullptr : STB, PF(22) + (size_t)(layer - 1) * D, PF(23) + (size_t)(layer - 1) * D};
            if (REPN(15) > 1) { pg8::EpiResid E2{xsrc, (float*)HB, (kind == 1) ? PF(9) : nullptr, nullptr, nullptr, (layer == 0) ? nullptr : STB, PF(22) + (size_t)(layer - 1) * D, PF(23) + (size_t)(layer - 1) * D}; pg8::gemm_phase(lds, K, D, K, S, E2, widk); }
            if (EN(15)) pg8::gemm_phase(lds, K, D, K, S, E, widk);
        }
        GSYNC();
        if (EN(13)) row_pass(XF, PF(14) + (size_t)layer * D, PF(15) + (size_t)layer * D, nullptr, XB, STB, widk);
        if (REPN(13) > 1) row_pass(XF, PF(14) + (size_t)layer * D, PF(15) + (size_t)layer * D, (float*)HB, OB, nullptr, widk);
        GSYNC();
#pragma unroll 1
        for (int gi = 0; gi < 2; ++gi) {
            const int N = gi == 0 ? NUP : D;
            pg8::PlainSched S; S.o.init(T / 256, N / 256, G, c); S.A = (const char*)XB;
            S.B = (const char*)(gi == 0 ? WB + W_UP + (size_t)layer * NUP * D : WB + W_GATE + (size_t)layer * D * D);
            S.tsA = (size_t)256 * D * 2; S.tsB = (size_t)256 * D * 2; S.poolmode = 0;
            if (gi == 0) { pg8::EpiBf16<0, true> E{HB, NUP}; for (int rep = 0; rep < REPN(16); ++rep) pg8::gemm_phase(lds, D, D, D, S, E, widk); }
            else { pg8::EpiBf16<2> E{PLEB, D}; for (int rep = 0; rep < REPN(17); ++rep) pg8::gemm_phase(lds, D, D, D, S, E, widk); }
        }
        {
            pg8::PlainSched S; S.o.init(T / 256, D / 256, G, c); S.A = (const char*)(PB + (size_t)layer * T * PLE); S.B = (const char*)(WB + W_PROJ + (size_t)layer * D * PLE);
            S.tsA = (size_t)256 * PLE * 2; S.tsB = (size_t)256 * PLE * 2; S.poolmode = 0;
            pg8::EpiBf16<0> E{PPB, D};
            for (int rep = 0; rep < REPN(18); ++rep) pg8::gemm_phase(lds, PLE, PLE, PLE, S, E, widk);
        }
        GSYNC();
        for (int rep = 0; rep < REPN(11); ++rep) conv_pass(HB, PF(17) + (size_t)layer * 3 * NUP, PF(18) + (size_t)layer * NUP, ACTB, widk);
        GSYNC();
        {
            pg8::PlainSched S; S.o.init(T / 256, D / 256, G, c); S.A = (const char*)ACTB; S.B = (const char*)(WB + W_DOWN + (size_t)layer * D * DFF);
            S.tsA = (size_t)256 * DFF * 2; S.tsB = (size_t)256 * DFF * 2; S.poolmode = 0;
            pg8::EpiResid E{XF, XF, nullptr, PLEB, PPB, STB, PF(14) + (size_t)layer * D, PF(15) + (size_t)layer * D};
            if (REPN(19) > 1) { pg8::EpiResid E2{XF, (float*)HB, nullptr, PLEB, PPB, STB, PF(14) + (size_t)layer * D, PF(15) + (size_t)layer * D}; pg8::gemm_phase(lds, DFF, DFF, DFF, S, E2, widk); }
            if (EN(19)) pg8::gemm_phase(lds, DFF, DFF, DFF, S, E, widk);
        }
        GSYNC();
        if (!EN(13)) {} else if (layer == 3) row_pass(XF, PF(22) + (size_t)layer * D, PF(23) + (size_t)layer * D, ((float*)PF(24)), nullptr, nullptr, widk);
        else row_pass(XF, PF(22) + (size_t)layer * D, PF(23) + (size_t)layer * D, nullptr, XB, STB, widk);
        if (layer != 3) GSYNC();
    }
}

extern "C" void kernel_launch(void* const* d_in, const int* in_sizes, int n_in, void* d_out, int out_size, void* d_ws, size_t ws_size, hipStream_t stream) {
    static int grid = 0;
    if (grid == 0) {
        if (n_in != 24 || out_size != T * D || ws_size < WS_END) { fprintf(stderr, "kernel_launch: unexpected problem (n_in %d, out %d, ws %zu < %zu)\n", n_in, out_size, ws_size, (size_t)WS_END); grid = -1; return; }
        int dev = 0, cus = 0, per_cu = 0;
        (void)hipGetDevice(&dev); (void)hipDeviceGetAttribute(&cus, hipDeviceAttributeMultiprocessorCount, dev);
        if (hipFuncSetAttribute((const void*)mega_fwd, hipFuncAttributeMaxDynamicSharedMemorySize, LDS_BYTES) != hipSuccess) { fprintf(stderr, "kernel_launch: hipFuncSetAttribute failed\n"); grid = -1; return; }
        if (hipOccupancyMaxActiveBlocksPerMultiprocessor(&per_cu, (const void*)mega_fwd, 512, LDS_BYTES) != hipSuccess || per_cu < 1) { fprintf(stderr, "kernel_launch: occupancy query says %d blocks/CU\n", per_cu); per_cu = 1; }
        (void)hipGetLastError();
        grid = cus;
    }
    if (grid < 0) return;
    Params p{};
    const float** pf = (const float**)&p;
    for (int i = 0; i < 24; ++i) pf[i] = (const float*)d_in[i];
    p.out = (float*)d_out; p.ws = (unsigned char*)d_ws;
    void* args[] = {&p};
    hipError_t e = hipLaunchCooperativeKernel((const void*)mega_fwd, dim3(grid), dim3(512), args, LDS_BYTES, stream);
    if (e != hipSuccess) fprintf(stderr, "kernel_launch: cooperative launch failed: %s (grid %d)\n", hipGetErrorString(e), grid);
}
```

```cpp
#include <hip/hip_runtime.h>
#include <hip/hip_cooperative_groups.h>
#include <cstdio>
namespace cg = cooperative_groups;

#define LAS __attribute__((address_space(3)))
typedef unsigned short bf16_t;
typedef short bf16x8 __attribute__((ext_vector_type(8)));
typedef float f32x4 __attribute__((ext_vector_type(4)));
typedef float f32x2 __attribute__((ext_vector_type(2)));
typedef unsigned u32x4 __attribute__((ext_vector_type(4)));
typedef unsigned u32x2 __attribute__((ext_vector_type(2)));

constexpr int T = 16384, SEQ = 8192, D = 2048, DFF = 5504, NUP = 11008, PLE = 256;
constexpr int GLA_N = 6144, DSA_N = 4176, DSA_NP = 4352;
constexpr float LN_EPS = 1e-5f;
constexpr float ALPHA = 1.681792830507429f;

constexpr size_t OFF_XF = 0;
constexpr size_t OFF_XB = OFF_XF + (size_t)T * D * 4;
constexpr size_t OFF_PB = OFF_XB + (size_t)T * D * 2;
constexpr size_t OFF_PLE = OFF_PB + (size_t)4 * T * PLE * 2;
constexpr size_t OFF_H = OFF_PLE + (size_t)T * D * 2;
constexpr size_t OFF_ACT = OFF_H + (size_t)T * NUP * 2;
constexpr size_t OFF_O = OFF_ACT + (size_t)T * DFF * 2;
constexpr size_t OFF_KTT = OFF_O + (size_t)T * D * 2;
constexpr size_t OFF_SEL = OFF_KTT + (size_t)T * 1024 * 2;
constexpr size_t OFF_XA = OFF_SEL + (size_t)T * 256 * 4;
constexpr size_t OFF_SSQ = OFF_XA + (size_t)T * 16 * 4;
constexpr size_t OFF_DL = OFF_SSQ + (size_t)T * 4 * 4;
constexpr size_t OFF_KIN = OFF_DL + (size_t)8 * 32 * 256 * 4;
constexpr size_t OFF_PP = OFF_KIN + (size_t)T * 64 * 2;
constexpr size_t OFF_CTL = OFF_PP + (size_t)T * D * 2;
constexpr size_t CTL_BYTES = 65536;
constexpr size_t OFF_ST = OFF_CTL + CTL_BYTES;
constexpr size_t OFF_W = OFF_ST + (size_t)T * 8;
constexpr size_t W_GIN = 0;
constexpr size_t W_GO = W_GIN + (size_t)2 * GLA_N * D;
constexpr size_t W_POOL = W_GO + (size_t)2 * D * D;
constexpr size_t W_DIN = W_POOL + (size_t)D * 512;
constexpr size_t W_DO = W_DIN + (size_t)DSA_NP * D;
constexpr size_t W_UP = W_DO + (size_t)D * D;
constexpr size_t W_DOWN = W_UP + (size_t)4 * NUP * D;
constexpr size_t W_GATE = W_DOWN + (size_t)4 * D * DFF;
constexpr size_t W_PROJ = W_GATE + (size_t)4 * D * D;
constexpr size_t W_END = W_PROJ + (size_t)4 * D * PLE;
constexpr size_t WS_END = OFF_W + W_END * 2;
constexpr size_t OFF_QKVR = OFF_H;
constexpr size_t OFF_BP = OFF_H + (size_t)T * GLA_N * 2;
constexpr size_t OFF_UT = OFF_ACT;
constexpr size_t OFF_KT = OFF_ACT + (size_t)8 * 32 * 512 * 256 * 4;
static_assert(OFF_BP + (size_t)8 * 32 * 512 * 512 * 2 <= OFF_ACT, "GLA overlay 1");
static_assert(OFF_KT + (size_t)T * 1024 * 2 <= OFF_O, "GLA overlay 2");

constexpr int LDS_BYTES = 147456;
constexpr int LDS_BAR_OFF = LDS_BYTES - 64;

__device__ __forceinline__ float bf2f(unsigned short b) { return __uint_as_float(((unsigned)b) << 16); }
__device__ __forceinline__ unsigned f2bf(float f) { unsigned u = __float_as_uint(f); return (u + 0x7fffu + ((u >> 16) & 1u)) >> 16; }
__device__ __forceinline__ unsigned cvt_pk_bf16(float lo, float hi) { unsigned r; asm volatile("v_cvt_pk_bf16_f32 %0, %1, %2" : "=v"(r) : "v"(lo), "v"(hi)); return r; }
__device__ __forceinline__ float lo16(unsigned w) { return __uint_as_float(w << 16); }
__device__ __forceinline__ float hi16(unsigned w) { return __uint_as_float(w & 0xffff0000u); }
__device__ __forceinline__ float shx(float v, int m, int lane) { return __int_as_float(__builtin_amdgcn_ds_bpermute((lane ^ m) << 2, __float_as_int(v))); }
__device__ __forceinline__ int shi(int v, int src) { return __builtin_amdgcn_ds_bpermute(src << 2, v); }
__device__ __forceinline__ float wave_sum(float v, int lane) {
#pragma unroll
    for (int o = 1; o < 64; o <<= 1) v += shx(v, o, lane);
    return v;
}
__device__ __forceinline__ f32x2 gelu_pk(f32x2 v) {
    const f32x2 av = __builtin_elementwise_abs(v), d = av * 0.2316418882f + 1.0f;
    f32x2 t; t.x = __builtin_amdgcn_rcpf(d.x); t.y = __builtin_amdgcn_rcpf(d.y);
    f32x2 q = t * 0.5307027145f + (-0.7265760135f); q = q * t + 0.7107068705f; q = q * t + (-0.142248368f); q = q * t + 0.127414796f; q = q * t;
    const f32x2 s = (v * v) * (-0.72134752044f);
    f32x2 e; e.x = __builtin_amdgcn_exp2f(s.x); e.y = __builtin_amdgcn_exp2f(s.y);
    const f32x2 m = v * (q * e), r = v - m;
    f32x2 o; o.x = v.x < 0.f ? m.x : r.x; o.y = v.y < 0.f ? m.y : r.y; return o;
}
__device__ __forceinline__ float sigmoidf_(float x) { return 1.0f / (1.0f + __expf(-x)); }

__device__ __forceinline__ int lane_asm() { int l; asm volatile("v_mbcnt_lo_u32_b32 %0, -1, 0\n\tv_mbcnt_hi_u32_b32 %0, -1, %0" : "=&v"(l)); return l; }
__device__ __forceinline__ int opaque_tid(int widk) { asm volatile("" : "+s"(widk)); int l; asm volatile("v_mbcnt_lo_u32_b32 %0, -1, 0\n\tv_mbcnt_hi_u32_b32 %0, -1, %0" : "=&v"(l)); return (widk << 6) | l; }
__device__ __forceinline__ int opaque_s(int v) { v = __builtin_amdgcn_readfirstlane(v); asm volatile("" : "+s"(v)); return v; }
#define IDX_SETUP const int tid = opaque_tid(widk), lane = tid & 63, wid = __builtin_amdgcn_readfirstlane(tid >> 6); const int G = opaque_s(gridDim.x), c = opaque_s(blockIdx.x); \
    const int gw = c * 8 + wid, NGW = G * 8, gt = c * 512 + tid, NT = G * 512; (void)lane; (void)wid; (void)gw; (void)NGW; (void)gt; (void)NT;
namespace pg8 {
constexpr int BM = 256, BK = 64, HALF = 128, HTB = HALF * BK * 2, NXCD = 8, WGM = 4;
__host__ __device__ __forceinline__ int lds_byte(int r, int c) { const int st = (r >> 4) * 2 + (c >> 5), rr = r & 15, cc = c & 31, ob = rr * 64 + cc * 2; return st * 1024 + (ob ^ (((ob >> 9) & 1) << 5)); }
__host__ __device__ __forceinline__ void stage_rc(int b, int& R, int& C) { const int st = b / 1024, sb = b % 1024, swz = sb ^ (((sb >> 9) & 1) << 5); R = (st >> 1) * 16 + swz / 64; C = (st & 1) * 32 + (swz % 64) / 2; }
__host__ __device__ __forceinline__ int perm32(int rho) { const int n = rho >> 4, i = rho & 15; return 8 * (i >> 2) + 4 * n + (i & 3); }

struct Unit { int pm, pn; const char* A; const char* B; };

struct TileOrder {
    int nM, nN, nwg, G, c;
    __device__ __forceinline__ void init(int nM_, int nN_, int G_, int c_) { nM = nM_; nN = nN_; nwg = nM * nN; G = G_; c = c_; }
    __device__ __forceinline__ bool next(int i, int& pm, int& pn) const {
        const long L = (long)i * G + c; if (L >= nwg) return false;
        int wgid = (int)L; { const int q = nwg / NXCD, r = nwg % NXCD, xcd = wgid % NXCD, off = wgid / NXCD; wgid = (xcd < r ? xcd * (q + 1) : r * (q + 1) + (xcd - r) * q) + off; }
        const int nig = WGM * nN, gid = wgid / nig, fm = gid * WGM, gsz = (nM - fm) < WGM ? (nM - fm) : WGM;
        pm = fm + ((wgid % nig) % gsz); pn = (wgid % nig) / gsz; return true;
    }
};
struct PlainSched {
    TileOrder o; const char* A; const char* B; size_t tsA, tsB; int poolmode;
    __device__ __forceinline__ bool next(int i, Unit& u) const {
        if (!o.next(i, u.pm, u.pn)) return false;
        u.A = A + (size_t)u.pm * tsA + (poolmode ? (size_t)(u.pn >> 1) * 1024 : 0); u.B = B + (size_t)u.pn * tsB; return true;
    }
};

template <int ACT  , bool NT = false  > struct EpiBf16 {
    static constexpr bool PERM = true;
    bf16_t* O; int ldc;
    __device__ __forceinline__ void operator()(const f32x4 (&acc)[2][2][4][2], const Unit& u, int wr, int wc, int fr, int fq) const {
        const int lane = lane_asm(); fr = lane & 15; fq = lane >> 4; (void)lane;
        const int row0 = u.pm * BM + wr * 64 + fr, col0 = u.pn * BM + wc * 32 + 8 * fq;
#pragma unroll
        for (int ai = 0; ai < 2; ++ai)
#pragma unroll
            for (int m = 0; m < 4; ++m) { bf16_t* rowp = O + (size_t)(row0 + ai * HALF + m * 16) * ldc + col0;
#pragma unroll
                for (int bj = 0; bj < 2; ++bj) { f32x4 v0 = acc[ai][bj][m][0], v1 = acc[ai][bj][m][1];
                    if (ACT == 2) {
#pragma unroll
                        for (int j = 0; j < 4; ++j) { v0[j] = sigmoidf_(v0[j]); v1[j] = sigmoidf_(v1[j]); } }
                    u32x4 w; w.x = cvt_pk_bf16(v0[0], v0[1]); w.y = cvt_pk_bf16(v0[2], v0[3]); w.z = cvt_pk_bf16(v1[0], v1[1]); w.w = cvt_pk_bf16(v1[2], v1[3]);
                    if (NT) __builtin_nontemporal_store(w, (u32x4*)(rowp + bj * HALF)); else *(u32x4*)(rowp + bj * HALF) = w; } }
    }
};
struct EpiPleMul {
    static constexpr bool PERM = true;
    bf16_t* O; int ldc;
    __device__ __forceinline__ void operator()(const f32x4 (&acc)[2][2][4][2], const Unit& u, int wr, int wc, int fr, int fq) const {
        const int lane = lane_asm(); fr = lane & 15; fq = lane >> 4; (void)lane;
        const int row0 = u.pm * BM + wr * 64 + fr, col0 = u.pn * BM + wc * 32 + 8 * fq;
#pragma unroll
        for (int ai = 0; ai < 2; ++ai)
#pragma unroll
            for (int m = 0; m < 4; ++m) { bf16_t* rowp = O + (size_t)(row0 + ai * HALF + m * 16) * ldc + col0;
#pragma unroll
                for (int bj = 0; bj < 2; ++bj) { const f32x4 v0 = acc[ai][bj][m][0], v1 = acc[ai][bj][m][1];
                    const u32x4 g = *(const u32x4*)(rowp + bj * HALF);
                    u32x4 w; w.x = cvt_pk_bf16(v0[0] * lo16(g.x), v0[1] * hi16(g.x)); w.y = cvt_pk_bf16(v0[2] * lo16(g.y), v0[3] * hi16(g.y));
                    w.z = cvt_pk_bf16(v1[0] * lo16(g.z), v1[1] * hi16(g.z)); w.w = cvt_pk_bf16(v1[2] * lo16(g.w), v1[3] * hi16(g.w));
                    *(u32x4*)(rowp + bj * HALF) = w; }
                asm volatile("" ::: "memory"); }
    }
};
template <int NB  > struct EpiResidT {
    static constexpr bool PERM = false;
    const float* src; float* dst; const float* cscale; const bf16_t* ple; const bf16_t* ple2;
    const float* st; const float* lg; const float* lb;
    __device__ __forceinline__ void operator()(const f32x4 (&acc)[2][2][4][2], const Unit& u, int wr, int wc, int fr, int fq) const {
        const int lane = lane_asm(); fr = lane & 15; fq = lane >> 4; (void)lane;
        const int row0 = u.pm * BM + wr * 64 + fr, col0 = u.pn * BM + wc * 32 + 4 * fq;
#pragma unroll
        for (int ai = 0; ai < 2; ++ai)
#pragma unroll
            for (int mp = 0; mp < 4 / NB; ++mp) {
                f32x4 sv[NB][2][2]; u32x2 pv[NB][2][2], qv[NB][2][2]; f32x2 sr[NB];
#pragma unroll
                for (int mm = 0; mm < NB; ++mm) { const int m = NB * mp + mm; const size_t rr = (size_t)(row0 + ai * HALF + m * 16), off = rr * D + col0;
                    sr[mm] = (f32x2){0.f, 1.f}; if (st) sr[mm] = *(const f32x2*)(st + 2 * rr);
#pragma unroll
                    for (int bj = 0; bj < 2; ++bj)
#pragma unroll
                        for (int n = 0; n < 2; ++n) { const size_t o2 = off + bj * HALF + n * 16; sv[mm][bj][n] = *(const f32x4*)(src + o2);
                            if (NB == 2 && ple) { pv[mm][bj][n] = *(const u32x2*)(ple + o2); qv[mm][bj][n] = *(const u32x2*)(ple2 + o2); } } }
#pragma unroll
                for (int mm = 0; mm < NB; ++mm) { const int m = NB * mp + mm; const size_t off = (size_t)(row0 + ai * HALF + m * 16) * D + col0;
#pragma unroll
                    for (int bj = 0; bj < 2; ++bj)
#pragma unroll
                        for (int n = 0; n < 2; ++n) { const size_t o2 = off + bj * HALF + n * 16; f32x4 a = acc[ai][bj][m][n];
                            if (cscale) a = a * *(const f32x4*)(cscale + col0 + bj * HALF + n * 16);
                            if (NB == 2 && ple) { const u32x2 pw = pv[mm][bj][n], qw = qv[mm][bj][n];
                                a = a + (f32x4){lo16(pw.x) * lo16(qw.x), hi16(pw.x) * hi16(qw.x), lo16(pw.y) * lo16(qw.y), hi16(pw.y) * hi16(qw.y)}; }
                            f32x4 sx = sv[mm][bj][n];
                            if (st) sx = (sx - sr[mm].x) * sr[mm].y * *(const f32x4*)(lg + col0 + bj * HALF + n * 16) + *(const f32x4*)(lb + col0 + bj * HALF + n * 16);
                            *(f32x4*)(dst + o2) = sx * ALPHA + a; } }
                asm volatile("" ::: "memory");
            }
    }
};

typedef EpiResidT<2> EpiResid;

template <class Epi, class Sched>
__device__ __forceinline__ void gemm_phase(LAS unsigned char* lds, const int K, const int lda, const int ldb, const Sched& S, const Epi& E, int widk) {
    const int tid = opaque_tid(widk), wid = __builtin_amdgcn_readfirstlane(tid >> 6), lane = tid & 63, wr = wid >> 2, wc = wid & 3, fr = lane & 15, fq = lane >> 4;
    const int nt = K / BK;
    unsigned voffA[2], voffB[2];
#pragma unroll
    for (int i = 0; i < 2; ++i) { int R, C; stage_rc(tid * 16 + i * 8192, R, C); const int Rb = Epi::PERM ? ((R & ~31) + perm32(R & 31)) : R;
        voffA[i] = (unsigned)(R * lda + C) * 2u; voffB[i] = (unsigned)(Rb * ldb + C) * 2u; }
    const size_t kstep = (size_t)(BK * 2);
    const size_t hsA = (size_t)HALF * lda * 2, hsB = (size_t)HALF * ldb * 2;
    const unsigned ldsw = (unsigned)wid * 1024u;
    const int aoff = lds_byte(wr * 64 + fr, fq * 8), boff = lds_byte(wc * 32 + fr, fq * 8);
#define PG8_SA(b, h) (((b) * 2 + (h)) * HTB)
#define PG8_SB(b, h) ((4 + (b) * 2 + (h)) * HTB)
#define PG8_STAGE(bufoff, gbase, voff) do { _Pragma("unroll") for (int _i = 0; _i < 2; ++_i) \
        __builtin_amdgcn_global_load_lds((const unsigned*)((const char*)(gbase) + (voff)[_i]), (LAS unsigned*)(lds + (bufoff) + ldsw + _i * 8192), 16, 0, 0); } while (0)
#define PG8_LDA(dst, b, h) do { _Pragma("unroll") for (int m = 0; m < 4; ++m) _Pragma("unroll") for (int k = 0; k < 2; ++k) dst[m][k] = *(const LAS bf16x8*)(lds + PG8_SA(b, h) + aoff + m * 2048 + k * 1024); } while (0)
#define PG8_LDB(dst, b, h) do { _Pragma("unroll") for (int n = 0; n < 2; ++n) _Pragma("unroll") for (int k = 0; k < 2; ++k) dst[n][k] = *(const LAS bf16x8*)(lds + PG8_SB(b, h) + boff + n * 2048 + k * 1024); } while (0)
#define PG8_MMA(ai, bj, At, Bt) do { __builtin_amdgcn_s_setprio(1); _Pragma("unroll") for (int m = 0; m < 4; ++m) _Pragma("unroll") for (int n = 0; n < 2; ++n) _Pragma("unroll") for (int k = 0; k < 2; ++k) \
        acc[ai][bj][m][n] = __builtin_amdgcn_mfma_f32_16x16x32_bf16(Bt[n][k], At[m][k], acc[ai][bj][m][n], 0, 0, 0); __builtin_amdgcn_s_setprio(0); } while (0)
#define PG8_WAIT_V(n) asm volatile("s_waitcnt vmcnt(" #n ")" ::: "memory")
#define PG8_WAIT_L(n) asm volatile("s_waitcnt lgkmcnt(" #n ")" ::: "memory")
#define PG8_BAR __builtin_amdgcn_s_barrier()
#define PG8_SCHED __builtin_amdgcn_sched_barrier(0)
    Unit cur, nxt; int ui = 0;
    if (!S.next(0, cur)) return;
    f32x4 acc[2][2][4][2];
#pragma unroll
    for (int a = 0; a < 2; ++a)
#pragma unroll
        for (int b = 0; b < 2; ++b)
#pragma unroll
            for (int m = 0; m < 4; ++m)
#pragma unroll
                for (int n = 0; n < 2; ++n) acc[a][b][m][n] = (f32x4){0.f, 0.f, 0.f, 0.f};
    bf16x8 At[4][2], B0[2][2], B1[2][2];
    const char* cA = cur.A; const char* cB = cur.B;
    PG8_STAGE(PG8_SB(0, 0), cB, voffB); PG8_STAGE(PG8_SB(0, 1), cB + hsB, voffB); PG8_STAGE(PG8_SA(0, 0), cA, voffA); PG8_STAGE(PG8_SA(0, 1), cA + hsA, voffA);
    if (wr == 1) PG8_BAR;
    PG8_WAIT_V(2); PG8_BAR;
    PG8_STAGE(PG8_SB(1, 0), cB + kstep, voffB); PG8_STAGE(PG8_SA(1, 0), cA + kstep, voffA); PG8_STAGE(PG8_SB(1, 1), cB + hsB + kstep, voffB);
    PG8_WAIT_V(6); PG8_BAR;
    for (;;) {
        const bool has_next = S.next(ui + 1, nxt);
        const char* nA = has_next ? nxt.A : cA; const char* nB = has_next ? nxt.B : cB;
        for (int t = 0; t < nt; t += 2) {
            const bool last = (t == nt - 2);
            const char* a1 = cA + (size_t)(t + 1) * kstep;
            const char* a2 = last ? nA : cA + (size_t)(t + 2) * kstep; const char* b2 = last ? nB : cB + (size_t)(t + 2) * kstep;
            const char* a3 = a2 + kstep; const char* b3 = b2 + kstep;
            PG8_LDB(B0, 0, 0); PG8_LDB(B1, 0, 1); PG8_SCHED; PG8_LDA(At, 0, 0); PG8_STAGE(PG8_SA(1, 1), a1 + hsA, voffA);
            PG8_WAIT_V(8); PG8_WAIT_L(0); PG8_BAR; PG8_MMA(0, 0, At, B0); PG8_MMA(0, 1, At, B1); PG8_BAR; PG8_SCHED;
            PG8_LDA(At, 0, 1); PG8_STAGE(PG8_SB(0, 0), b2, voffB); PG8_STAGE(PG8_SB(0, 1), b2 + hsB, voffB); PG8_STAGE(PG8_SA(0, 0), a2, voffA);
            PG8_WAIT_V(8); PG8_WAIT_L(0); PG8_BAR; PG8_MMA(1, 0, At, B0); PG8_MMA(1, 1, At, B1); PG8_BAR; PG8_SCHED;
            PG8_LDB(B0, 1, 0); PG8_LDB(B1, 1, 1); PG8_SCHED; PG8_LDA(At, 1, 0); PG8_STAGE(PG8_SA(0, 1), a2 + hsA, voffA);
            PG8_WAIT_V(8); PG8_WAIT_L(0); PG8_BAR; PG8_MMA(0, 0, At, B0); PG8_MMA(0, 1, At, B1); PG8_BAR; PG8_SCHED;
            PG8_LDA(At, 1, 1); PG8_STAGE(PG8_SB(1, 0), b3, voffB); PG8_STAGE(PG8_SB(1, 1), b3 + hsB, voffB); PG8_STAGE(PG8_SA(1, 0), a3, voffA);
            PG8_WAIT_V(8); PG8_WAIT_L(0); PG8_BAR; PG8_MMA(1, 0, At, B0); PG8_MMA(1, 1, At, B1); PG8_BAR; PG8_SCHED;
        }
        if (wr == 0) PG8_BAR;
        E(acc, cur, wr, wc, fr, fq);
        if (!has_next) break;
#pragma unroll
        for (int a = 0; a < 2; ++a)
#pragma unroll
            for (int b = 0; b < 2; ++b)
#pragma unroll
                for (int m = 0; m < 4; ++m)
#pragma unroll
                    for (int n = 0; n < 2; ++n) acc[a][b][m][n] = (f32x4){0.f, 0.f, 0.f, 0.f};
        cur = nxt; cA = nA; cB = nB; ++ui;
        if (wr == 1) PG8_BAR;
    }
    PG8_WAIT_V(0);
    PG8_BAR;
#undef PG8_SA
#undef PG8_SB
#undef PG8_STAGE
#undef PG8_LDA
#undef PG8_LDB
#undef PG8_MMA
#undef PG8_WAIT_V
#undef PG8_WAIT_L
#undef PG8_BAR
#undef PG8_SCHED
}
}

struct GlaScoreSched {
    int G, c; const bf16_t* AP; const bf16_t* KT;
    __device__ __forceinline__ bool next(int i, pg8::Unit& u) const {
        const int idx = c + i * G; if (idx >= 256) return false;
        const int bh = idx >> 5, sc = idx & 31, b = bh >> 2, h = bh & 3; const size_t tok0 = (size_t)b * SEQ + sc * 256;
        u.pm = idx; u.pn = 0; u.A = (const char*)(AP + tok0 * 2048 + h * 512); u.B = (const char*)(KT + tok0 * 1024 + h * 256); return true;
    }
};
struct GlaScoreEpi {
    static constexpr bool PERM = true;
    bf16_t* AP;
    __device__ __forceinline__ void operator()(const f32x4 (&acc)[2][2][4][2], const pg8::Unit& u, int wr, int wc, int fr, int fq) const {
        const int lane = lane_asm(); fr = lane & 15; fq = lane >> 4; (void)lane;
        const int idx = u.pm, bh = idx >> 5, sc = idx & 31, b = bh >> 2, h = bh & 3; const size_t tok0 = (size_t)b * SEQ + sc * 256;
#pragma unroll
        for (int ai = 0; ai < 2; ++ai)
#pragma unroll
            for (int m = 0; m < 4; ++m) { const int r = ai * 128 + wr * 64 + m * 16 + fr; bf16_t* rowp = AP + (tok0 + r) * 2048 + h * 512 + 256;
#pragma unroll
                for (int bj = 0; bj < 2; ++bj) { const int c0 = bj * 128 + wc * 32 + 8 * fq; f32x4 v0 = acc[ai][bj][m][0], v1 = acc[ai][bj][m][1];
#pragma unroll
                    for (int j = 0; j < 4; ++j) { if (c0 + j > r) v0[j] = 0.f; if (c0 + 4 + j > r) v1[j] = 0.f; }
                    u32x4 w; w.x = cvt_pk_bf16(v0[0], v0[1]); w.y = cvt_pk_bf16(v0[2], v0[3]); w.z = cvt_pk_bf16(v1[0], v1[1]); w.w = cvt_pk_bf16(v1[2], v1[3]);
                    *(u32x4*)(rowp + c0) = w; } }
    }
};
struct GlaUSched {
    int G, c; const bf16_t* BP; const bf16_t* KTT;
    __device__ __forceinline__ bool next(int i, pg8::Unit& u) const {
        const int idx = c + i * G; if (idx >= 512) return false;
        const int bhsc = idx >> 1, mt = idx & 1, bh = bhsc >> 5, sc = bhsc & 31;
        u.pm = idx; u.pn = 0; u.A = (const char*)(BP + ((size_t)bhsc * 512 + mt * 256) * 512 + 256); u.B = (const char*)(KTT + (size_t)bh * 256 * SEQ + sc * 256); return true;
    }
};
struct GlaUEpi {
    static constexpr bool PERM = false;
    float* UT; const float* DL;
    __device__ __forceinline__ void operator()(const f32x4 (&acc)[2][2][4][2], const pg8::Unit& u, int wr, int wc, int fr, int fq) const {
        const int lane = lane_asm(); fr = lane & 15; fq = lane >> 4; (void)lane;
        const int idx = u.pm, bhsc = idx >> 1, mt = idx & 1; const float* dl = DL + (size_t)bhsc * 256;
#pragma unroll
        for (int ai = 0; ai < 2; ++ai)
#pragma unroll
            for (int m = 0; m < 4; ++m) { const int r = mt * 256 + ai * 128 + wr * 64 + m * 16 + fr; float* rowp = UT + ((size_t)bhsc * 512 + r) * 256;
#pragma unroll
                for (int bj = 0; bj < 2; ++bj)
#pragma unroll
                    for (int n = 0; n < 2; ++n) { const int c0 = bj * 128 + wc * 32 + n * 16 + 4 * fq; *(f32x4*)(rowp + c0) = acc[ai][bj][m][n] * *(const f32x4*)(dl + c0); } }
    }
};
struct GlaOSched {
    int G, c; const bf16_t* AP; const bf16_t* BP;
    __device__ __forceinline__ bool next(int i, pg8::Unit& u) const {
        const int idx = c + i * G; if (idx >= 512) return false;
        const int bhsc = idx >> 1, nt = idx & 1, bh = bhsc >> 5, sc = bhsc & 31, b = bh >> 2, h = bh & 3; const size_t tok0 = (size_t)b * SEQ + sc * 256;
        u.pm = idx; u.pn = 0; u.A = (const char*)(AP + tok0 * 2048 + h * 512); u.B = (const char*)(BP + ((size_t)bhsc * 512 + nt * 256) * 512); return true;
    }
};
struct GlaOEpi {
    static constexpr bool PERM = true;
    bf16_t* O; float* SSQ;
    __device__ __forceinline__ void operator()(const f32x4 (&acc)[2][2][4][2], const pg8::Unit& u, int wr, int wc, int fr, int fq) const {
        const int lane = lane_asm(); fr = lane & 15; fq = lane >> 4; (void)lane;
        const int idx = u.pm, bhsc = idx >> 1, nt = idx & 1, bh = bhsc >> 5, sc = bhsc & 31, b = bh >> 2, h = bh & 3; const size_t tok0 = (size_t)b * SEQ + sc * 256;
#pragma unroll
        for (int ai = 0; ai < 2; ++ai)
#pragma unroll
            for (int m = 0; m < 4; ++m) { const int r = ai * 128 + wr * 64 + m * 16 + fr; bf16_t* rowp = O + (tok0 + r) * 2048 + h * 512 + nt * 256; float ss = 0.f;
#pragma unroll
                for (int bj = 0; bj < 2; ++bj) { const int c0 = bj * 128 + wc * 32 + 8 * fq; const f32x4 v0 = acc[ai][bj][m][0], v1 = acc[ai][bj][m][1];
                    ss += (v0[0] * v0[0] + v0[1] * v0[1]) + (v0[2] * v0[2] + v0[3] * v0[3]) + (v1[0] * v1[0] + v1[1] * v1[1]) + (v1[2] * v1[2] + v1[3] * v1[3]);
                    u32x4 w; w.x = cvt_pk_bf16(v0[0], v0[1]); w.y = cvt_pk_bf16(v0[2], v0[3]); w.z = cvt_pk_bf16(v1[0], v1[1]); w.w = cvt_pk_bf16(v1[2], v1[3]);
                    *(u32x4*)(rowp + c0) = w; }
                ss += shx(ss, 16, lane); ss += shx(ss, 32, lane);
                if (fq == 0) atomicAdd(SSQ + (tok0 + r) * 4 + h, ss); }
    }
};

struct Params {
    const float *x, *p, *gla_w_in, *gla_w_a1, *gla_w_a2, *gla_b_a, *gla_norm_g, *gla_w_o, *pool_w, *pool_scale, *dsa_w_in, *dsa_kidx_g, *dsa_kidx_b, *dsa_w_o,
        *ln_mix_g, *ln_mix_b, *ffn_w_up, *ffn_conv_w, *ffn_conv_b, *ffn_w_down, *ple_gate_w, *ple_proj_w, *ln_ffn_g, *ln_ffn_b;
    float* out; unsigned char* ws;
};

__device__ __forceinline__ void transpose_item(const float* W, int K, int N, bf16_t* WT, int row_off, LAS unsigned* scr, int item, int lane) {
    const int nblk = (N + 63) / 64, kb = item / nblk, nb = item % nblk, k0 = 64 * kb, n0 = 64 * nb;
    const int nn = (lane & 15) * 4; const bool nok = (n0 + nn) < N;
#pragma unroll
    for (int i = 0; i < 8; ++i) { const int kk = 8 * i + 2 * (lane >> 4);
        f32x4 v0 = {0.f, 0.f, 0.f, 0.f}, v1 = v0;
        if (nok) { v0 = __builtin_nontemporal_load((const f32x4*)(W + (size_t)(k0 + kk) * N + n0 + nn)); v1 = __builtin_nontemporal_load((const f32x4*)(W + (size_t)(k0 + kk + 1) * N + n0 + nn)); }
#pragma unroll
        for (int j = 0; j < 4; ++j) scr[((nn + j) * 72 + kk) >> 1] = cvt_pk_bf16(v0[j], v1[j]); }
    asm volatile("s_waitcnt lgkmcnt(0)" ::: "memory");
#pragma unroll
    for (int j = 0; j < 8; ++j) { const int n = (lane >> 3) + 8 * j, ch = lane & 7;
        const u32x4 o = *(const LAS u32x4*)(scr + ((n * 72 + ch * 8) >> 1));
        __builtin_nontemporal_store(o, (u32x4*)(WT + (size_t)(row_off + n0 + n) * K + k0 + 8 * ch)); }
    asm volatile("s_waitcnt lgkmcnt(0)" ::: "memory");
}
#define TJOB(W, K, N, DST, ROWOFF) do { const int _ni = ((K) / 64) * (((N) + 63) / 64); for (int _it = gw; _it < _ni; _it += NGW) transpose_item((W), (K), (N), (DST), (ROWOFF), scr, _it, lane); } while (0)

__device__ __forceinline__ void row_pass(const float* src, const float* __restrict__ g, const float* __restrict__ b, float* dst32, bf16_t* __restrict__ dstb, float* __restrict__ stats, int widk) {
    IDX_SETUP
    f32x4 vn[8];
    if (gw < T) { const f32x4* xr = (const f32x4*)(src + (size_t)gw * D) + lane;
#pragma unroll
        for (int j = 0; j < 8; ++j) vn[j] = xr[64 * j]; }
    for (int r = gw; r < T; r += NGW) {
        f32x4 v[8];
#pragma unroll
        for (int j = 0; j < 8; ++j) v[j] = vn[j];
        if (r + NGW < T) { const f32x4* xr = (const f32x4*)(src + (size_t)(r + NGW) * D) + lane;
#pragma unroll
            for (int j = 0; j < 8; ++j) vn[j] = xr[64 * j]; }
        if (g) {
            float s = 0.f;
#pragma unroll
            for (int j = 0; j < 8; ++j) s += (v[j].x + v[j].y) + (v[j].z + v[j].w);
            const float mean = wave_sum(s, lane) * (1.f / D); float s2 = 0.f;
#pragma unroll
            for (int j = 0; j < 8; ++j) { v[j] = v[j] - mean; s2 += (v[j].x * v[j].x + v[j].y * v[j].y) + (v[j].z * v[j].z + v[j].w * v[j].w); }
            const float rstd = 1.0f / sqrtf(wave_sum(s2, lane) * (1.f / D) + LN_EPS);
            if (stats && lane == 0) *(f32x2*)(stats + 2 * (size_t)r) = (f32x2){mean, rstd};
#pragma unroll
            for (int j = 0; j < 8; ++j) { const f32x4 gg = ((const f32x4*)g)[lane + 64 * j], bb = ((const f32x4*)b)[lane + 64 * j]; v[j] = v[j] * rstd * gg + bb; }
        }
        if (dst32) { f32x4* o = (f32x4*)(dst32 + (size_t)r * D) + lane;
#pragma unroll
            for (int j = 0; j < 8; ++j) o[64 * j] = v[j]; }
        if (dstb) { u32x2* o = (u32x2*)(dstb + (size_t)r * D) + lane;
#pragma unroll
            for (int j = 0; j < 8; ++j) { u32x2 w; w.x = cvt_pk_bf16(v[j].x, v[j].y); w.y = cvt_pk_bf16(v[j].z, v[j].w); o[64 * j] = w; } }
    }
}

__device__ __forceinline__ void xa_pass(const bf16_t* srcb, const float* wa1, float* xa, int widk) {
    IDX_SETUP
    for (int r0 = gw * 4; r0 < T; r0 += NGW * 4) {
        f32x4 acc[4][4];
#pragma unroll
        for (int rr = 0; rr < 4; ++rr)
#pragma unroll
            for (int qd = 0; qd < 4; ++qd) acc[rr][qd] = (f32x4){0.f, 0.f, 0.f, 0.f};
#pragma unroll 2
        for (int i = 0; i < 32; ++i) { const int cc = lane + 64 * i; const f32x4* w = (const f32x4*)(wa1 + (size_t)cc * 16);
            const f32x4 w0 = w[0], w1 = w[1], w2 = w[2], w3 = w[3];
#pragma unroll
            for (int rr = 0; rr < 4; ++rr) { const float xv = bf2f(srcb[(size_t)(r0 + rr) * D + cc]);
                acc[rr][0] += w0 * xv; acc[rr][1] += w1 * xv; acc[rr][2] += w2 * xv; acc[rr][3] += w3 * xv; } }
        const bool b5 = (lane & 32) != 0, b4 = (lane & 16) != 0, b3 = (lane & 8) != 0, b2 = (lane & 4) != 0;
        const int idx = (b5 ? 8 : 0) + (b4 ? 4 : 0) + (b3 ? 2 : 0) + (b2 ? 1 : 0);
#pragma unroll
        for (int rr = 0; rr < 4; ++rr) {
            float k8[8], k4[4], k2[2];
#pragma unroll
            for (int j = 0; j < 8; ++j) { const float lo = acc[rr][j >> 2][j & 3], hi = acc[rr][2 + (j >> 2)][j & 3]; k8[j] = (b5 ? hi : lo) + shx(b5 ? lo : hi, 32, lane); }
#pragma unroll
            for (int j = 0; j < 4; ++j) k4[j] = (b4 ? k8[j + 4] : k8[j]) + shx(b4 ? k8[j] : k8[j + 4], 16, lane);
#pragma unroll
            for (int j = 0; j < 2; ++j) k2[j] = (b3 ? k4[j + 2] : k4[j]) + shx(b3 ? k4[j] : k4[j + 2], 8, lane);
            float k1 = (b2 ? k2[1] : k2[0]) + shx(b2 ? k2[0] : k2[1], 4, lane);
            k1 += shx(k1, 2, lane); k1 += shx(k1, 1, lane);
            if ((lane & 3) == 0) xa[(size_t)(r0 + rr) * 16 + idx] = k1;
        }
    }
}
__device__ __forceinline__ void conv_pass(const bf16_t* __restrict__ H, const float* __restrict__ cw, const float* __restrict__ cb, bf16_t* __restrict__ ACT, int widk) {
    IDX_SETUP
    constexpr int NCG = DFF / 8, NSEG = T / 32;
    for (int idx = gt; idx < NCG * NSEG; idx += NT) {
        const int cgi = idx % NCG, sg = idx / NCG, t0 = sg * 32, c0 = cgi * 8;
        f32x4 wg[3][2], wu[3][2], bg[2], bu[2];
#pragma unroll
        for (int j = 0; j < 3; ++j)
#pragma unroll
            for (int q = 0; q < 2; ++q) { wg[j][q] = *(const f32x4*)(cw + (size_t)j * NUP + c0 + 4 * q); wu[j][q] = *(const f32x4*)(cw + (size_t)j * NUP + DFF + c0 + 4 * q); }
#pragma unroll
        for (int q = 0; q < 2; ++q) { bg[q] = *(const f32x4*)(cb + c0 + 4 * q); bu[q] = *(const f32x4*)(cb + DFF + c0 + 4 * q); }
        f32x4 g2[2], g1[2], u2[2], u1[2];
        if ((t0 & (SEQ - 1)) == 0) {
#pragma unroll
            for (int q = 0; q < 2; ++q) { g2[q] = (f32x4){0.f, 0.f, 0.f, 0.f}; g1[q] = g2[q]; u2[q] = g2[q]; u1[q] = g2[q]; }
        } else {
            const u32x4 a = *(const u32x4*)(H + (size_t)(t0 - 2) * NUP + c0), b = *(const u32x4*)(H + (size_t)(t0 - 1) * NUP + c0);
            const u32x4 c = *(const u32x4*)(H + (size_t)(t0 - 2) * NUP + DFF + c0), d = *(const u32x4*)(H + (size_t)(t0 - 1) * NUP + DFF + c0);
            g2[0] = (f32x4){lo16(a.x), hi16(a.x), lo16(a.y), hi16(a.y)}; g2[1] = (f32x4){lo16(a.z), hi16(a.z), lo16(a.w), hi16(a.w)};
            g1[0] = (f32x4){lo16(b.x), hi16(b.x), lo16(b.y), hi16(b.y)}; g1[1] = (f32x4){lo16(b.z), hi16(b.z), lo16(b.w), hi16(b.w)};
            u2[0] = (f32x4){lo16(c.x), hi16(c.x), lo16(c.y), hi16(c.y)}; u2[1] = (f32x4){lo16(c.z), hi16(c.z), lo16(c.w), hi16(c.w)};
            u1[0] = (f32x4){lo16(d.x), hi16(d.x), lo16(d.y), hi16(d.y)}; u1[1] = (f32x4){lo16(d.z), hi16(d.z), lo16(d.w), hi16(d.w)};
        }
#pragma unroll 4
        for (int t = 0; t < 32; ++t) {
            const u32x4 a = __builtin_nontemporal_load((const u32x4*)(H + (size_t)(t0 + t) * NUP + c0)), c = __builtin_nontemporal_load((const u32x4*)(H + (size_t)(t0 + t) * NUP + DFF + c0));
            f32x4 g0[2], u0[2];
            g0[0] = (f32x4){lo16(a.x), hi16(a.x), lo16(a.y), hi16(a.y)}; g0[1] = (f32x4){lo16(a.z), hi16(a.z), lo16(a.w), hi16(a.w)};
            u0[0] = (f32x4){lo16(c.x), hi16(c.x), lo16(c.y), hi16(c.y)}; u0[1] = (f32x4){lo16(c.z), hi16(c.z), lo16(c.w), hi16(c.w)};
            unsigned ow[4];
#pragma unroll
            for (int q = 0; q < 2; ++q) {
                const f32x4 hg = bg[q] + wg[0][q] * g2[q] + wg[1][q] * g1[q] + wg[2][q] * g0[q];
                const f32x4 hu = bu[q] + wu[0][q] * u2[q] + wu[1][q] * u1[q] + wu[2][q] * u0[q];
                const f32x2 ga = gelu_pk((f32x2){hg[0], hg[1]}), gb = gelu_pk((f32x2){hg[2], hg[3]});
                ow[2 * q] = cvt_pk_bf16(ga.x * hu[0], ga.y * hu[1]); ow[2 * q + 1] = cvt_pk_bf16(gb.x * hu[2], gb.y * hu[3]);
                g2[q] = g1[q]; g1[q] = g0[q]; u2[q] = u1[q]; u1[q] = u0[q];
            }
            *(u32x4*)(ACT + (size_t)(t0 + t) * DFF + c0) = (u32x4){ow[0], ow[1], ow[2], ow[3]};
        }
    }
}

__device__ __forceinline__ void ple_mul(bf16_t* SG, const bf16_t* PP, int widk) {
    IDX_SETUP
    for (int idx = gt; idx < T * (D / 8); idx += NT) {
        const u32x4 a = ((const u32x4*)SG)[idx], b = ((const u32x4*)PP)[idx];
        u32x4 w; w.x = cvt_pk_bf16(lo16(a.x) * lo16(b.x), hi16(a.x) * hi16(b.x)); w.y = cvt_pk_bf16(lo16(a.y) * lo16(b.y), hi16(a.y) * hi16(b.y));
        w.z = cvt_pk_bf16(lo16(a.z) * lo16(b.z), hi16(a.z) * hi16(b.z)); w.w = cvt_pk_bf16(lo16(a.w) * lo16(b.w), hi16(a.w) * hi16(b.w));
        ((u32x4*)SG)[idx] = w;
    }
}
__device__ __forceinline__ void gla_prep(const bf16_t* QKVR, const float* XA, const float* wa2, const float* ba, bf16_t* AP, bf16_t* KT, bf16_t* KTT, float* DL, LAS unsigned char* lds, int widk) {
    IDX_SETUP
    LAS float* tot = (LAS float*)lds;
    for (int it = c; it < 256; it += G) {
        const int h = it & 3, sc = (it >> 2) & 31, b = it >> 7, bh = b * 4 + h, col = h * 256 + 4 * lane;
        f32x4 w2[16];
#pragma unroll
        for (int j = 0; j < 16; ++j) w2[j] = *(const f32x4*)(wa2 + (size_t)j * 1024 + col);
        const f32x4 bav = *(const f32x4*)(ba + col);
        const size_t tokw = (size_t)b * SEQ + sc * 256 + wid * 32;
#define GLA_LA2(t, out) do { const f32x4* xa4 = (const f32x4*)(XA + (t) * 16); const f32x4 a0 = xa4[0], a1 = xa4[1], a2 = xa4[2], a3 = xa4[3]; \
            f32x4 z = bav + w2[0] * a0[0] + w2[1] * a0[1] + w2[2] * a0[2] + w2[3] * a0[3]; z += w2[4] * a1[0] + w2[5] * a1[1] + w2[6] * a1[2] + w2[7] * a1[3]; \
            z += w2[8] * a2[0] + w2[9] * a2[1] + w2[10] * a2[2] + w2[11] * a2[3]; z += w2[12] * a3[0] + w2[13] * a3[1] + w2[14] * a3[2] + w2[15] * a3[3]; \
            _Pragma("unroll") for (int _e = 0; _e < 4; ++_e) (out)[_e] = -0.0625f * __builtin_amdgcn_logf(1.0f + __builtin_amdgcn_exp2f(-z[_e] * 1.44269504f)); } while (0)
        f32x4 sum = {0.f, 0.f, 0.f, 0.f};
#pragma unroll 4
        for (int tt = 0; tt < 32; ++tt) { f32x4 la; GLA_LA2(tokw + tt, la); sum += la; }
        *(LAS f32x4*)(tot + wid * 256 + 4 * lane) = sum;
        __syncthreads();
        f32x4 bs = {0.f, 0.f, 0.f, 0.f}, ball = bs;
#pragma unroll
        for (int w = 0; w < 8; ++w) { const f32x4 tv = *(const LAS f32x4*)(tot + w * 256 + 4 * lane); if (w < wid) bs += tv; ball += tv; }
        for (int tt = 0; tt < 32; tt += 8) {
            unsigned pk[4][4];
#pragma unroll
            for (int e = 0; e < 8; e += 2) {
                f32x4 kt2[2];
#pragma unroll
                for (int e2 = 0; e2 < 2; ++e2) {
                    const size_t t = tokw + tt + e + e2;
                    f32x4 la; GLA_LA2(t, la); bs += la;
                    const u32x2 qw = *(const u32x2*)(QKVR + t * GLA_N + col), kw = *(const u32x2*)(QKVR + t * GLA_N + 1024 + col);
                    const f32x4 qv = {lo16(qw.x), hi16(qw.x), lo16(qw.y), hi16(qw.y)}, kv = {lo16(kw.x), hi16(kw.x), lo16(kw.y), hi16(kw.y)};
                    f32x4 qt, kt;
#pragma unroll
                    for (int j = 0; j < 4; ++j) { qt[j] = qv[j] * 0.0625f * __builtin_amdgcn_exp2f(bs[j]); kt[j] = kv[j] * __builtin_amdgcn_exp2f(fminf(-bs[j], 120.f)); }
                    u32x2 qo, ko; qo.x = cvt_pk_bf16(qt[0], qt[1]); qo.y = cvt_pk_bf16(qt[2], qt[3]); ko.x = cvt_pk_bf16(kt[0], kt[1]); ko.y = cvt_pk_bf16(kt[2], kt[3]);
                    *(u32x2*)(AP + t * 2048 + h * 512 + 4 * lane) = qo;
                    *(u32x2*)(KT + t * 1024 + col) = ko;
                    kt2[e2] = kt;
                }
#pragma unroll
                for (int j = 0; j < 4; ++j) pk[j][e >> 1] = cvt_pk_bf16(kt2[0][j], kt2[1][j]);
            }
#pragma unroll
            for (int j = 0; j < 4; ++j)
                *(u32x4*)(KTT + ((size_t)(bh * 256 + 4 * lane + j) * SEQ + sc * 256 + wid * 32 + tt)) = (u32x4){pk[j][0], pk[j][1], pk[j][2], pk[j][3]};
        }
        if (wid == 0) { f32x4 dl;
#pragma unroll
            for (int j = 0; j < 4; ++j) dl[j] = __builtin_amdgcn_exp2f(ball[j]);
            *(f32x4*)(DL + (size_t)(bh * 32 + sc) * 256 + 4 * lane) = dl; }
#undef GLA_LA2
        __syncthreads();
    }
}
__device__ __forceinline__ void gla_vt(const bf16_t* __restrict__ QKVR, bf16_t* __restrict__ BP, LAS unsigned char* lds, int widk) {
    IDX_SETUP
    LAS bf16_t* scr = (LAS bf16_t*)(lds + wid * 9216);
    for (int it = gw; it < 256 * 32; it += NGW) {
        const int tt = it >> 5, vt = it & 31;
        const size_t tokb = (size_t)tt * 64; const int vcol = vt * 64, h = vcol >> 9, vv0 = vcol & 511;
        const int b = (int)(tokb >> 13), tl = (int)(tokb & (SEQ - 1)), sc = tl >> 8, tloc0 = tl & 255, bhsc = (b * 4 + h) * 32 + sc;
#pragma unroll
        for (int i = 0; i < 8; ++i) { const int row = (lane >> 3) + 8 * i, ch = lane & 7;
            const u32x4 w = *(const u32x4*)(QKVR + (tokb + row) * GLA_N + 2048 + vcol + ch * 8);
            *(LAS u32x4*)(scr + row * 72 + ch * 8) = w; }
        asm volatile("s_waitcnt lgkmcnt(0)" ::: "memory");
#pragma unroll
        for (int cch = 0; cch < 8; ++cch) {
            unsigned short e[8];
#pragma unroll
            for (int j = 0; j < 8; ++j) e[j] = scr[(cch * 8 + j) * 72 + lane];
            u32x4 w; w.x = e[0] | ((unsigned)e[1] << 16); w.y = e[2] | ((unsigned)e[3] << 16); w.z = e[4] | ((unsigned)e[5] << 16); w.w = e[6] | ((unsigned)e[7] << 16);
            *(u32x4*)(BP + ((size_t)bhsc * 512 + vv0 + lane) * 512 + 256 + tloc0 + cch * 8) = w;
        }
        asm volatile("s_waitcnt lgkmcnt(0)" ::: "memory");
    }
}
__device__ __forceinline__ void gla_scan(const float* __restrict__ UT, const float* __restrict__ DL, bf16_t* __restrict__ BP, int widk) {
    IDX_SETUP
    for (int idx = gt; idx < 8 * 512 * 64; idx += NT) {
        const int k4 = idx & 63, v = (idx >> 6) & 511, bh = idx >> 15;
        f32x4 S = {0.f, 0.f, 0.f, 0.f};
#pragma unroll 4
        for (int sc = 0; sc < 32; ++sc) {
            const size_t bhsc = (size_t)bh * 32 + sc;
            u32x2 w; w.x = cvt_pk_bf16(S[0], S[1]); w.y = cvt_pk_bf16(S[2], S[3]);
            *(u32x2*)(BP + (bhsc * 512 + v) * 512 + k4 * 4) = w;
            const f32x4 dl = *(const f32x4*)(DL + bhsc * 256 + k4 * 4), uu = *(const f32x4*)(UT + (bhsc * 512 + v) * 256 + k4 * 4);
            S = dl * S + uu;
        }
    }
}
__device__ __forceinline__ void gla_gate(bf16_t* O, const float* SSQ, const bf16_t* QKVR, const float* ng, int widk) {
    IDX_SETUP
    for (int idx = gt; idx < T * (D / 8); idx += NT) {
        const int t = idx >> 8, c0 = (idx & 255) * 8, h = c0 >> 9;
        const float rs = 1.0f / sqrtf(SSQ[(size_t)t * 4 + h] * (1.f / 512.f) + LN_EPS);
        const u32x4 ov = *(const u32x4*)(O + (size_t)t * D + c0), rv = *(const u32x4*)(QKVR + (size_t)t * GLA_N + 4096 + c0);
        const f32x4 g0 = *(const f32x4*)(ng + c0), g1 = *(const f32x4*)(ng + c0 + 4);
        float o[8] = {lo16(ov.x), hi16(ov.x), lo16(ov.y), hi16(ov.y), lo16(ov.z), hi16(ov.z), lo16(ov.w), hi16(ov.w)};
        float r[8] = {lo16(rv.x), hi16(rv.x), lo16(rv.y), hi16(rv.y), lo16(rv.z), hi16(rv.z), lo16(rv.w), hi16(rv.w)};
        float gg[8] = {g0[0], g0[1], g0[2], g0[3], g1[0], g1[1], g1[2], g1[3]};
        float y[8];
#pragma unroll
        for (int j = 0; j < 8; ++j) { const float on = bf2f((unsigned short)f2bf(o[j] * rs * gg[j])); y[j] = on * (r[j] * sigmoidf_(r[j])); }
        *(u32x4*)(O + (size_t)t * D + c0) = (u32x4){cvt_pk_bf16(y[0], y[1]), cvt_pk_bf16(y[2], y[3]), cvt_pk_bf16(y[4], y[5]), cvt_pk_bf16(y[6], y[7])};
    }
}

__device__ __forceinline__ f32x4 ldbf4(const bf16_t* p) { const u32x2 w = *(const u32x2*)p; return (f32x4){lo16(w.x), hi16(w.x), lo16(w.y), hi16(w.y)}; }
__device__ __forceinline__ void pool_pass(const bf16_t* __restrict__ X, bf16_t* __restrict__ PO, int widk) {
    IDX_SETUP
    for (int idx = gt; idx < 512 * 512; idx += NT) {
        const int cg4 = idx & 511, sg = idx >> 9, c0 = cg4 * 4, w = 2 << (c0 >> 9);
        const int t0 = sg * 32, tb = t0 & (SEQ - 1);
        f32x4 sum = {0.f, 0.f, 0.f, 0.f};
        for (int j = 1; j < w; ++j) if (tb - j >= 0) sum += ldbf4(X + (size_t)(t0 - j) * D + c0);
#pragma unroll 4
        for (int t = 0; t < 32; ++t) {
            const f32x4 xv = ldbf4(X + (size_t)(t0 + t) * D + c0);
            sum += xv;
            const int tp = tb + t; const float inv = 1.0f / (float)((tp + 1) < w ? (tp + 1) : w);
            const f32x4 y = sum * inv - xv;
            u32x2 o; o.x = cvt_pk_bf16(y[0], y[1]); o.y = cvt_pk_bf16(y[2], y[3]);
            *(u32x2*)(PO + (size_t)(t0 + t) * D + c0) = o;
            if (tp - w + 1 >= 0) sum -= ldbf4(X + (size_t)(t0 + t - w + 1) * D + c0);
        }
    }
}

__device__ __forceinline__ void dsa_kin(const bf16_t* DP, const float* g, const float* b, bf16_t* KIN, int widk) {
    IDX_SETUP
    const float gg = g[lane], bb = b[lane];
    for (int r = gw; r < T; r += NGW) {
        const float v = bf2f(DP[(size_t)r * DSA_NP + 4096 + lane]);
        const float mean = wave_sum(v, lane) * (1.f / 64.f), d = v - mean, var = wave_sum(d * d, lane) * (1.f / 64.f);
        KIN[(size_t)r * 64 + lane] = (bf16_t)f2bf(d * (1.0f / sqrtf(var + LN_EPS)) * gg + bb);
    }
}
__device__ __forceinline__ unsigned f2key(float f) { const unsigned u = __float_as_uint(f); return (u & 0x80000000u) ? ~u : (u | 0x80000000u); }
__device__ __forceinline__ void topk_find_digit(const LAS unsigned* hist, int kk, int lane, int& dg, int& nk) {
    const u32x4 h4 = *(const LAS u32x4*)(hist + 4 * lane);
    const int cc = (int)(h4.x + h4.y + h4.z + h4.w);
    int suf = cc;
#pragma unroll
    for (int o = 1; o < 64; o <<= 1) { const int tv = shi(suf, (lane + o) & 63); if (lane + o < 64) suf += tv; }
    const unsigned long long bal = __ballot(suf >= kk);
    const int Lh = bal ? 63 - __builtin_clzll(bal) : 0;
    int above = suf - cc, d, k2;
    if (above + (int)h4.w >= kk) { d = 3; k2 = kk - above; }
    else { above += (int)h4.w;
        if (above + (int)h4.z >= kk) { d = 2; k2 = kk - above; }
        else { above += (int)h4.z;
            if (above + (int)h4.y >= kk) { d = 1; k2 = kk - above; }
            else { above += (int)h4.y; d = 0; k2 = kk - above; } } }
    dg = __builtin_amdgcn_readlane(4 * lane + d, Lh); nk = __builtin_amdgcn_readlane(k2, Lh);
}
__device__ __forceinline__ void dsa_topk(const bf16_t* DP, const bf16_t* KIN, int* SEL, LAS unsigned char* lds, int widk) {
    IDX_SETUP
    LAS float* scs = (LAS float*)lds;
    LAS unsigned* hist = (LAS unsigned*)(lds + 131072);
    LAS unsigned* misc = (LAS unsigned*)(lds + 131072 + 4096);
    LAS float* mmf = (LAS float*)(lds + 131072 + 4096 + 128);
    LAS unsigned* cand = (LAS unsigned*)(lds + 131072 + 4096 + 384);
    const int fr = lane & 15, fq = lane >> 4;
    for (int rr = c; rr < T / 4; rr += G) {
        const int b = rr >> 11; int blk = rr & 2047; { const int cblk = blk & 255, kb = blk >> 8; blk = (kb < 4) ? (cblk + 256 * kb) : (2047 - (cblk + 256 * (kb - 4))); }
        const int tq0 = blk * 4, n = tq0 + 4;
        const size_t tokq = (size_t)b * SEQ + tq0;
        bf16x8 Af[4][2]; float wv[4][4];
#pragma unroll
        for (int q = 0; q < 4; ++q) {
#pragma unroll
            for (int ks = 0; ks < 2; ++ks) Af[q][ks] = *(const bf16x8*)(DP + (tokq + q) * DSA_NP + 3072 + fr * 64 + ks * 32 + fq * 8);
            const u32x2 ww = *(const u32x2*)(DP + (tokq + q) * DSA_NP + 4160 + 4 * fq);
            wv[q][0] = lo16(ww.x) * 0.03125f; wv[q][1] = hi16(ww.x) * 0.03125f; wv[q][2] = lo16(ww.y) * 0.03125f; wv[q][3] = hi16(ww.y) * 0.03125f;
        }
        const int ntile = (n + 15) >> 4;
        {
            bf16x8 Bf[4][2], Bn[4][2];
#define TOPK_LOAD(dst, jbase) do { _Pragma("unroll") for (int u = 0; u < 4; ++u) { int j = (jbase) + 8 * u; j = j < 512 ? j : 511; \
                const bf16_t* kp = KIN + ((size_t)b * SEQ + j * 16 + fr) * 64 + fq * 8; dst[u][0] = *(const bf16x8*)kp; dst[u][1] = *(const bf16x8*)(kp + 32); } } while (0)
            TOPK_LOAD(Bf, wid);
            float rmn = __builtin_inff(), rmx = -__builtin_inff();
            for (int j4 = wid; j4 < ntile; j4 += 32) {
                TOPK_LOAD(Bn, j4 + 32);
#pragma unroll
                for (int u = 0; u < 4; ++u) {
                    const int j = j4 + 8 * u;
                    if (j < ntile) {
                        float myval = 0.f;
#pragma unroll
                        for (int q = 0; q < 4; ++q) {
                            f32x4 a = {0.f, 0.f, 0.f, 0.f};
                            a = __builtin_amdgcn_mfma_f32_16x16x32_bf16(Af[q][0], Bf[u][0], a, 0, 0, 0);
                            a = __builtin_amdgcn_mfma_f32_16x16x32_bf16(Af[q][1], Bf[u][1], a, 0, 0, 0);
                            float val = wv[q][0] * fmaxf(a[0], 0.f) + wv[q][1] * fmaxf(a[1], 0.f) + wv[q][2] * fmaxf(a[2], 0.f) + wv[q][3] * fmaxf(a[3], 0.f);
                            val += shx(val, 16, lane); val += shx(val, 32, lane);
                            if (fq == q) myval = val;
                        }
                        const int s = j * 16 + fr;
                        if (s > tq0 + fq) myval = -__builtin_inff(); else { rmn = fminf(rmn, myval); rmx = fmaxf(rmx, myval); }
                        scs[fq * 8192 + s] = myval;
                    }
                }
#pragma unroll
                for (int u = 0; u < 4; ++u) { Bf[u][0] = Bn[u][0]; Bf[u][1] = Bn[u][1]; }
            }
#undef TOPK_LOAD
#pragma unroll
            for (int o = 1; o < 16; o <<= 1) { rmn = fminf(rmn, shx(rmn, o, lane)); rmx = fmaxf(rmx, shx(rmx, o, lane)); }
            if (fr == 0) { mmf[wid * 8 + fq * 2] = rmn; mmf[wid * 8 + fq * 2 + 1] = rmx; }
            for (int i = tid; i < 1024; i += 512) hist[i] = 0u;
            if (tid < 32) misc[tid] = 0u;
        }
        __syncthreads();
        const int q = wid >> 1, sub = tid & 127, nq = tq0 + q + 1;
        int* selrow = SEL + (tokq + q) * 256;
        LAS float* row = scs + q * 8192;
        if (n <= 256) {
            for (int i = sub; i < 256; i += 128) selrow[i] = (i < nq) ? i : -1;
        } else {
            float mn = mmf[q * 2], mx = mmf[q * 2 + 1];
#pragma unroll
            for (int w = 1; w < 8; ++w) { mn = fminf(mn, mmf[w * 8 + q * 2]); mx = fmaxf(mx, mmf[w * 8 + q * 2 + 1]); }
            const float scale = (mx > mn) ? 255.0f / (mx - mn) : 0.f;
#define DSA_BIN(v) ({ int _b = (int)(((v) - mn) * scale); _b = _b < 0 ? 0 : _b; _b > 255 ? 255 : _b; })
            for (int sb = 0; sb < nq; sb += 512) { const int s4 = sb + 4 * sub;
                if (s4 < nq) { const f32x4 v4 = *(const LAS f32x4*)(row + s4);
#pragma unroll
                    for (int e = 0; e < 4; ++e) if (s4 + e < nq) __hip_atomic_fetch_add(hist + q * 256 + DSA_BIN(v4[e]), 1u, __ATOMIC_RELAXED, __HIP_MEMORY_SCOPE_WORKGROUP); } }
            __syncthreads();
            int bA, kkA; topk_find_digit(hist + q * 256, 256, lane, bA, kkA);
            LAS unsigned* lst = cand + q * 512;
            for (int sb = 0; sb < nq; sb += 512) { const int s4 = sb + 4 * sub; const bool in4 = s4 < nq;
                f32x4 v4 = {0.f, 0.f, 0.f, 0.f}; if (in4) v4 = *(const LAS f32x4*)(row + s4);
#pragma unroll
                for (int e = 0; e < 4; ++e) { const int s = s4 + e; const bool in = s < nq; const float v = v4[e]; const int bin = DSA_BIN(v);
                    const bool gsel = in && bin > bA;
                    const unsigned long long gm = __ballot(gsel);
                    if (gm) { const int leader = __builtin_ctzll(gm); unsigned base = 0u;
                        if (lane == leader) base = __hip_atomic_fetch_add(misc + q * 4 + 2, (unsigned)__builtin_popcountll(gm), __ATOMIC_RELAXED, __HIP_MEMORY_SCOPE_WORKGROUP);
                        base = (unsigned)__builtin_amdgcn_readlane((int)base, leader);
                        const unsigned pos = base + (unsigned)__builtin_popcountll(gm & ((1ull << lane) - 1ull));
                        if (gsel && pos < 256u) selrow[pos] = s; }
                    if (in && bin == bA) { const unsigned cp = __hip_atomic_fetch_add(misc + q * 4 + 3, 1u, __ATOMIC_RELAXED, __HIP_MEMORY_SCOPE_WORKGROUP); if (cp < 256u) { lst[2 * cp] = f2key(v); lst[2 * cp + 1] = (unsigned)s; } } }
            }
            __syncthreads();
            const int nc = (int)misc[q * 4 + 3];
            if (nc <= 256) {
                for (int i = sub; i < nc; i += 128) { const unsigned ki = lst[2 * i], si = lst[2 * i + 1]; int rank = 0;
                    for (int j = 0; j < nc; ++j) { const unsigned kj = lst[2 * j], sj = lst[2 * j + 1]; rank += (kj > ki || (kj == ki && sj < si)) ? 1 : 0; }
                    if (rank < kkA) selrow[256 - kkA + rank] = (int)si; }
            } else if ((wid & 1) == 0) {
                unsigned prefix = 0u, maskb = 0u; int kk = kkA;
#pragma unroll 1
                for (int pass = 0; pass < 4; ++pass) { const int shift = 24 - 8 * pass;
                    for (int i = lane; i < 256; i += 64) hist[q * 256 + i] = 0u;
                    asm volatile("s_waitcnt lgkmcnt(0)" ::: "memory");
                    for (int s = lane; s < nq; s += 64) { const float v = row[s]; if (DSA_BIN(v) == bA) { const unsigned key = f2key(v); if ((key & maskb) == prefix) __hip_atomic_fetch_add(hist + q * 256 + ((key >> shift) & 255u), 1u, __ATOMIC_RELAXED, __HIP_MEMORY_SCOPE_WORKGROUP); } }
                    asm volatile("s_waitcnt lgkmcnt(0)" ::: "memory");
                    int dg, nk; topk_find_digit(hist + q * 256, kk, lane, dg, nk); kk = nk;
                    prefix |= (unsigned)dg << shift; maskb |= 255u << shift; }
                int baseG = 256 - kkA, baseE = 256 - kk; const int endE = 256;
                for (int sb = 0; sb < nq; sb += 64) { const int s = sb + lane; const bool in = s < nq; const float v = in ? row[s] : 0.f; const bool inb = in && DSA_BIN(v) == bA; const unsigned key = f2key(v);
                    const bool g = inb && key > prefix, e = inb && key == prefix;
                    const unsigned long long gm = __ballot(g), em = __ballot(e), lt = (1ull << lane) - 1ull;
                    if (g) { const int pos = baseG + __builtin_popcountll(gm & lt); if (pos < 256) selrow[pos] = s; }
                    if (e) { const int pos = baseE + __builtin_popcountll(em & lt); if (pos < endE) selrow[pos] = s; }
                    baseG += __builtin_popcountll(gm); baseE += __builtin_popcountll(em); }
            }
#undef DSA_BIN
        }
        __syncthreads();
    }
}
__device__ __forceinline__ void dsa_attn(const bf16_t* DP, const int* SEL, bf16_t* O, LAS unsigned char* lds, int widk) {
    IDX_SETUP
    LAS unsigned char* pl = lds + wid * 10240;
    LAS unsigned char* vt = lds + wid * 10240 + 2048;
    const int fr = lane & 15, fq = lane >> 4;
    unsigned tra[8][2];
#pragma unroll
    for (int cb = 0; cb < 8; ++cb)
#pragma unroll
        for (int t = 0; t < 2; ++t) { const unsigned q_ = (unsigned)(fr >> 2), p_ = (unsigned)(fr & 3), row = 8u * (unsigned)fq + 4u * (unsigned)t + q_, ch = 2u * (unsigned)cb + (p_ >> 1);
            tra[cb][t] = (unsigned)(size_t)vt + 256u * row + 16u * (ch ^ (((row & 3u) << 2) | ((row >> 2) & 3u))) + 8u * (p_ & 1u); }
    for (int m = 0;; ++m) {
#ifdef ATTN_BLOCKED_XCD
        const int kk_ = wid + 8 * m; if (kk_ >= 256 || G != 256) { if (G == 256) break; }
        const int pair = c >> 5, t = (c & 31) + 32 * kk_, b = pair >> 2, g = pair & 3;
#else
        const int jdx = c + G * (wid + 8 * m); if (jdx >= T * 4) break;
        const int pair = jdx & 7, t = jdx >> 3, b = pair >> 2, g = pair & 3;
#endif
        const size_t tok = (size_t)b * SEQ + t; const int nvalid = (t + 1) < 256 ? (t + 1) : 256;
        int s0 = SEL[tok * 256 + lane], s1 = SEL[tok * 256 + 64 + lane], s2 = SEL[tok * 256 + 128 + lane], s3 = SEL[tok * 256 + 192 + lane];
        s0 = s0 < 0 ? 0 : s0; s1 = s1 < 0 ? 0 : s1; s2 = s2 < 0 ? 0 : s2; s3 = s3 < 0 ? 0 : s3;
        bf16x8 qf[4];
#pragma unroll
        for (int ks = 0; ks < 4; ++ks) { qf[ks] = (bf16x8){0, 0, 0, 0, 0, 0, 0, 0}; if (fr < 4) qf[ks] = *(const bf16x8*)(DP + tok * DSA_NP + (g * 4 + fr) * 128 + ks * 32 + fq * 8); }
        const bf16_t* kbase = DP + (size_t)b * SEQ * DSA_NP + 2048 + g * 128 + fq * 8;
        f32x4 acc[16];
#pragma unroll
        for (int j = 0; j < 16; ++j) {
            const int sreg = (j < 4) ? s0 : (j < 8) ? s1 : (j < 12) ? s2 : s3;
            const int idx = shi(sreg, (16 * j + fr) & 63);
            const bf16_t* kr = kbase + (size_t)idx * DSA_NP;
            const bf16x8 a0 = *(const bf16x8*)kr, a1 = *(const bf16x8*)(kr + 32), a2 = *(const bf16x8*)(kr + 64), a3 = *(const bf16x8*)(kr + 96);
            f32x4 a = {0.f, 0.f, 0.f, 0.f};
            a = __builtin_amdgcn_mfma_f32_16x16x32_bf16(a0, qf[0], a, 0, 0, 0);
            a = __builtin_amdgcn_mfma_f32_16x16x32_bf16(a1, qf[1], a, 0, 0, 0);
            a = __builtin_amdgcn_mfma_f32_16x16x32_bf16(a2, qf[2], a, 0, 0, 0);
            a = __builtin_amdgcn_mfma_f32_16x16x32_bf16(a3, qf[3], a, 0, 0, 0);
            acc[j] = a;
            if ((j & 7) == 7) asm volatile("" ::: "memory");
        }
        const bf16_t* vbase = DP + (size_t)b * SEQ * DSA_NP + 2560 + g * 128 + fr * 8;
        u32x4 vcur[8], vnxt[8], vnn[8];
#define ATTN_VLOAD(dst, ks) do { const int sreg_ = ((ks) < 2) ? s0 : ((ks) < 4) ? s1 : ((ks) < 6) ? s2 : s3; _Pragma("unroll") for (int i = 0; i < 8; ++i) { \
            const int idx_ = shi(sreg_, 32 * ((ks) & 1) + fq + 4 * i); dst[i] = *(const u32x4*)(vbase + (size_t)idx_ * DSA_NP); } } while (0)
        ATTN_VLOAD(vcur, 0); ATTN_VLOAD(vnxt, 1);
        float mx = -__builtin_inff();
#pragma unroll
        for (int j = 0; j < 16; ++j)
#pragma unroll
            for (int r = 0; r < 4; ++r) { const int slot = 16 * j + 4 * fq + r; const float sv = (slot < nvalid) ? acc[j][r] * 0.08838834764831845f : -__builtin_inff(); acc[j][r] = sv; mx = fmaxf(mx, sv); }
        mx = fmaxf(mx, shx(mx, 16, lane)); mx = fmaxf(mx, shx(mx, 32, lane));
        float sum = 0.f;
#pragma unroll
        for (int j = 0; j < 16; ++j)
#pragma unroll
            for (int r = 0; r < 4; ++r) { const float pv = __expf(acc[j][r] - mx); acc[j][r] = pv; sum += pv; }
        sum += shx(sum, 16, lane); sum += shx(sum, 32, lane);
        const float inv = 1.0f / sum;
        if (fr < 4) {
#pragma unroll
            for (int j = 0; j < 16; ++j) { u32x2 w; w.x = cvt_pk_bf16(acc[j][0] * inv, acc[j][1] * inv); w.y = cvt_pk_bf16(acc[j][2] * inv, acc[j][3] * inv);
                *(LAS u32x2*)(pl + (fr * 256 + 16 * j + 4 * fq) * 2) = w; }
        }
        f32x4 oc[8];
#pragma unroll
        for (int cb = 0; cb < 8; ++cb) oc[cb] = (f32x4){0.f, 0.f, 0.f, 0.f};
#pragma unroll
        for (int ks = 0; ks < 8; ++ks) {
            if (ks < 6) ATTN_VLOAD(vnn, ks + 2);
#pragma unroll
            for (int i = 0; i < 8; ++i) { const unsigned row = (unsigned)(fq + 4 * i), ch = (unsigned)fr;
                *(LAS u32x4*)(vt + 256u * row + 16u * (ch ^ (((row & 3u) << 2) | ((row >> 2) & 3u)))) = vcur[i]; }
            bf16x8 pa = (bf16x8){0, 0, 0, 0, 0, 0, 0, 0};
            asm volatile("s_waitcnt lgkmcnt(0)" ::: "memory");
            if (fr < 4) pa = *(const LAS bf16x8*)(pl + (fr * 256 + 32 * ks + 8 * fq) * 2);
            u32x2 t0[8], t1[8];
#pragma unroll
            for (int cb = 0; cb < 8; ++cb) {
                asm volatile("ds_read_b64_tr_b16 %0, %1" : "=v"(t0[cb]) : "v"(tra[cb][0]) : "memory");
                asm volatile("ds_read_b64_tr_b16 %0, %1" : "=v"(t1[cb]) : "v"(tra[cb][1]) : "memory");
            }
            asm volatile("s_waitcnt lgkmcnt(0)" : "+v"(t0[0]), "+v"(t0[1]), "+v"(t0[2]), "+v"(t0[3]), "+v"(t0[4]), "+v"(t0[5]), "+v"(t0[6]), "+v"(t0[7]),
                                                  "+v"(t1[0]), "+v"(t1[1]), "+v"(t1[2]), "+v"(t1[3]), "+v"(t1[4]), "+v"(t1[5]), "+v"(t1[6]), "+v"(t1[7]), "+v"(pa) :: "memory");
#pragma unroll
            for (int cb = 0; cb < 8; ++cb) { const u32x4 bw = {t0[cb].x, t0[cb].y, t1[cb].x, t1[cb].y};
                oc[cb] = __builtin_amdgcn_mfma_f32_16x16x32_bf16(pa, __builtin_bit_cast(bf16x8, bw), oc[cb], 0, 0, 0); }
#pragma unroll
            for (int i = 0; i < 8; ++i) { vcur[i] = vnxt[i]; vnxt[i] = vnn[i]; }
        }
#undef ATTN_VLOAD
        if (fq == 0) {
            bf16_t* op = O + tok * D + (g * 4) * 128 + fr;
#pragma unroll
            for (int cb = 0; cb < 8; ++cb)
#pragma unroll
                for (int r = 0; r < 4; ++r) op[r * 128 + 16 * cb] = (bf16_t)f2bf(oc[cb][r]);
        }
        asm volatile("s_waitcnt lgkmcnt(0)" ::: "memory");
    }
}


#define XB_TMO      128
#define XB_XCNT(j)  (256  + 64 * (j))
#define XB_XSUB(j)  (1280 + 64 * (j))
#define XB_XGEN(j)  (2304 + 64 * (j))
#define XB_TOP      3328
#define XB_TOPGEN   3392
#define XB_SPIN_CAP (1u << 22)
__device__ __forceinline__ unsigned xb_ld(unsigned* p)              { return __hip_atomic_load(p, __ATOMIC_RELAXED, __HIP_MEMORY_SCOPE_AGENT); }
__device__ __forceinline__ unsigned xb_add(unsigned* p, unsigned v) { return __hip_atomic_fetch_add(p, v, __ATOMIC_RELAXED, __HIP_MEMORY_SCOPE_AGENT); }
__device__ __forceinline__ unsigned xb_xcc_id() { return (unsigned)__builtin_amdgcn_s_getreg((3 << 11) | 20) & 0xFu; }
#define XB_SPIN(cond, bar) do { unsigned _sp = 0; while (cond) { __builtin_amdgcn_s_sleep(1); \
    if ((++_sp & 255u) == 0u) { if (xb_ld(&(bar)[XB_TMO])) break; if (_sp > XB_SPIN_CAP) { atomicAdd(&(bar)[XB_TMO], 1u); break; } } } } while (0)
__device__ __forceinline__ void xcd_barrier_complete(unsigned* bar, unsigned x, unsigned& nloc, unsigned& nx) {
    const unsigned G = gridDim.x;
    unsigned sum, cnt, mine, sp = 0u;
    for (;;) {
        sum = 0u; cnt = 0u; mine = 0u;
#pragma unroll
        for (unsigned j = 0; j < 16; ++j) { const unsigned cc = xb_ld(&bar[XB_XCNT(j)]); sum += cc; cnt += (cc > 0u) ? 1u : 0u; mine = (j == x) ? cc : mine; }
        if (sum == G) break;
        __builtin_amdgcn_s_sleep(1);
        if ((++sp & 255u) == 0u) { if (xb_ld(&bar[XB_TMO])) break; if (sp > XB_SPIN_CAP) { atomicAdd(&bar[XB_TMO], 1u); break; } }
    }
    nloc = mine > 0u ? mine : 1u; nx = cnt > 0u ? cnt : 1u;
}
__device__ __forceinline__ void xcd_barrier(unsigned* bar, volatile LAS unsigned* st, int widk) {
    asm volatile("s_waitcnt vmcnt(0)" ::: "memory");
    __syncthreads();
    if (opaque_tid(widk) == 0) {
        __builtin_amdgcn_s_waitcnt(0);
        const unsigned x = xb_xcc_id();
        unsigned nloc = st[0], nx = st[1];
        if (nloc == 0u) { xcd_barrier_complete(bar, x, nloc, nx); st[0] = nloc; st[1] = nx; }
        const unsigned old = xb_add(&bar[XB_XSUB(x)], 1u);
        const unsigned gen = old / nloc;
        if (old + 1u == (gen + 1u) * nloc) {
            __builtin_amdgcn_fence(__ATOMIC_RELEASE, "agent");
            asm volatile("s_waitcnt vmcnt(0)" ::: "memory");
            const unsigned og = xb_add(&bar[XB_TOP], 1u);
            const unsigned tg = og / nx;
            if (og + 1u == (tg + 1u) * nx) xb_add(&bar[XB_TOPGEN], 1u);
            else XB_SPIN(xb_ld(&bar[XB_TOPGEN]) == tg, bar);
            __builtin_amdgcn_fence(__ATOMIC_ACQUIRE, "agent");
            xb_add(&bar[XB_XGEN(x)], 1u);
            asm volatile("s_waitcnt vmcnt(0)" ::: "memory");
        } else {
            XB_SPIN(xb_ld(&bar[XB_XGEN(x)]) == gen, bar);
            __builtin_amdgcn_fence(__ATOMIC_ACQUIRE, "agent");
            asm volatile("s_waitcnt vmcnt(0)" ::: "memory");
        }
    }
    __syncthreads();
}
#ifndef EN_MASK
#define EN_MASK 0xFFFFFF
#endif
#define EN(b) ((EN_MASK >> (b)) & 1)
#ifndef REP_MASK
#define REP_MASK 0
#endif
#define REPN(b) (1 + ((REP_MASK >> (b)) & 1))
__device__ __forceinline__ const void* ldp(LAS unsigned char* lds, int i) {
    const LAS unsigned* q = (const LAS unsigned*)(lds + 143360) + 2 * i;
    const unsigned lo = __builtin_amdgcn_readfirstlane(q[0]), hi = __builtin_amdgcn_readfirstlane(q[1]);
    return (const void*)(((unsigned long long)hi << 32) | lo);
}
#ifdef CGSYNC
#define GSYNC() grid.sync()
#else
#define GSYNC() do { for (int _r = 0; _r < REPN(20); ++_r) xcd_barrier((unsigned*)(WSP + OFF_CTL), (volatile LAS unsigned*)(lds + LDS_BAR_OFF), widk); } while (0)
#endif

__global__ void __launch_bounds__(512, 2) mega_fwd(Params P) {
    extern __shared__ __attribute__((aligned(16))) unsigned char lds_raw[];
    LAS unsigned char* lds = (LAS unsigned char*)lds_raw;
    cg::grid_group grid = cg::this_grid();
    const int G = gridDim.x, c = blockIdx.x;
    const int widk = __builtin_amdgcn_readfirstlane(threadIdx.x >> 6);
    if (threadIdx.x == 0) { ((LAS unsigned*)(lds + LDS_BAR_OFF))[0] = 0u; ((LAS unsigned*)(lds + LDS_BAR_OFF))[1] = 0u; }
    if (blockIdx.x == 0) for (int i = threadIdx.x; i < 3456; i += 512) __hip_atomic_store((unsigned*)(P.ws + OFF_CTL) + i, 0u, __ATOMIC_RELAXED, __HIP_MEMORY_SCOPE_AGENT);

#ifdef LDSP
    {
        LAS unsigned long long* PL = (LAS unsigned long long*)(lds + 143360);
        if (threadIdx.x == 0) { const unsigned long long* src = (const unsigned long long*)&P;
#pragma unroll
            for (int i = 0; i < 26; ++i) PL[i] = src[i]; }
        __syncthreads();
    }
#endif
#ifdef LDSP
#define PF(i) ((const float*)ldp(lds, (i)))
#else
#define PF(i) (((const float* const*)&P)[(i)])
#endif
#ifdef LDSP
#define WSP ((unsigned char*)ldp(lds, 25))
#else
#define WSP (P.ws)
#endif
#define XF ((float*)(WSP + OFF_XF))
#define XB ((bf16_t*)(WSP + OFF_XB))
#define PB ((bf16_t*)(WSP + OFF_PB))
#define PLEB ((bf16_t*)(WSP + OFF_PLE))
#define HB ((bf16_t*)(WSP + OFF_H))
#define ACTB ((bf16_t*)(WSP + OFF_ACT))
#define OB ((bf16_t*)(WSP + OFF_O))
#define KTT ((bf16_t*)(WSP + OFF_KTT))
#define SEL ((int*)(WSP + OFF_SEL))
#define XA ((float*)(WSP + OFF_XA))
#define SSQ ((float*)(WSP + OFF_SSQ))
#define DL ((float*)(WSP + OFF_DL))
#define KIN ((bf16_t*)(WSP + OFF_KIN))
#define WB ((bf16_t*)(WSP + OFF_W))
#define QKVR ((bf16_t*)(WSP + OFF_QKVR))
#define BP ((bf16_t*)(WSP + OFF_BP))
#define UT ((float*)(WSP + OFF_UT))
#define KT ((bf16_t*)(WSP + OFF_KT))
#define AP PLEB
#define STB ((float*)(WSP + OFF_ST))
#define PPB ((bf16_t*)(WSP + OFF_PP))


    for (int rep = 0; rep < REPN(12); ++rep) {
        IDX_SETUP
        LAS unsigned* scr = (LAS unsigned*)(lds + wid * 16384);
        if (EN(12)) {
#pragma unroll 1
        for (int j = 0; j < 2; ++j) {
            TJOB(PF(2) + (size_t)j * D * GLA_N, D, GLA_N, WB + W_GIN + (size_t)j * GLA_N * D, 0);
            TJOB(PF(7) + (size_t)j * D * D, D, D, WB + W_GO + (size_t)j * D * D, 0);
        }
#pragma unroll 1
        for (int g = 0; g < 4; ++g) TJOB(PF(8) + (size_t)g * 512 * 512, 512, 512, WB + W_POOL, g * 512);
        TJOB(PF(10), D, DSA_N, WB + W_DIN, 0);
        TJOB(PF(13), D, D, WB + W_DO, 0);
#pragma unroll 1
        for (int i = 0; i < 4; ++i) {
            TJOB(PF(16) + (size_t)i * D * NUP, D, NUP, WB + W_UP + (size_t)i * NUP * D, 0);
            TJOB(PF(19) + (size_t)i * DFF * D, DFF, D, WB + W_DOWN + (size_t)i * D * DFF, 0);
            TJOB(PF(20) + (size_t)i * D * D, D, D, WB + W_GATE + (size_t)i * D * D, 0);
            TJOB(PF(21) + (size_t)i * PLE * D, PLE, D, WB + W_PROJ + (size_t)i * D * PLE, 0);
        }
        }
        if (EN(13)) row_pass(PF(0), nullptr, nullptr, nullptr, XB, nullptr, widk);
        for (size_t i = (size_t)gt; i < (size_t)4 * T * PLE / 4; i += (size_t)NT) { const f32x4 v = __builtin_nontemporal_load(((const f32x4*)PF(1)) + i); u32x2 w; w.x = cvt_pk_bf16(v.x, v.y); w.y = cvt_pk_bf16(v.z, v.w); ((u32x2*)PB)[i] = w; }
    }
    grid.sync();
    if (threadIdx.x == 0) (void)xb_add((unsigned*)(P.ws + OFF_CTL) + XB_XCNT(xb_xcc_id()), 1u);

#pragma unroll 1
    for (int layer = 0; layer < 4; ++layer) {
        const int kind = layer % 3, jl = layer / 3;
        const float* xsrc = (layer == 0) ? PF(0) : XF;
        if (kind != 1) {
            if (kind == 0) for (int rep = 0; rep < REPN(21); ++rep) xa_pass(XB, PF(3) + (size_t)jl * D * 16, XA, widk);
            const int N = (kind == 0) ? GLA_N : DSA_NP;
            pg8::PlainSched S; S.o.init(T / 256, N / 256, G, c); S.A = (const char*)XB; S.B = (const char*)(kind == 0 ? WB + W_GIN + (size_t)jl * GLA_N * D : WB + W_DIN);
            S.tsA = (size_t)256 * D * 2; S.tsB = (size_t)256 * D * 2; S.poolmode = 0;
            pg8::EpiBf16<0> E{HB, N};
            for (int rep = 0; rep < REPN(14); ++rep) pg8::gemm_phase(lds, D, D, D, S, E, widk);
            GSYNC();
        }
        if (kind == 0) {
            for (int rep = 0; rep < REPN(0); ++rep) gla_prep(QKVR, XA, PF(4) + (size_t)jl * 16 * 1024, PF(5) + (size_t)jl * 1024, AP, KT, KTT, DL, lds, widk);
            for (int rep = 0; rep < REPN(1); ++rep) gla_vt(QKVR, BP, lds, widk);
            { IDX_SETUP for (int i = gt; i < T * 4; i += NT) SSQ[i] = 0.f; }
            GSYNC();
            for (int rep = 0; rep < REPN(2); ++rep) { GlaScoreSched S{G, c, AP, KT}; GlaScoreEpi E{AP}; pg8::gemm_phase(lds, 256, 2048, 1024, S, E, widk); }
            for (int rep = 0; rep < REPN(3); ++rep) { GlaUSched S{G, c, BP, KTT}; GlaUEpi E{UT, DL}; pg8::gemm_phase(lds, 256, 512, SEQ, S, E, widk); }
            GSYNC();
            for (int rep = 0; rep < REPN(4); ++rep) gla_scan(UT, DL, BP, widk);
            GSYNC();
            if (EN(5)) { GlaOSched S{G, c, AP, BP}; GlaOEpi E{OB, SSQ}; pg8::gemm_phase(lds, 512, 2048, 512, S, E, widk); }
            GSYNC();
            if (EN(6)) gla_gate(OB, SSQ, QKVR, PF(6) + (size_t)jl * D, widk);
            GSYNC();
        } else if (kind == 1) {
            for (int rep = 0; rep < REPN(7); ++rep) pool_pass(XB, OB, widk);
            GSYNC();
        } else {
            for (int rep = 0; rep < REPN(8); ++rep) dsa_kin(HB, PF(11), PF(12), KIN, widk);
            GSYNC();
            for (int rep = 0; rep < REPN(9); ++rep) dsa_topk(HB, KIN, SEL, lds, widk);
            GSYNC();
            for (int rep = 0; rep < REPN(10); ++rep) dsa_attn(HB, SEL, OB, lds, widk);
            GSYNC();
        }
        {
            pg8::PlainSched S; S.o.init(T / 256, D / 256, G, c); S.A = (const char*)OB;
            S.B = (const char*)(kind == 0 ? WB + W_GO + (size_t)jl * D * D : kind == 1 ? WB + W_POOL : WB + W_DO);
            const int K = (kind == 1) ? 512 : D;
            S.tsA = (size_t)256 * D * 2; S.tsB = (size_t)256 * K * 2; S.poolmode = (kind == 1);
            pg8::EpiResidT<4> E{xsrc, XF, (kind == 1) ? PF(9) : nullptr, nullptr, nullptr, (layer == 0) ? nullptr : STB, PF(22) + (size_t)(layer - 1) * D, PF(23) + (size_t)(layer - 1) * D};
            if (REPN(15) > 1) { pg8::EpiResid E2{xsrc, (float*)HB, (kind == 1) ? PF(9) : nullptr, nullptr, nullptr, (layer == 0) ? nullptr : STB, PF(22) + (size_t)(layer - 1) * D, PF(23) + (size_t)(layer - 1) * D}; pg8::gemm_phase(lds, K, D, K, S, E2, widk); }
            if (EN(15)) pg8::gemm_phase(lds, K, D, K, S, E, widk);
        }
        GSYNC();
        if (EN(13)) row_pass(XF, PF(14) + (size_t)layer * D, PF(15) + (size_t)layer * D, nullptr, XB, STB, widk);
        if (REPN(13) > 1) row_pass(XF, PF(14) + (size_t)layer * D, PF(15) + (size_t)layer * D, (float*)HB, OB, nullptr, widk);
        GSYNC();
#pragma unroll 1
        for (int gi = 0; gi < 2; ++gi) {
            const int N = gi == 0 ? NUP : D;
            pg8::PlainSched S; S.o.init(T / 256, N / 256, G, c); S.A = (const char*)XB;
            S.B = (const char*)(gi == 0 ? WB + W_UP + (size_t)layer * NUP * D : WB + W_GATE + (size_t)layer * D * D);
            S.tsA = (size_t)256 * D * 2; S.tsB = (size_t)256 * D * 2; S.poolmode = 0;
            if (gi == 0) { pg8::EpiBf16<0, true> E{HB, NUP}; for (int rep = 0; rep < REPN(16); ++rep) pg8::gemm_phase(lds, D, D, D, S, E, widk); }
            else { pg8::EpiBf16<2> E{PLEB, D}; for (int rep = 0; rep < REPN(17); ++rep) pg8::gemm_phase(lds, D, D, D, S, E, widk); }
        }
        {
            pg8::PlainSched S; S.o.init(T / 256, D / 256, G, c); S.A = (const char*)(PB + (size_t)layer * T * PLE); S.B = (const char*)(WB + W_PROJ + (size_t)layer * D * PLE);
            S.tsA = (size_t)256 * PLE * 2; S.tsB = (size_t)256 * PLE * 2; S.poolmode = 0;
            pg8::EpiBf16<0> E{PPB, D};
            for (int rep = 0; rep < REPN(18); ++rep) pg8::gemm_phase(lds, PLE, PLE, PLE, S, E, widk);
        }
        GSYNC();
        for (int rep = 0; rep < REPN(11); ++rep) conv_pass(HB, PF(17) + (size_t)layer * 3 * NUP, PF(18) + (size_t)layer * NUP, ACTB, widk);
        GSYNC();
        {
            pg8::PlainSched S; S.o.init(T / 256, D / 256, G, c); S.A = (const char*)ACTB; S.B = (const char*)(WB + W_DOWN + (size_t)layer * D * DFF);
            S.tsA = (size_t)256 * DFF * 2; S.tsB = (size_t)256 * DFF * 2; S.poolmode = 0;
            pg8::EpiResid E{XF, XF, nullptr, PLEB, PPB, STB, PF(14) + (size_t)layer * D, PF(15) + (size_t)layer * D};
            if (REPN(19) > 1) { pg8::EpiResid E2{XF, (float*)HB, nullptr, PLEB, PPB, STB, PF(14) + (size_t)layer * D, PF(15) + (size_t)layer * D}; pg8::gemm_phase(lds, DFF, DFF, DFF, S, E2, widk); }
            if (EN(19)) pg8::gemm_phase(lds, DFF, DFF, DFF, S, E, widk);
        }
        GSYNC();
        if (!EN(13)) {} else if (layer == 3) row_pass(XF, PF(22) + (size_t)layer * D, PF(23) + (size_t)layer * D, ((float*)PF(24)), nullptr, nullptr, widk);
        else row_pass(XF, PF(22) + (size_t)layer * D, PF(23) + (size_t)layer * D, nullptr, XB, STB, widk);
        if (layer != 3) GSYNC();
    }
}

extern "C" void kernel_launch(void* const* d_in, const int* in_sizes, int n_in, void* d_out, int out_size, void* d_ws, size_t ws_size, hipStream_t stream) {
    static int grid = 0;
    if (grid == 0) {
        if (n_in != 24 || out_size != T * D || ws_size < WS_END) { fprintf(stderr, "kernel_launch: unexpected problem (n_in %d, out %d, ws %zu < %zu)\n", n_in, out_size, ws_size, (size_t)WS_END); grid = -1; return; }
        int dev = 0, cus = 0, per_cu = 0;
        (void)hipGetDevice(&dev); (void)hipDeviceGetAttribute(&cus, hipDeviceAttributeMultiprocessorCount, dev);
        if (hipFuncSetAttribute((const void*)mega_fwd, hipFuncAttributeMaxDynamicSharedMemorySize, LDS_BYTES) != hipSuccess) { fprintf(stderr, "kernel_launch: hipFuncSetAttribute failed\n"); grid = -1; return; }
        if (hipOccupancyMaxActiveBlocksPerMultiprocessor(&per_cu, (const void*)mega_fwd, 512, LDS_BYTES) != hipSuccess || per_cu < 1) { fprintf(stderr, "kernel_launch: occupancy query says %d blocks/CU\n", per_cu); per_cu = 1; }
        (void)hipGetLastError();
        grid = cus;
    }
    if (grid < 0) return;
    Params p{};
    const float** pf = (const float**)&p;
    for (int i = 0; i < 24; ++i) pf[i] = (const float*)d_in[i];
    p.out = (float*)d_out; p.ws = (unsigned char*)d_ws;
    void* args[] = {&p};
    hipError_t e = hipLaunchCooperativeKernel((const void*)mega_fwd, dim3(grid), dim3(512), args, LDS_BYTES, stream);
    if (e != hipSuccess) fprintf(stderr, "kernel_launch: cooperative launch failed: %s (grid %d)\n", hipGetErrorString(e), grid);
}
```
